# Optimizing an MI355X kernel written in HIP

```python
import jax, jax.numpy as jnp
from jax import lax
import numpy as np

D_MODEL = 2048
BATCH = 2
SEQ = 16384
DEPTH = 1

ATTN_HEADS = 16
ATTN_KV_HEADS = 4
ATTN_HEAD_DIM = 64
ATTN_GROUP = ATTN_HEADS // ATTN_KV_HEADS
ATTN_WIDTH = ATTN_HEADS * ATTN_HEAD_DIM
KV_WIDTH = ATTN_KV_HEADS * ATTN_HEAD_DIM
WINDOW = 128
ATTN_BLOCK = 128
ROPE_THETA = 10000.0

HGRN_WIDTH = D_MODEL // 2
HGRN_EXPAND = 128
HGRN_HEADS = HGRN_WIDTH // HGRN_EXPAND
HGRN_KEY_DIM = HGRN_EXPAND
HGRN_VALUE_DIM = HGRN_WIDTH // HGRN_HEADS
HGRN_FORGET_WIDTH = HGRN_HEADS * HGRN_KEY_DIM
HGRN_CHUNK = 64

NORM_EPS = 1e-6

IN_SPLITS = (
    ATTN_WIDTH,
    KV_WIDTH,
    KV_WIDTH,
    ATTN_WIDTH,
    HGRN_FORGET_WIDTH,
    HGRN_FORGET_WIDTH,
    HGRN_WIDTH,
    HGRN_WIDTH,
    D_MODEL,
    D_MODEL,
)
IN_WIDTH = int(sum(IN_SPLITS))
SPLIT_POINTS = tuple(int(s) for s in np.cumsum(IN_SPLITS)[:-1])

kernel_name = "hybrid_swa_sink_hgrn2_gated_merge"


def rms_norm(x, gain):
    xf = x.astype(jnp.float32)
    y = xf * lax.rsqrt(jnp.mean(xf * xf, axis=-1, keepdims=True) + NORM_EPS)
    return (y * gain.astype(jnp.float32)).astype(x.dtype)


def rotary(x, positions):
    half = x.shape[-1] // 2
    inv_freq = ROPE_THETA ** (-jnp.arange(half, dtype=jnp.float32) / half)
    ang = positions.astype(jnp.float32)[..., None] * inv_freq
    cos = jnp.cos(ang)[:, :, None, :]
    sin = jnp.sin(ang)[:, :, None, :]
    xf = x.astype(jnp.float32)
    x1, x2 = xf[..., :half], xf[..., half:]
    return jnp.concatenate([x1 * cos - x2 * sin, x2 * cos + x1 * sin], axis=-1).astype(x.dtype)


def sliding_window_attention(q, k, v, sinks):
    B, T = q.shape[0], q.shape[1]
    nb = T // ATTN_BLOCK
    qb = q.reshape(B, nb, ATTN_BLOCK, ATTN_KV_HEADS, ATTN_GROUP, ATTN_HEAD_DIM)

    def with_prev(a):
        ab = a.reshape(B, nb, ATTN_BLOCK, ATTN_KV_HEADS, ATTN_HEAD_DIM)
        prev = jnp.pad(ab[:, :-1], ((0, 0), (1, 0), (0, 0), (0, 0), (0, 0)))
        return jnp.concatenate([prev, ab], axis=2)

    kb, vb = with_prev(k), with_prev(v)
    scores = jnp.einsum('bnqhgd,bnkhd->bnhgqk', qb, kb).astype(jnp.float32) * (ATTN_HEAD_DIM ** -0.5)
    q_pos = jnp.arange(ATTN_BLOCK)[:, None] + ATTN_BLOCK
    k_pos = jnp.arange(2 * ATTN_BLOCK)[None, :]
    rel = q_pos - k_pos
    band = (rel >= 0) & (rel < WINDOW)
    has_prev = (jnp.arange(nb) > 0)[:, None, None] | (k_pos >= ATTN_BLOCK)[None]
    mask = band[None] & has_prev
    scores = jnp.where(mask[None, :, None, None], scores, -jnp.inf)
    sink = jnp.broadcast_to(
        sinks.astype(jnp.float32).reshape(1, 1, ATTN_KV_HEADS, ATTN_GROUP, 1, 1),
        scores.shape[:-1] + (1,))
    probs = jax.nn.softmax(jnp.concatenate([scores, sink], axis=-1), axis=-1)[..., :-1]
    out = jnp.einsum('bnhgqk,bnkhd->bnqhgd', probs.astype(v.dtype), vb)
    return out.reshape(B, T, ATTN_WIDTH)


def hgrn2_chunked(q, k, v, log_f):
    B, T, H, dk = q.shape
    dv = v.shape[-1]
    nc = T // HGRN_CHUNK

    def to_chunks(a):
        return a.reshape(B, nc, HGRN_CHUNK, H, a.shape[-1]).transpose(1, 0, 2, 3, 4)

    qc, kc, vc = to_chunks(q), to_chunks(k), to_chunks(v)
    bc = jnp.cumsum(to_chunks(log_f), axis=2)
    causal = jnp.tril(jnp.ones((HGRN_CHUNK, HGRN_CHUNK), dtype=bool))[None, :, :, None, None]

    def step(S, inp):
        qt, kt, vt, bt = inp
        diff = bt[:, :, None] - bt[:, None, :]
        decay = jnp.exp(jnp.where(causal, diff, -jnp.inf))
        scores = jnp.einsum('bthd,bshd,btshd->bhts', qt, kt, decay)
        o_intra = jnp.einsum('bhts,bshv->bthv', scores, vt)
        o_inter = jnp.einsum('bthd,bhdv->bthv', qt * jnp.exp(bt), S)
        b_last = bt[:, -1]
        k_dec = kt * jnp.exp(b_last[:, None] - bt)
        S_new = jnp.exp(b_last)[..., None] * S + jnp.einsum('bshd,bshv->bhdv', k_dec, vt)
        return S_new, o_intra + o_inter

    S0 = jnp.zeros((B, H, dk, dv), dtype=jnp.float32)
    _, o = lax.scan(step, S0, (qc, kc, vc, bc))
    return o.transpose(1, 0, 2, 3, 4).reshape(B, T, H, dv)


def setup_inputs(seed: int = 0) -> dict:
    key = jax.random.key(seed)
    ks = jax.random.split(key, 11)
    f32 = jnp.float32
    x = jax.random.normal(ks[0], (BATCH, SEQ, D_MODEL), f32)
    positions = jnp.broadcast_to(jnp.arange(SEQ, dtype=jnp.int32), (BATCH, SEQ))
    norm_gain = 1.0 + 0.02 * jax.random.normal(ks[1], (DEPTH, D_MODEL), f32)
    w_in = jax.random.normal(ks[2], (DEPTH, D_MODEL, IN_WIDTH), f32) * D_MODEL ** -0.5
    attn_sinks = 0.5 * jax.random.normal(ks[3], (DEPTH, ATTN_HEADS), f32)
    hgrn_lower_bounds = 0.1 * jax.random.normal(ks[4], (DEPTH + 1, HGRN_FORGET_WIDTH), f32)
    hgrn_norm_gain = 1.0 + 0.02 * jax.random.normal(ks[5], (DEPTH, HGRN_HEADS, HGRN_VALUE_DIM), f32)
    w_attn_out = jax.random.normal(ks[6], (DEPTH, ATTN_WIDTH, D_MODEL), f32) * ATTN_WIDTH ** -0.5
    w_hgrn_out = jax.random.normal(ks[7], (DEPTH, HGRN_WIDTH, D_MODEL), f32) * HGRN_WIDTH ** -0.5
    w_o = jax.random.normal(ks[8], (DEPTH, D_MODEL, D_MODEL), f32) * D_MODEL ** -0.5
    final_norm_gain = 1.0 + 0.02 * jax.random.normal(ks[9], (D_MODEL,), f32)
    return {"x": x, "positions": positions, "norm_gain": norm_gain, "w_in": w_in,
            "attn_sinks": attn_sinks, "hgrn_lower_bounds": hgrn_lower_bounds,
            "hgrn_norm_gain": hgrn_norm_gain, "w_attn_out": w_attn_out,
            "w_hgrn_out": w_hgrn_out, "w_o": w_o, "final_norm_gain": final_norm_gain}


def reference(x, positions, norm_gain, w_in, attn_sinks, hgrn_lower_bounds, hgrn_norm_gain,
              w_attn_out, w_hgrn_out, w_o, final_norm_gain):
    B, T = x.shape[0], x.shape[1]
    lower_bounds = jnp.cumsum(jax.nn.softmax(hgrn_lower_bounds.astype(jnp.float32), axis=0), axis=0)
    for l in range(DEPTH):
        h = rms_norm(x, norm_gain[l])
        proj = h @ w_in[l]
        (aq, ak, av, a_gate, hq, hf, hi, h_gate, m_attn, m_hgrn) = jnp.split(proj, SPLIT_POINTS, axis=-1)

        aq = rotary(aq.reshape(B, T, ATTN_HEADS, ATTN_HEAD_DIM), positions)
        ak = rotary(ak.reshape(B, T, ATTN_KV_HEADS, ATTN_HEAD_DIM), positions)
        av = av.reshape(B, T, ATTN_KV_HEADS, ATTN_HEAD_DIM)
        attn = sliding_window_attention(aq, ak, av, attn_sinks[l])
        y_attn = (attn * jax.nn.silu(a_gate)) @ w_attn_out[l]

        lb = lower_bounds[l]
        hf32 = hf.astype(jnp.float32)
        forget = lb + (1.0 - lb) * jax.nn.sigmoid(hf32)
        log_f = jnp.log(forget)
        k_in = (1.0 - lb) * jax.nn.sigmoid(-hf32)
        q_r = jax.nn.silu(hq.astype(jnp.float32)) * (HGRN_KEY_DIM ** -0.5)
        heads_k = (B, T, HGRN_HEADS, HGRN_KEY_DIM)
        o = hgrn2_chunked(q_r.reshape(heads_k), k_in.reshape(heads_k),
                          hi.astype(jnp.float32).reshape(B, T, HGRN_HEADS, HGRN_VALUE_DIM),
                          log_f.reshape(heads_k))
        o = rms_norm(o, hgrn_norm_gain[l]).reshape(B, T, HGRN_WIDTH).astype(x.dtype)
        y_hgrn = (o * jax.nn.silu(h_gate)) @ w_hgrn_out[l]

        merged = jax.nn.sigmoid(m_attn) * y_attn + jax.nn.sigmoid(m_hgrn) * y_hgrn
        x = x + merged @ w_o[l]
    return rms_norm(x, final_norm_gain)
```

```cpp
#include <hip/hip_runtime.h>
#include <hip/hip_cooperative_groups.h>
#include <cstdio>
namespace cg = cooperative_groups;

#define LAS __attribute__((address_space(3)))
typedef unsigned short bf16_t;
typedef short bf16x8 __attribute__((ext_vector_type(8)));
typedef float f32x4 __attribute__((ext_vector_type(4)));
typedef float f32x2 __attribute__((ext_vector_type(2)));
typedef unsigned u32x4 __attribute__((ext_vector_type(4)));
typedef unsigned u32x2 __attribute__((ext_vector_type(2)));

constexpr int NB = 2, NT = 16384, NTOK = NB * NT, DM = 2048, INW = 10752;
constexpr int OQ = 0, OKK = 1024, OV = 1280, OAG = 1536, OHQ = 2560, OHF = 3584, OHI = 4608, OHG = 5632, OMA = 6656, OMH = 8704;
constexpr int NCHUNK = NT / 64;
constexpr int NHU = NB * 8 * NCHUNK;
constexpr int NAU = NB * (NT / 128) * 4;

constexpr size_t WS_HA = 0;
constexpr size_t WS_WIN = WS_HA + (size_t)NTOK * DM * 2;
constexpr size_t WS_WAO = WS_WIN + (size_t)INW * DM * 2;
constexpr size_t WS_WHO = WS_WAO + (size_t)DM * 1024 * 2;
constexpr size_t WS_WO = WS_WHO + (size_t)DM * 1024 * 2;
constexpr size_t WS_PROJ = WS_WO + (size_t)DM * DM * 2;
constexpr size_t WS_ROPE = WS_PROJ + (size_t)NTOK * INW * 2;
constexpr size_t WS_AATT = WS_ROPE + (size_t)NTOK * 32 * 8;
constexpr size_t WS_AHGR = WS_AATT + (size_t)NTOK * 1024 * 2;
constexpr size_t WS_DTOT = WS_AHGR + (size_t)NTOK * 1024 * 2;
constexpr size_t WS_RSS = WS_DTOT + (size_t)NHU * 128 * 4;
constexpr size_t WS_END = WS_RSS + (size_t)NTOK * 32 * 4;

struct Params {
    const float* x; const int* pos; const float* norm_gain; const float* w_in; const float* sinks; const float* lbt;
    const float* hgain; const float* w_ao; const float* w_ho; const float* w_o; const float* fgain;
    float* out; unsigned char* ws;
};

__constant__ float c_inv_freq[32] = {
    1.0f, 0.749894261f, 0.562341332f, 0.421696514f, 0.316227764f, 0.237137377f, 0.177827939f, 0.133352131f, 0.100000001f, 0.0749894157f,
    0.0562341325f, 0.0421696529f, 0.0316227749f, 0.0237137377f, 0.0177827943f, 0.0133352149f, 0.00999999978f, 0.00749894185f,
    0.00562341325f, 0.00421696482f, 0.00316227763f, 0.00237137359f, 0.00177827943f, 0.00133352145f, 0.00100000005f, 0.000749894243f,
    0.000562341302f, 0.000421696517f, 0.000316227757f, 0.00023713737f, 0.00017782794f, 0.00013335215f};

__device__ __forceinline__ float bf2f(bf16_t b) { return __uint_as_float(((unsigned)b) << 16); }
__device__ __forceinline__ float bflo(unsigned w) { return __uint_as_float(w << 16); }
__device__ __forceinline__ float bfhi(unsigned w) { return __uint_as_float(w & 0xffff0000u); }
__device__ __forceinline__ unsigned cvt_pk_bf16(float lo, float hi) { unsigned r; asm volatile("v_cvt_pk_bf16_f32 %0, %1, %2" : "=v"(r) : "v"(lo), "v"(hi)); return r; }
__device__ __forceinline__ float fast_rcp(float x) { return __builtin_amdgcn_rcpf(x); }
__device__ __forceinline__ float sigmoidf_(float v) { return fast_rcp(1.0f + __expf(-v)); }
__device__ __forceinline__ float wave_sum(float v) {
#pragma unroll
    for (int o = 32; o > 0; o >>= 1) v += __shfl_xor(v, o);
    return v;
}
__device__ __forceinline__ bf16x8 mk8(unsigned a, unsigned b, unsigned c, unsigned d) { u32x4 w; w.x = a; w.y = b; w.z = c; w.w = d; return __builtin_bit_cast(bf16x8, w); }

namespace pg8 {
constexpr int BM = 256, BK = 64, HALF = 128, HTB = HALF * BK * 2, STAGE_BYTES = 8 * HTB, NXCD = 8, WGM = 8;
__host__ __device__ __forceinline__ int lds_byte(int r, int c) { const int st = (r >> 4) * 2 + (c >> 5), rr = r & 15, cc = c & 31, ob = rr * 64 + cc * 2; return st * 1024 + (ob ^ (((ob >> 9) & 1) << 5)); }
__host__ __device__ __forceinline__ void stage_rc(int b, int& R, int& C) { const int st = b / 1024, sb = b % 1024, swz = sb ^ (((sb >> 9) & 1) << 5); R = (st >> 1) * 16 + swz / 64; C = (st & 1) * 32 + (swz % 64) / 2; }
__host__ __device__ __forceinline__ int perm32(int rho) { const int n = rho >> 4, i = rho & 15; return 8 * (i >> 2) + 4 * n + (i & 3); }

struct Unit { int pm, pn, kind; };
struct Gemm { const bf16_t* A0; const bf16_t* B0; const bf16_t* A1; const bf16_t* B1; int M, N, K; };

struct StaticOrder {
    int nM, nN, nwg, G, c, dual;
    __device__ void init(int M, int N, int G_, int c_, int dual_) { nM = M / BM; nN = N / BM; nwg = nM * nN; G = G_; c = c_; dual = dual_; }
    __device__ bool next(int i, Unit& u) const {
        const int it = i >> dual;
        const long L = (long)it * G + c; if (L >= nwg) return false;
        int wgid = (int)L; { const int q = nwg / NXCD, r = nwg % NXCD, xcd = wgid % NXCD, off = wgid / NXCD; wgid = (xcd < r ? xcd * (q + 1) : r * (q + 1) + (xcd - r) * q) + off; }
        const int nig = WGM * nN, gid = wgid / nig, fm = gid * WGM, gsz = (nM - fm) < WGM ? (nM - fm) : WGM;
        u.pm = fm + ((wgid % nig) % gsz); u.pn = (wgid % nig) / gsz; u.kind = i & dual; return true;
    }
};

template <class Epi>
__device__ __forceinline__ void gemm_phase(LAS unsigned char* lds, const Gemm g, const StaticOrder& S, const Epi& E) {
    const int tid = threadIdx.x, wid = __builtin_amdgcn_readfirstlane(tid >> 6), lane = tid & 63, wr = wid >> 2, wc = wid & 3, fr = lane & 15, fq = lane >> 4;
    const int K = g.K, nt = K / BK;
    unsigned voffA[2], voffB[2];
#pragma unroll
    for (int i = 0; i < 2; ++i) { int R, C; stage_rc(tid * 16 + i * 8192, R, C); const int Rb = Epi::PERM ? ((R & ~31) + perm32(R & 31)) : R;
        voffA[i] = (unsigned)(R * K + C) * 2u; voffB[i] = (unsigned)(Rb * K + C) * 2u; }
    const size_t kstep = (size_t)(BK * 2);
    const size_t hstep = (size_t)HALF * K * 2;
    const size_t tstep = 2 * hstep;
    const unsigned ldsw = (unsigned)wid * 1024u;
    const int aoff = lds_byte(wr * 64 + fr, fq * 8), boff = lds_byte(wc * 32 + fr, fq * 8);
#define PG8_SA(b, h) (((b) * 2 + (h)) * HTB)
#define PG8_SB(b, h) ((4 + (b) * 2 + (h)) * HTB)
#define PG8_STAGE(bufoff, gbase, voff) do { _Pragma("unroll") for (int _i = 0; _i < 2; ++_i) \
        __builtin_amdgcn_global_load_lds((const unsigned*)((const char*)(gbase) + (voff)[_i]), (LAS unsigned*)(lds + (bufoff) + ldsw + _i * 8192), 16, 0, 0); } while (0)
#define PG8_LDA(dst, b, h) do { _Pragma("unroll") for (int m = 0; m < 4; ++m) _Pragma("unroll") for (int k = 0; k < 2; ++k) dst[m][k] = *(const LAS bf16x8*)(lds + PG8_SA(b, h) + aoff + m * 2048 + k * 1024); } while (0)
#define PG8_LDB(dst, b, h) do { _Pragma("unroll") for (int n = 0; n < 2; ++n) _Pragma("unroll") for (int k = 0; k < 2; ++k) dst[n][k] = *(const LAS bf16x8*)(lds + PG8_SB(b, h) + boff + n * 2048 + k * 1024); } while (0)
#define PG8_MMA(ai, bj, At, Bt) do { __builtin_amdgcn_s_setprio(1); _Pragma("unroll") for (int m = 0; m < 4; ++m) _Pragma("unroll") for (int n = 0; n < 2; ++n) _Pragma("unroll") for (int k = 0; k < 2; ++k) \
        acc[ai][bj][m][n] = __builtin_amdgcn_mfma_f32_16x16x32_bf16(Bt[n][k], At[m][k], acc[ai][bj][m][n], 0, 0, 0); __builtin_amdgcn_s_setprio(0); } while (0)
#define PG8_WAIT_V(n) asm volatile("s_waitcnt vmcnt(" #n ")" ::: "memory")
#define PG8_WAIT_L(n) asm volatile("s_waitcnt lgkmcnt(" #n ")" ::: "memory")
#define PG8_BAR __builtin_amdgcn_s_barrier()
#define PG8_SCHED __builtin_amdgcn_sched_barrier(0)
    Unit cur, nxt; int ui = 0;
    if (!S.next(0, cur)) return;
    f32x4 acc[2][2][4][2];
#pragma unroll
    for (int a = 0; a < 2; ++a)
#pragma unroll
        for (int b = 0; b < 2; ++b)
#pragma unroll
            for (int m = 0; m < 4; ++m)
#pragma unroll
                for (int n = 0; n < 2; ++n) acc[a][b][m][n] = (f32x4){0.f, 0.f, 0.f, 0.f};
    bf16x8 At[4][2], B0[2][2], B1[2][2];
    const char* cA = (const char*)(cur.kind ? g.A1 : g.A0) + (size_t)cur.pm * tstep; const char* cB = (const char*)(cur.kind ? g.B1 : g.B0) + (size_t)cur.pn * tstep;
    PG8_STAGE(PG8_SB(0, 0), cB, voffB); PG8_STAGE(PG8_SA(0, 0), cA, voffA); PG8_STAGE(PG8_SB(0, 1), cB + hstep, voffB); PG8_STAGE(PG8_SA(0, 1), cA + hstep, voffA);
    if (wr == 1) PG8_BAR;
    PG8_WAIT_V(4); PG8_BAR;
    PG8_STAGE(PG8_SB(1, 0), cB + kstep, voffB); PG8_STAGE(PG8_SA(1, 0), cA + kstep, voffA); PG8_STAGE(PG8_SB(1, 1), cB + hstep + kstep, voffB);
    PG8_WAIT_V(6); PG8_BAR;
    for (;;) {
        const bool has_next = S.next(ui + 1, nxt);
        const char* nA = has_next ? (const char*)(nxt.kind ? g.A1 : g.A0) + (size_t)nxt.pm * tstep : cA; const char* nB = has_next ? (const char*)(nxt.kind ? g.B1 : g.B0) + (size_t)nxt.pn * tstep : cB;
        for (int t = 0; t < nt; t += 2) {
            const bool last = (t == nt - 2);
            const char* a1 = cA + (size_t)(t + 1) * kstep;
            const char* a2 = last ? nA : cA + (size_t)(t + 2) * kstep; const char* b2 = last ? nB : cB + (size_t)(t + 2) * kstep;
            const char* a3 = a2 + kstep; const char* b3 = b2 + kstep;
            PG8_LDB(B0, 0, 0); PG8_SCHED; PG8_LDA(At, 0, 0); PG8_STAGE(PG8_SA(1, 1), a1 + hstep, voffA);
            PG8_WAIT_L(8); PG8_BAR; PG8_WAIT_L(0); PG8_MMA(0, 0, At, B0); PG8_BAR; PG8_SCHED;
            PG8_LDB(B1, 0, 1); PG8_STAGE(PG8_SB(0, 0), b2, voffB);
            PG8_BAR; PG8_WAIT_L(0); PG8_MMA(0, 1, At, B1); PG8_BAR;
            PG8_LDA(At, 0, 1); PG8_STAGE(PG8_SA(0, 0), a2, voffA);
            PG8_BAR; PG8_WAIT_L(0); PG8_MMA(1, 0, At, B0); PG8_BAR; PG8_SCHED;
            PG8_STAGE(PG8_SB(0, 1), b2 + hstep, voffB);
            PG8_WAIT_V(6); PG8_BAR; PG8_MMA(1, 1, At, B1); PG8_BAR;
            PG8_LDB(B0, 1, 0); PG8_SCHED; PG8_LDA(At, 1, 0); PG8_STAGE(PG8_SA(0, 1), a2 + hstep, voffA);
            PG8_WAIT_L(8); PG8_BAR; PG8_WAIT_L(0); PG8_MMA(0, 0, At, B0); PG8_BAR; PG8_SCHED;
            PG8_LDB(B1, 1, 1); PG8_STAGE(PG8_SB(1, 0), b3, voffB);
            PG8_BAR; PG8_WAIT_L(0); PG8_MMA(0, 1, At, B1); PG8_BAR;
            PG8_LDA(At, 1, 1); PG8_STAGE(PG8_SA(1, 0), a3, voffA);
            PG8_BAR; PG8_WAIT_L(0); PG8_MMA(1, 0, At, B0); PG8_BAR; PG8_SCHED;
            PG8_STAGE(PG8_SB(1, 1), b3 + hstep, voffB);
            PG8_WAIT_V(6); PG8_BAR; PG8_MMA(1, 1, At, B1); PG8_BAR;
        }
        const bool keep = E(acc, cur, wr, wc, fr, fq);
        if (!has_next) break;
        if (!keep) {
#pragma unroll
            for (int a = 0; a < 2; ++a)
#pragma unroll
                for (int b = 0; b < 2; ++b)
#pragma unroll
                    for (int m = 0; m < 4; ++m)
#pragma unroll
                        for (int n = 0; n < 2; ++n) acc[a][b][m][n] = (f32x4){0.f, 0.f, 0.f, 0.f};
        }
        cur = nxt; cA = nA; cB = nB; ++ui;
    }
    PG8_WAIT_V(0);
    if (wr == 0) PG8_BAR;
    PG8_BAR;
#undef PG8_SA
#undef PG8_SB
#undef PG8_STAGE
#undef PG8_LDA
#undef PG8_LDB
#undef PG8_MMA
#undef PG8_WAIT_V
#undef PG8_WAIT_L
#undef PG8_BAR
#undef PG8_SCHED
}
}

struct EpiProj {
    static constexpr bool PERM = true;
    bf16_t* O;
    __device__ __forceinline__ bool operator()(f32x4 (&acc)[2][2][4][2], const pg8::Unit& u, int wr, int wc, int fr, int fq) const {
        const int pn = u.pn;
        int mode = 0; float scale = 1.0f;
        if ((pn >= 6 && pn < 10) || (pn >= 22 && pn < 26)) mode = 1;
        else if (pn >= 10 && pn < 14) { mode = 1; scale = 0.08838834764831845f; }
        else if (pn >= 26) mode = 2;
        const int row0 = u.pm * 256 + wr * 64 + fr, col0 = pn * 256 + wc * 32 + 8 * fq;
#pragma unroll
        for (int ai = 0; ai < 2; ++ai)
#pragma unroll
            for (int m = 0; m < 4; ++m) { bf16_t* rowp = O + (size_t)(row0 + ai * 128 + m * 16) * INW + col0;
#pragma unroll
                for (int bj = 0; bj < 2; ++bj) { f32x4 v0 = acc[ai][bj][m][0], v1 = acc[ai][bj][m][1];
                    if (mode != 0) {
#pragma unroll
                        for (int j = 0; j < 4; ++j) { const float s0 = sigmoidf_(v0[j]), s1 = sigmoidf_(v1[j]);
                            v0[j] = (mode == 1) ? v0[j] * s0 * scale : s0; v1[j] = (mode == 1) ? v1[j] * s1 * scale : s1; }
                    }
                    u32x4 w; w.x = cvt_pk_bf16(v0[0], v0[1]); w.y = cvt_pk_bf16(v0[2], v0[3]); w.z = cvt_pk_bf16(v1[0], v1[1]); w.w = cvt_pk_bf16(v1[2], v1[3]);
                    *(u32x4*)(rowp + bj * 128) = w; } }
        return false;
    }
};
struct EpiMerge {
    static constexpr bool PERM = true;
    const bf16_t* proj; bf16_t* O;
    __device__ __forceinline__ bool operator()(f32x4 (&acc)[2][2][4][2], const pg8::Unit& u, int wr, int wc, int fr, int fq) const {
        const int row0 = u.pm * 256 + wr * 64 + fr, col0 = u.pn * 256 + wc * 32 + 8 * fq;
#pragma unroll
        for (int ai = 0; ai < 2; ++ai)
#pragma unroll
            for (int m = 0; m < 4; ++m) { const size_t r = (size_t)(row0 + ai * 128 + m * 16);
#pragma unroll
                for (int bj = 0; bj < 2; ++bj) { const int c = col0 + bj * 128;
                    const u32x4 g2 = *(const u32x4*)(proj + r * INW + OMH + c);
                    float s2[8] = {bflo(g2.x), bfhi(g2.x), bflo(g2.y), bfhi(g2.y), bflo(g2.z), bfhi(g2.z), bflo(g2.w), bfhi(g2.w)};
                    if (u.kind == 0) {
                        const u32x4 g1 = *(const u32x4*)(proj + r * INW + OMA + c);
                        float s1[8] = {bflo(g1.x), bfhi(g1.x), bflo(g1.y), bfhi(g1.y), bflo(g1.z), bfhi(g1.z), bflo(g1.w), bfhi(g1.w)};
#pragma unroll
                        for (int j = 0; j < 4; ++j) { acc[ai][bj][m][0][j] *= s1[j] * fast_rcp(fmaxf(s2[j], 1e-20f)); acc[ai][bj][m][1][j] *= s1[4 + j] * fast_rcp(fmaxf(s2[4 + j], 1e-20f)); }
                    } else {
                        const f32x4 v0 = acc[ai][bj][m][0], v1 = acc[ai][bj][m][1];
                        u32x4 w; w.x = cvt_pk_bf16(v0[0] * s2[0], v0[1] * s2[1]); w.y = cvt_pk_bf16(v0[2] * s2[2], v0[3] * s2[3]);
                        w.z = cvt_pk_bf16(v1[0] * s2[4], v1[1] * s2[5]); w.w = cvt_pk_bf16(v1[2] * s2[6], v1[3] * s2[7]);
                        *(u32x4*)(O + r * DM + c) = w;
                    } } }
        return u.kind == 0;
    }
};
struct EpiResid {
    static constexpr bool PERM = false;
    const float* X; float* O; float* rss;
    __device__ __forceinline__ bool operator()(f32x4 (&acc)[2][2][4][2], const pg8::Unit& u, int wr, int wc, int fr, int fq) const {
        const int row0 = u.pm * 256 + wr * 64 + fr, col0 = u.pn * 256 + wc * 32 + 4 * fq;
#pragma unroll
        for (int ai = 0; ai < 2; ++ai)
#pragma unroll
            for (int m = 0; m < 4; ++m) { const size_t r = (size_t)(row0 + ai * 128 + m * 16); float ss = 0.f;
#pragma unroll
                for (int bj = 0; bj < 2; ++bj)
#pragma unroll
                    for (int n = 0; n < 2; ++n) { const size_t o = r * DM + col0 + bj * 128 + n * 16;
                        f32x4 v = *(const f32x4*)(X + o) + acc[ai][bj][m][n];
                        ss += v[0] * v[0] + v[1] * v[1] + v[2] * v[2] + v[3] * v[3];
                        *(f32x4*)(O + o) = v; }
                ss += __shfl_xor(ss, 16); ss += __shfl_xor(ss, 32);
                if (fq == 0) rss[r * 32 + u.pn * 4 + wc] = ss; }
        return false;
    }
};

__device__ __forceinline__ void transpose_tile(const float* __restrict__ W, int K, int N, bf16_t* __restrict__ WT, int tile, float* tl  ) {
    const int ntn = N >> 6; const int k0 = (tile / ntn) * 64, n0 = (tile % ntn) * 64; const int tid = threadIdx.x;
    { const int k = tid >> 3, c = (tid & 7) * 8; const float* src = W + (size_t)(k0 + k) * N + n0 + c;
      const f32x4 a = *(const f32x4*)src, b = *(const f32x4*)(src + 4); float* d = tl + k * 65 + c;
      d[0] = a[0]; d[1] = a[1]; d[2] = a[2]; d[3] = a[3]; d[4] = b[0]; d[5] = b[1]; d[6] = b[2]; d[7] = b[3]; }
    __syncthreads();
    { const int n = tid >> 3, kc = (tid & 7) * 8; const float* s = tl + kc * 65 + n;
      u32x4 w; w.x = cvt_pk_bf16(s[0], s[65]); w.y = cvt_pk_bf16(s[130], s[195]); w.z = cvt_pk_bf16(s[260], s[325]); w.w = cvt_pk_bf16(s[390], s[455]);
      *(u32x4*)(WT + (size_t)(n0 + n) * K + k0 + kc) = w; }
    __syncthreads();
}

__device__ __forceinline__ void phase_prep(const Params& p, unsigned char* shm) {
    const int tid = threadIdx.x, wid = tid >> 6, lane = tid & 63;
    bf16_t* hA = (bf16_t*)(p.ws + WS_HA);
    for (int r = blockIdx.x * 8 + wid; r < NTOK; r += gridDim.x * 8) {
        const f32x4* xr = (const f32x4*)(p.x + (size_t)r * DM);
        f32x4 v[8]; float ss = 0.f;
#pragma unroll
        for (int i = 0; i < 8; ++i) { v[i] = xr[lane + 64 * i]; ss += v[i][0] * v[i][0] + v[i][1] * v[i][1] + v[i][2] * v[i][2] + v[i][3] * v[i][3]; }
        ss = wave_sum(ss);
        const float rstd = rsqrtf(ss * (1.0f / DM) + 1e-6f);
#pragma unroll
        for (int i = 0; i < 8; ++i) { const f32x4 g = ((const f32x4*)p.norm_gain)[lane + 64 * i];
            u32x2 w; w.x = cvt_pk_bf16(v[i][0] * rstd * g[0], v[i][1] * rstd * g[1]); w.y = cvt_pk_bf16(v[i][2] * rstd * g[2], v[i][3] * rstd * g[3]);
            *(u32x2*)(hA + (size_t)r * DM + (lane + 64 * i) * 4) = w; }
    }
    float* tl = (float*)shm;
    constexpr int T_IN = (DM / 64) * (INW / 64), T_AO = (1024 / 64) * (DM / 64), T_WO = (DM / 64) * (DM / 64);
    for (int t = blockIdx.x; t < T_IN + 2 * T_AO + T_WO; t += gridDim.x) {
        if (t < T_IN) transpose_tile(p.w_in, DM, INW, (bf16_t*)(p.ws + WS_WIN), t, tl);
        else if (t < T_IN + T_AO) transpose_tile(p.w_ao, 1024, DM, (bf16_t*)(p.ws + WS_WAO), t - T_IN, tl);
        else if (t < T_IN + 2 * T_AO) transpose_tile(p.w_ho, 1024, DM, (bf16_t*)(p.ws + WS_WHO), t - T_IN - T_AO, tl);
        else transpose_tile(p.w_o, DM, DM, (bf16_t*)(p.ws + WS_WO), t - T_IN - 2 * T_AO, tl);
    }
    f32x2* rope = (f32x2*)(p.ws + WS_ROPE);
    for (int idx = blockIdx.x * 512 + tid; idx < NTOK * 32; idx += gridDim.x * 512) {
        const int tok = idx >> 5, i = idx & 31;
        const float ang = (float)p.pos[tok] * c_inv_freq[i];
        const double a = (double)ang; const double kq = rint(a * 0.63661977236758134308);
        const double r = fma(-kq, 1.5707963267948966192, a) - kq * 6.123233995736766e-17;
        const double r2 = r * r;
        double sn = r2 * (-1.0 / 39916800.0) + (1.0 / 362880.0); sn = sn * r2 - (1.0 / 5040.0); sn = sn * r2 + (1.0 / 120.0); sn = sn * r2 - (1.0 / 6.0); sn = sn * r2 * r + r;
        double cs = r2 * (1.0 / 479001600.0) - (1.0 / 3628800.0); cs = cs * r2 + (1.0 / 40320.0); cs = cs * r2 - (1.0 / 720.0); cs = cs * r2 + (1.0 / 24.0); cs = cs * r2 - 0.5; cs = cs * r2 + 1.0;
        const int q = ((int)(long long)kq) & 3;
        const double c_ = (q == 0) ? cs : (q == 1) ? -sn : (q == 2) ? -cs : sn;
        const double s_ = (q == 0) ? sn : (q == 1) ? cs : (q == 2) ? -sn : -cs;
        f32x2 o; o.x = (float)c_; o.y = (float)s_; rope[idx] = o;
    }
}

constexpr int KS_STRIDE = 72;
constexpr int VT_STRIDE = 264;
__device__ __forceinline__ void attn_unit(const Params& p, unsigned char* shm, int unit) {
    const bf16_t* proj = (const bf16_t*)(p.ws + WS_PROJ);
    const f32x2* rope = (const f32x2*)(p.ws + WS_ROPE);
    bf16_t* Aatt = (bf16_t*)(p.ws + WS_AATT);
    bf16_t* Ks = (bf16_t*)shm;
    bf16_t* Vt = (bf16_t*)(shm + 256 * KS_STRIDE * 2);
    const int tid = threadIdx.x, wid = tid >> 6, lane = tid & 63, fr = lane & 15, fq = lane >> 4;
    const int kvh = unit & 3, blk = unit >> 2, n = blk & 127, b = blk >> 7;
    const int tq0 = b * NT + n * 128;
    const int tk0 = tq0 - 128;
    {
        const int key = tid & 255, hc = tid >> 8; const bool valid = (n > 0) || (key >= 128);
        u32x4 o1a = {0, 0, 0, 0}, o1b = {0, 0, 0, 0}, o2a = {0, 0, 0, 0}, o2b = {0, 0, 0, 0};
        if (valid) {
            const size_t tok = (size_t)(tk0 + key);
            const bf16_t* kp = proj + tok * INW + OKK + kvh * 64 + hc * 16;
            const u32x4 x1a = *(const u32x4*)kp, x1b = *(const u32x4*)(kp + 8), x2a = *(const u32x4*)(kp + 32), x2b = *(const u32x4*)(kp + 40);
            const f32x4* rp = (const f32x4*)(rope + tok * 32 + hc * 16);
            unsigned x1[8] = {x1a.x, x1a.y, x1a.z, x1a.w, x1b.x, x1b.y, x1b.z, x1b.w};
            unsigned x2[8] = {x2a.x, x2a.y, x2a.z, x2a.w, x2b.x, x2b.y, x2b.z, x2b.w};
            unsigned r1[8], r2[8];
#pragma unroll
            for (int i = 0; i < 8; ++i) { const f32x4 cs = rp[i];
                const float a0 = bflo(x1[i]), a1 = bfhi(x1[i]), b0 = bflo(x2[i]), b1 = bfhi(x2[i]);
                r1[i] = cvt_pk_bf16(a0 * cs[0] - b0 * cs[1], a1 * cs[2] - b1 * cs[3]);
                r2[i] = cvt_pk_bf16(b0 * cs[0] + a0 * cs[1], b1 * cs[2] + a1 * cs[3]); }
            o1a = (u32x4){r1[0], r1[1], r1[2], r1[3]}; o1b = (u32x4){r1[4], r1[5], r1[6], r1[7]};
            o2a = (u32x4){r2[0], r2[1], r2[2], r2[3]}; o2b = (u32x4){r2[4], r2[5], r2[6], r2[7]};
        }
        bf16_t* kd = Ks + key * KS_STRIDE + hc * 16;
        *(u32x4*)kd = o1a; *(u32x4*)(kd + 8) = o1b; *(u32x4*)(kd + 32) = o2a; *(u32x4*)(kd + 40) = o2b;
    }
    {
        const int kp = tid & 127, dc = tid >> 7; const bool valid = (n > 0) || (kp >= 64);
        u32x4 va0 = {0, 0, 0, 0}, va1 = {0, 0, 0, 0}, vb0 = {0, 0, 0, 0}, vb1 = {0, 0, 0, 0};
        if (valid) {
            const bf16_t* vp = proj + (size_t)(tk0 + 2 * kp) * INW + OV + kvh * 64 + dc * 16;
            va0 = *(const u32x4*)vp; va1 = *(const u32x4*)(vp + 8); vb0 = *(const u32x4*)(vp + INW); vb1 = *(const u32x4*)(vp + INW + 8);
        }
        const unsigned a[8] = {va0.x, va0.y, va0.z, va0.w, va1.x, va1.y, va1.z, va1.w};
        const unsigned c[8] = {vb0.x, vb0.y, vb0.z, vb0.w, vb1.x, vb1.y, vb1.z, vb1.w};
        unsigned* vd = (unsigned*)(Vt + (dc * 16) * VT_STRIDE + 2 * kp);
#pragma unroll
        for (int i = 0; i < 8; ++i) {
            vd[(2 * i) * (VT_STRIDE / 2)] = (a[i] & 0xffffu) | (c[i] << 16);
            vd[(2 * i + 1) * (VT_STRIDE / 2)] = (a[i] >> 16) | (c[i] & 0xffff0000u);
        }
    }
    __syncthreads();
    const int g = wid >> 1, hq = kvh * 4 + g;
    const float sink = p.sinks[hq];
    for (int qi = 0; qi < 4; ++qi) {
        const int qt = (wid & 1) * 4 + qi, iq = qt * 16 + fr; const size_t tq = (size_t)(tq0 + iq);
        bf16x8 qf0, qf1;
        {
            const bf16_t* qp = proj + tq * INW + OQ + hq * 64 + fq * 8;
            const u32x4 x1 = *(const u32x4*)qp, x2 = *(const u32x4*)(qp + 32);
            const f32x4* rp = (const f32x4*)(rope + tq * 32 + fq * 8);
            const unsigned a[4] = {x1.x, x1.y, x1.z, x1.w}, c[4] = {x2.x, x2.y, x2.z, x2.w}; unsigned r1[4], r2[4];
#pragma unroll
            for (int i = 0; i < 4; ++i) { const f32x4 cs = rp[i];
                const float a0 = bflo(a[i]) * 0.125f, a1 = bfhi(a[i]) * 0.125f, b0 = bflo(c[i]) * 0.125f, b1 = bfhi(c[i]) * 0.125f;
                r1[i] = cvt_pk_bf16(a0 * cs[0] - b0 * cs[1], a1 * cs[2] - b1 * cs[3]);
                r2[i] = cvt_pk_bf16(b0 * cs[0] + a0 * cs[1], b1 * cs[2] + a1 * cs[3]); }
            qf0 = mk8(r1[0], r1[1], r1[2], r1[3]); qf1 = mk8(r2[0], r2[1], r2[2], r2[3]);
        }
        f32x4 s[9];
#pragma unroll
        for (int k9 = 0; k9 < 9; ++k9) {
            const bf16_t* kr = Ks + ((qt + k9) * 16 + fr) * KS_STRIDE + fq * 8;
            const bf16x8 a0 = *(const bf16x8*)kr, a1 = *(const bf16x8*)(kr + 32);
            f32x4 z = {0.f, 0.f, 0.f, 0.f};
            z = __builtin_amdgcn_mfma_f32_16x16x32_bf16(a0, qf0, z, 0, 0, 0);
            s[k9] = __builtin_amdgcn_mfma_f32_16x16x32_bf16(a1, qf1, z, 0, 0, 0);
        }
        float mx = sink;
#pragma unroll
        for (int k9 = 0; k9 < 9; ++k9)
#pragma unroll
            for (int j = 0; j < 4; ++j) { const int jw = (qt + k9) * 16 + fq * 4 + j;
                const bool vis = (jw > iq) && (jw <= iq + 128) && (n > 0 || jw >= 128);
                s[k9][j] = vis ? s[k9][j] : -INFINITY; mx = fmaxf(mx, s[k9][j]); }
        mx = fmaxf(mx, __shfl_xor(mx, 16)); mx = fmaxf(mx, __shfl_xor(mx, 32));
        float l = 0.f;
#pragma unroll
        for (int k9 = 0; k9 < 9; ++k9)
#pragma unroll
            for (int j = 0; j < 4; ++j) { const float e = __expf(s[k9][j] - mx); s[k9][j] = e; l += e; }
        l += __shfl_xor(l, 16); l += __shfl_xor(l, 32);
        l += __expf(sink - mx);
        const float inv_l = 1.0f / l;
        bf16x8 pf[5];
#pragma unroll
        for (int pp = 0; pp < 4; ++pp) pf[pp] = mk8(cvt_pk_bf16(s[2 * pp][0], s[2 * pp][1]), cvt_pk_bf16(s[2 * pp][2], s[2 * pp][3]), cvt_pk_bf16(s[2 * pp + 1][0], s[2 * pp + 1][1]), cvt_pk_bf16(s[2 * pp + 1][2], s[2 * pp + 1][3]));
        pf[4] = mk8(cvt_pk_bf16(s[8][0], s[8][1]), cvt_pk_bf16(s[8][2], s[8][3]), 0u, 0u);
        f32x4 o[4];
#pragma unroll
        for (int nt = 0; nt < 4; ++nt) { o[nt] = (f32x4){0.f, 0.f, 0.f, 0.f};
            const bf16_t* vr = Vt + (nt * 16 + fr) * VT_STRIDE + fq * 4;
#pragma unroll
            for (int pp = 0; pp < 5; ++pp) { const int kta = qt + 2 * pp, ktb = (kta + 1 > 15) ? 15 : kta + 1;
                const u32x2 lo = *(const u32x2*)(vr + kta * 16), hi = *(const u32x2*)(vr + ktb * 16);
                o[nt] = __builtin_amdgcn_mfma_f32_16x16x32_bf16(mk8(lo.x, lo.y, hi.x, hi.y), pf[pp], o[nt], 0, 0, 0); } }
#pragma unroll
        for (int nt = 0; nt < 4; ++nt) { const int col = hq * 64 + nt * 16 + fq * 4;
            const u32x2 gt = *(const u32x2*)(proj + tq * INW + OAG + col);
            u32x2 w; w.x = cvt_pk_bf16(o[nt][0] * inv_l * bflo(gt.x), o[nt][1] * inv_l * bfhi(gt.x)); w.y = cvt_pk_bf16(o[nt][2] * inv_l * bflo(gt.y), o[nt][3] * inv_l * bfhi(gt.y));
            *(u32x2*)(Aatt + tq * 1024 + col) = w; }
    }
    __syncthreads();
}

constexpr int H_STRIDE64 = 72;
constexpr int H_STRIDE128 = 136;
struct HgrnCol { float lf_prefix[16]; float kk[16]; };
__device__ __forceinline__ void hgrn_gates(const Params& p, const bf16_t* proj, size_t r0, int h, int d, int seg, float (&bp)[16], float (&kk)[16]) {
    const int col = h * 128 + d;
    const float a0 = p.lbt[col], a1 = p.lbt[1024 + col];
    const float lb = fast_rcp(1.0f + __expf(a1 - a0));
    float run = 0.f;
#pragma unroll
    for (int i = 0; i < 16; ++i) {
        const float hf = bf2f(proj[(r0 + seg * 16 + i) * INW + OHF + col]);
        const float e = __expf(-hf), inv = fast_rcp(1.0f + e);
        const float f = lb + (1.0f - lb) * inv;
        kk[i] = (1.0f - lb) * e * inv;
        run += __logf(f); bp[i] = run;
    }
}

__device__ __forceinline__ void hgrn_local_unit(const Params& p, unsigned char* shm, int u) {
    const bf16_t* proj = (const bf16_t*)(p.ws + WS_PROJ);
    float* UT = p.out + (size_t)u * 16384; float* dtot = (float*)(p.ws + WS_DTOT) + (size_t)u * 128;
    bf16_t* KdT = (bf16_t*)shm;
    bf16_t* Vt = (bf16_t*)(shm + 128 * H_STRIDE64 * 2);
    float* segsum = (float*)(shm + 2 * 128 * H_STRIDE64 * 2);
    const int tid = threadIdx.x, wid = tid >> 6, lane = tid & 63, fr = lane & 15, fq = lane >> 4;
    const int c = u & 255, sq = u >> 8, h = sq & 7, b = sq >> 3; const size_t r0 = (size_t)b * NT + (size_t)c * 64;
    const int d = tid & 127, seg = tid >> 7;
    float bp[16], kk[16];
    hgrn_gates(p, proj, r0, h, d, seg, bp, kk);
    segsum[seg * 128 + d] = bp[15];
    { unsigned w[8];
#pragma unroll
      for (int i = 0; i < 8; ++i) { const unsigned lo = proj[(r0 + seg * 16 + 2 * i) * INW + OHI + h * 128 + d], hi = proj[(r0 + seg * 16 + 2 * i + 1) * INW + OHI + h * 128 + d]; w[i] = lo | (hi << 16); }
      bf16_t* vd = Vt + d * H_STRIDE64 + seg * 16; *(u32x4*)vd = (u32x4){w[0], w[1], w[2], w[3]}; *(u32x4*)(vd + 8) = (u32x4){w[4], w[5], w[6], w[7]}; }
    __syncthreads();
    float off = 0.f, btot = 0.f;
#pragma unroll
    for (int s2 = 0; s2 < 4; ++s2) { const float v = segsum[s2 * 128 + d]; btot += v; if (s2 < seg) off += v; }
    { unsigned w[8];
#pragma unroll
      for (int i = 0; i < 8; ++i) { const float k0 = kk[2 * i] * __expf(btot - (off + bp[2 * i])), k1 = kk[2 * i + 1] * __expf(btot - (off + bp[2 * i + 1])); w[i] = cvt_pk_bf16(k0, k1); }
      bf16_t* kd = KdT + d * H_STRIDE64 + seg * 16; *(u32x4*)kd = (u32x4){w[0], w[1], w[2], w[3]}; *(u32x4*)(kd + 8) = (u32x4){w[4], w[5], w[6], w[7]}; }
    if (seg == 0) dtot[d] = __expf(btot);
    __syncthreads();
    f32x4 acc[8];
#pragma unroll
    for (int vt = 0; vt < 8; ++vt) acc[vt] = (f32x4){0.f, 0.f, 0.f, 0.f};
#pragma unroll
    for (int ks = 0; ks < 2; ++ks) { const bf16x8 a = *(const bf16x8*)(KdT + (16 * wid + fr) * H_STRIDE64 + ks * 32 + fq * 8);
#pragma unroll
        for (int vt = 0; vt < 8; ++vt) { const bf16x8 bv = *(const bf16x8*)(Vt + (16 * vt + fr) * H_STRIDE64 + ks * 32 + fq * 8);
            acc[vt] = __builtin_amdgcn_mfma_f32_16x16x32_bf16(a, bv, acc[vt], 0, 0, 0); } }
#pragma unroll
    for (int vt = 0; vt < 8; ++vt) *(f32x4*)(UT + (size_t)(16 * vt + fr) * 128 + 16 * wid + fq * 4) = acc[vt];
    __syncthreads();
}

__device__ __forceinline__ void hgrn_scan(const Params& p) {
    const float* dtot = (const float*)(p.ws + WS_DTOT);
    for (int gidx = blockIdx.x * 512 + threadIdx.x; gidx < 16 * 8192; gidx += gridDim.x * 512) {
        const int sq = gidx >> 13, e = (gidx & 8191) * 2, d = e & 127;
        float* base = p.out + (size_t)sq * 256 * 16384 + e; const float* db = dtot + (size_t)sq * 256 * 128 + d;
        f32x2 S = {0.f, 0.f};
        for (int c0 = 0; c0 < 256; c0 += 8) {
            f32x2 U[8], D[8];
#pragma unroll
            for (int i = 0; i < 8; ++i) { U[i] = *(const f32x2*)(base + (size_t)(c0 + i) * 16384); D[i] = *(const f32x2*)(db + (size_t)(c0 + i) * 128); }
#pragma unroll
            for (int i = 0; i < 8; ++i) { *(f32x2*)(base + (size_t)(c0 + i) * 16384) = S; S = D[i] * S + U[i]; }
        }
    }
}

__device__ __forceinline__ void hgrn_out_unit(const Params& p, unsigned char* shm, int u) {
    const bf16_t* proj = (const bf16_t*)(p.ws + WS_PROJ);
    const float* ST = p.out + (size_t)u * 16384;
    bf16_t* Ahg = (bf16_t*)(p.ws + WS_AHGR);
    bf16_t* Qs = (bf16_t*)shm;
    bf16_t* Ks2 = (bf16_t*)(shm + 64 * H_STRIDE128 * 2);
    bf16_t* Vt = (bf16_t*)(shm + 2 * 64 * H_STRIDE128 * 2);
    bf16_t* St = (bf16_t*)(shm + 2 * 64 * H_STRIDE128 * 2 + 128 * H_STRIDE64 * 2);
    float* segsum = (float*)(shm + 2 * 64 * H_STRIDE128 * 2 + 128 * H_STRIDE64 * 2 + 128 * H_STRIDE128 * 2);
    float* eref = segsum + 512;
    float* part = eref + 128;
    const int tid = threadIdx.x, wid = tid >> 6, lane = tid & 63, fr = lane & 15, fq = lane >> 4;
    const int c = u & 255, sq = u >> 8, h = sq & 7, b = sq >> 3; const size_t r0 = (size_t)b * NT + (size_t)c * 64;
    const int d = tid & 127, seg = tid >> 7;
    f32x4 sv[8];
#pragma unroll
    for (int i = 0; i < 8; ++i) sv[i] = *(const f32x4*)(ST + (size_t)(tid + 512 * i) * 4);
    float bp[16], kk[16];
    hgrn_gates(p, proj, r0, h, d, seg, bp, kk);
    segsum[seg * 128 + d] = bp[15];
    { unsigned w[8];
#pragma unroll
      for (int i = 0; i < 8; ++i) { const unsigned lo = proj[(r0 + seg * 16 + 2 * i) * INW + OHI + h * 128 + d], hi = proj[(r0 + seg * 16 + 2 * i + 1) * INW + OHI + h * 128 + d]; w[i] = lo | (hi << 16); }
      bf16_t* vd = Vt + d * H_STRIDE64 + seg * 16; *(u32x4*)vd = (u32x4){w[0], w[1], w[2], w[3]}; *(u32x4*)(vd + 8) = (u32x4){w[4], w[5], w[6], w[7]}; }
    __syncthreads();
    float off = 0.f;
#pragma unroll
    for (int s2 = 0; s2 < 4; ++s2) { const float v = segsum[s2 * 128 + d]; if (s2 < seg) off += v; }
    const float bref = segsum[d] + segsum[128 + d];
    if (seg == 0) eref[d] = __expf(bref);
#pragma unroll
    for (int i = 0; i < 16; ++i) { const float bb = off + bp[i] - bref; const int t = seg * 16 + i;
        const float qv = bf2f(proj[(r0 + t) * INW + OHQ + h * 128 + d]);
        const unsigned qk = cvt_pk_bf16(qv * __expf(bb), kk[i] * __expf(-bb));
        Qs[t * H_STRIDE128 + d] = (bf16_t)(qk & 0xffffu); Ks2[t * H_STRIDE128 + d] = (bf16_t)(qk >> 16); }
    __syncthreads();
#pragma unroll
    for (int i = 0; i < 8; ++i) { const int idx = tid + 512 * i, v = idx >> 5, d4 = (idx & 31) * 4;
        const f32x4 er = *(const f32x4*)(eref + d4);
        u32x2 w; w.x = cvt_pk_bf16(sv[i][0] * er[0], sv[i][1] * er[1]); w.y = cvt_pk_bf16(sv[i][2] * er[2], sv[i][3] * er[3]);
        *(u32x2*)(St + v * H_STRIDE128 + d4) = w; }
    __syncthreads();
    const int tt = wid & 3, vh = wid >> 2;
    bf16x8 bq[4];
#pragma unroll
    for (int ks = 0; ks < 4; ++ks) bq[ks] = *(const bf16x8*)(Qs + (16 * tt + fr) * H_STRIDE128 + ks * 32 + fq * 8);
    f32x4 pa[4];
#pragma unroll
    for (int st = 0; st < 4; ++st) { pa[st] = (f32x4){0.f, 0.f, 0.f, 0.f};
        if (st <= tt) {
#pragma unroll
            for (int ks = 0; ks < 4; ++ks) { const bf16x8 a = *(const bf16x8*)(Ks2 + (16 * st + fr) * H_STRIDE128 + ks * 32 + fq * 8);
                pa[st] = __builtin_amdgcn_mfma_f32_16x16x32_bf16(a, bq[ks], pa[st], 0, 0, 0); }
#pragma unroll
            for (int j = 0; j < 4; ++j) { const int s_ = 16 * st + fq * 4 + j, t_ = 16 * tt + fr; pa[st][j] = (s_ <= t_) ? pa[st][j] : 0.f; }
        } }
    bf16x8 pf[2];
#pragma unroll
    for (int pp = 0; pp < 2; ++pp) pf[pp] = mk8(cvt_pk_bf16(pa[2 * pp][0], pa[2 * pp][1]), cvt_pk_bf16(pa[2 * pp][2], pa[2 * pp][3]), cvt_pk_bf16(pa[2 * pp + 1][0], pa[2 * pp + 1][1]), cvt_pk_bf16(pa[2 * pp + 1][2], pa[2 * pp + 1][3]));
    f32x4 o[4]; float ss = 0.f;
#pragma unroll
    for (int vt = 0; vt < 4; ++vt) { const int vrow = 16 * (vh * 4 + vt) + fr; o[vt] = (f32x4){0.f, 0.f, 0.f, 0.f};
#pragma unroll
        for (int pp = 0; pp < 2; ++pp) { const u32x2 lo = *(const u32x2*)(Vt + vrow * H_STRIDE64 + (2 * pp) * 16 + fq * 4), hi = *(const u32x2*)(Vt + vrow * H_STRIDE64 + (2 * pp + 1) * 16 + fq * 4);
            o[vt] = __builtin_amdgcn_mfma_f32_16x16x32_bf16(mk8(lo.x, lo.y, hi.x, hi.y), pf[pp], o[vt], 0, 0, 0); }
#pragma unroll
        for (int ks = 0; ks < 4; ++ks) { const bf16x8 a = *(const bf16x8*)(St + vrow * H_STRIDE128 + ks * 32 + fq * 8);
            o[vt] = __builtin_amdgcn_mfma_f32_16x16x32_bf16(a, bq[ks], o[vt], 0, 0, 0); }
        ss += o[vt][0] * o[vt][0] + o[vt][1] * o[vt][1] + o[vt][2] * o[vt][2] + o[vt][3] * o[vt][3]; }
    ss += __shfl_xor(ss, 16); ss += __shfl_xor(ss, 32);
    if (fq == 0) part[vh * 64 + 16 * tt + fr] = ss;
    __syncthreads();
    const float tot = part[16 * tt + fr] + part[64 + 16 * tt + fr];
    const float rstd = rsqrtf(tot * (1.0f / 128.0f) + 1e-6f);
    const size_t r = r0 + 16 * tt + fr;
#pragma unroll
    for (int vt = 0; vt < 4; ++vt) { const int col = h * 128 + 16 * (vh * 4 + vt) + fq * 4;
        const f32x4 gn = *(const f32x4*)(p.hgain + col);
        const u32x2 gt = *(const u32x2*)(proj + r * INW + OHG + col);
        u32x2 w; w.x = cvt_pk_bf16(o[vt][0] * rstd * gn[0] * bflo(gt.x), o[vt][1] * rstd * gn[1] * bfhi(gt.x)); w.y = cvt_pk_bf16(o[vt][2] * rstd * gn[2] * bflo(gt.y), o[vt][3] * rstd * gn[3] * bfhi(gt.y));
        *(u32x2*)(Ahg + r * 1024 + col) = w; }
    __syncthreads();
}

__device__ __forceinline__ void phase_final(const Params& p) {
    const int tid = threadIdx.x, wid = tid >> 6, lane = tid & 63;
    const float* rss = (const float*)(p.ws + WS_RSS);
    for (int r = blockIdx.x * 8 + wid; r < NTOK; r += gridDim.x * 8) {
        float ss = (lane < 32) ? rss[(size_t)r * 32 + lane] : 0.f;
        ss = wave_sum(ss);
        const float rstd = rsqrtf(ss * (1.0f / DM) + 1e-6f);
        f32x4* orow = (f32x4*)(p.out + (size_t)r * DM);
#pragma unroll
        for (int i = 0; i < 8; ++i) { const f32x4 g = ((const f32x4*)p.fgain)[lane + 64 * i]; f32x4 v = orow[lane + 64 * i];
            v[0] = v[0] * rstd * g[0]; v[1] = v[1] * rstd * g[1]; v[2] = v[2] * rstd * g[2]; v[3] = v[3] * rstd * g[3]; orow[lane + 64 * i] = v; }
    }
}

__global__ void __launch_bounds__(512, 2) fwd_megakernel(Params p) {
    extern __shared__ __attribute__((aligned(16))) unsigned char shm[];
    cg::grid_group grid = cg::this_grid();
    const int G = (int)gridDim.x, c = (int)blockIdx.x;
    phase_prep(p, shm);
    grid.sync();
    { pg8::Gemm g; g.A0 = (const bf16_t*)(p.ws + WS_HA); g.B0 = (const bf16_t*)(p.ws + WS_WIN); g.A1 = g.A0; g.B1 = g.B0; g.M = NTOK; g.N = INW; g.K = DM;
      pg8::StaticOrder S; S.init(NTOK, INW, G, c, 0); EpiProj E; E.O = (bf16_t*)(p.ws + WS_PROJ);
      pg8::gemm_phase<EpiProj>((LAS unsigned char*)shm, g, S, E); }
    grid.sync();
    for (int u = c; u < NAU; u += G) attn_unit(p, shm, u);
    for (int u = c; u < NHU; u += G) hgrn_local_unit(p, shm, u);
    grid.sync();
    hgrn_scan(p);
    grid.sync();
    for (int u = c; u < NHU; u += G) hgrn_out_unit(p, shm, u);
    grid.sync();
    { pg8::Gemm g; g.A0 = (const bf16_t*)(p.ws + WS_AATT); g.B0 = (const bf16_t*)(p.ws + WS_WAO); g.A1 = (const bf16_t*)(p.ws + WS_AHGR); g.B1 = (const bf16_t*)(p.ws + WS_WHO); g.M = NTOK; g.N = DM; g.K = 1024;
      pg8::StaticOrder S; S.init(NTOK, DM, G, c, 1); EpiMerge E; E.proj = (const bf16_t*)(p.ws + WS_PROJ); E.O = (bf16_t*)(p.ws + WS_HA);
      pg8::gemm_phase<EpiMerge>((LAS unsigned char*)shm, g, S, E); }
    grid.sync();
    { pg8::Gemm g; g.A0 = (const bf16_t*)(p.ws + WS_HA); g.B0 = (const bf16_t*)(p.ws + WS_WO); g.A1 = g.A0; g.B1 = g.B0; g.M = NTOK; g.N = DM; g.K = DM;
      pg8::StaticOrder S; S.init(NTOK, DM, G, c, 0); EpiResid E; E.X = p.x; E.O = p.out; E.rss = (float*)(p.ws + WS_RSS);
      pg8::gemm_phase<EpiResid>((LAS unsigned char*)shm, g, S, E); }
    grid.sync();
    phase_final(p);
}

extern "C" void kernel_launch(void* const* d_in, const int* in_sizes, int n_in, void* d_out, int out_size, void* d_ws, size_t ws_size, hipStream_t stream) {
    constexpr size_t kDynLds = pg8::STAGE_BYTES;
    static int grid_blocks = 0;
    if (grid_blocks == 0) {
        if (ws_size < WS_END) { fprintf(stderr, "kernel_launch: workspace too small: %zu < %zu\n", ws_size, (size_t)WS_END); grid_blocks = -1; return; }
        int dev = 0, cus = 0, per_cu = 0;
        (void)hipGetDevice(&dev);
        (void)hipDeviceGetAttribute(&cus, hipDeviceAttributeMultiprocessorCount, dev);
        if (hipFuncSetAttribute((const void*)fwd_megakernel, hipFuncAttributeMaxDynamicSharedMemorySize, (int)kDynLds) != hipSuccess) { fprintf(stderr, "kernel_launch: hipFuncSetAttribute failed\n"); grid_blocks = -1; return; }
        if (hipOccupancyMaxActiveBlocksPerMultiprocessor(&per_cu, (const void*)fwd_megakernel, 512, kDynLds) != hipSuccess || per_cu < 1) { fprintf(stderr, "kernel_launch: occupancy query failed (%d)\n", per_cu); (void)hipGetLastError(); grid_blocks = -1; return; }
        if (per_cu > 1) per_cu = 1;
        grid_blocks = cus * per_cu;
    }
    if (grid_blocks < 0) return;
    Params p{};
    p.x = (const float*)d_in[0]; p.pos = (const int*)d_in[1]; p.norm_gain = (const float*)d_in[2]; p.w_in = (const float*)d_in[3]; p.sinks = (const float*)d_in[4];
    p.lbt = (const float*)d_in[5]; p.hgain = (const float*)d_in[6]; p.w_ao = (const float*)d_in[7]; p.w_ho = (const float*)d_in[8]; p.w_o = (const float*)d_in[9];
    p.fgain = (const float*)d_in[10]; p.out = (float*)d_out; p.ws = (unsigned char*)d_ws;
    void* args[] = {&p};
    hipError_t e = hipLaunchCooperativeKernel((const void*)fwd_megakernel, dim3(grid_blocks), dim3(512), args, kDynLds, stream);
    if (e != hipSuccess) fprintf(stderr, "cooperative launch failed: %s (grid %d)\n", hipGetErrorString(e), grid_blocks);
}
```

```cpp
#include <hip/hip_runtime.h>
#include <hip/hip_cooperative_groups.h>
#include <cstdio>
namespace cg = cooperative_groups;

#define LAS __attribute__((address_space(3)))
typedef unsigned short bf16_t;
typedef short bf16x8 __attribute__((ext_vector_type(8)));
typedef float f32x4 __attribute__((ext_vector_type(4)));
typedef float f32x2 __attribute__((ext_vector_type(2)));
typedef unsigned u32x4 __attribute__((ext_vector_type(4)));
typedef unsigned u32x2 __attribute__((ext_vector_type(2)));

constexpr int NB = 2, NT = 16384, NTOK = NB * NT, DM = 2048, INW = 10752;
constexpr int OQ = 0, OKK = 1024, OV = 1280, OAG = 1536, OHQ = 2560, OHF = 3584, OHI = 4608, OHG = 5632, OMA = 6656, OMH = 8704;
constexpr int NCHUNK = NT / 64;
constexpr int NHU = NB * 8 * NCHUNK;
constexpr int NAU = NB * (NT / 128) * 4;

constexpr size_t WS_HA = 0;
constexpr size_t WS_WIN = WS_HA + (size_t)NTOK * DM * 2;
constexpr size_t WS_WAO = WS_WIN + (size_t)INW * DM * 2;
constexpr size_t WS_WHO = WS_WAO + (size_t)DM * 1024 * 2;
constexpr size_t WS_WO = WS_WHO + (size_t)DM * 1024 * 2;
constexpr size_t WS_PROJ = WS_WO + (size_t)DM * DM * 2;
constexpr size_t WS_ROPE = WS_PROJ + (size_t)NTOK * INW * 2;
constexpr size_t WS_AATT = WS_ROPE + (size_t)NTOK * 32 * 8;
constexpr size_t WS_AHGR = WS_AATT + (size_t)NTOK * 1024 * 2;
constexpr size_t WS_DTOT = WS_AHGR + (size_t)NTOK * 1024 * 2;
constexpr size_t WS_RSS = WS_DTOT + (size_t)NHU * 128 * 4;
constexpr size_t WS_END = WS_RSS + (size_t)NTOK * 32 * 4;

struct Params {
    const float* x; const int* pos; const float* norm_gain; const float* w_in; const float* sinks; const float* lbt;
    const float* hgain; const float* w_ao; const float* w_ho; const float* w_o; const float* fgain;
    float* out; unsigned char* ws;
};

__constant__ float c_inv_freq[32] = {
    1.0f, 0.749894261f, 0.562341332f, 0.421696514f, 0.316227764f, 0.237137377f, 0.177827939f, 0.133352131f, 0.100000001f, 0.0749894157f,
    0.0562341325f, 0.0421696529f, 0.0316227749f, 0.0237137377f, 0.0177827943f, 0.0133352149f, 0.00999999978f, 0.00749894185f,
    0.00562341325f, 0.00421696482f, 0.00316227763f, 0.00237137359f, 0.00177827943f, 0.00133352145f, 0.00100000005f, 0.000749894243f,
    0.000562341302f, 0.000421696517f, 0.000316227757f, 0.00023713737f, 0.00017782794f, 0.00013335215f};

__device__ __forceinline__ float bf2f(bf16_t b) { return __uint_as_float(((unsigned)b) << 16); }
__device__ __forceinline__ float bflo(unsigned w) { return __uint_as_float(w << 16); }
__device__ __forceinline__ float bfhi(unsigned w) { return __uint_as_float(w & 0xffff0000u); }
__device__ __forceinline__ unsigned cvt_pk_bf16(float lo, float hi) { unsigned r; asm volatile("v_cvt_pk_bf16_f32 %0, %1, %2" : "=v"(r) : "v"(lo), "v"(hi)); return r; }
__device__ __forceinline__ float fast_rcp(float x) { return __builtin_amdgcn_rcpf(x); }
__device__ __forceinline__ float sigmoidf_(float v) { return fast_rcp(1.0f + __expf(-v)); }
__device__ __forceinline__ float wave_sum(float v) {
#pragma unroll
    for (int o = 32; o > 0; o >>= 1) v += __shfl_xor(v, o);
    return v;
}
__device__ __forceinline__ bf16x8 mk8(unsigned a, unsigned b, unsigned c, unsigned d) { u32x4 w; w.x = a; w.y = b; w.z = c; w.w = d; return __builtin_bit_cast(bf16x8, w); }

namespace pg8 {
constexpr int BM = 256, BK = 64, HALF = 128, HTB = HALF * BK * 2, STAGE_BYTES = 8 * HTB, NXCD = 8, WGM = 8;
__host__ __device__ __forceinline__ int lds_byte(int r, int c) { const int st = (r >> 4) * 2 + (c >> 5), rr = r & 15, cc = c & 31, ob = rr * 64 + cc * 2; return st * 1024 + (ob ^ (((ob >> 9) & 1) << 5)); }
__host__ __device__ __forceinline__ void stage_rc(int b, int& R, int& C) { const int st = b / 1024, sb = b % 1024, swz = sb ^ (((sb >> 9) & 1) << 5); R = (st >> 1) * 16 + swz / 64; C = (st & 1) * 32 + (swz % 64) / 2; }
__host__ __device__ __forceinline__ int perm32(int rho) { const int n = rho >> 4, i = rho & 15; return 8 * (i >> 2) + 4 * n + (i & 3); }

struct Unit { int pm, pn, kind; };
struct Gemm { const bf16_t* A0; const bf16_t* B0; const bf16_t* A1; const bf16_t* B1; int M, N, K; };

struct StaticOrder {
    int nM, nN, nwg, G, c, dual, R, reps;
    __device__ void init(int M, int N, int G_, int c_, int dual_, int reps_ = 1) { nM = M / BM; nN = N / BM; nwg = nM * nN; G = G_; c = c_; dual = dual_; R = (nwg + G - 1) / G; reps = reps_; }
    __device__ bool next(int i, Unit& u) const {
        if (i >= reps * (R << dual)) return false;
        const int it = (i >> dual) % R;
        const long L = (long)it * G + c; if (L >= nwg) return false;
        int wgid = (int)L; { const int q = nwg / NXCD, r = nwg % NXCD, xcd = wgid % NXCD, off = wgid / NXCD; wgid = (xcd < r ? xcd * (q + 1) : r * (q + 1) + (xcd - r) * q) + off; }
        const int nig = WGM * nN, gid = wgid / nig, fm = gid * WGM, gsz = (nM - fm) < WGM ? (nM - fm) : WGM;
        u.pm = fm + ((wgid % nig) % gsz); u.pn = (wgid % nig) / gsz; u.kind = i & dual; return true;
    }
};

template <class Epi>
__device__ __forceinline__ void gemm_phase(LAS unsigned char* lds, const Gemm g, const StaticOrder& S, const Epi& E) {
    const int tid = threadIdx.x, wid = __builtin_amdgcn_readfirstlane(tid >> 6), lane = tid & 63, wr = wid >> 2, wc = wid & 3, fr = lane & 15, fq = lane >> 4;
    const int K = g.K, nt = K / BK;
    unsigned voffA[2], voffB[2];
#pragma unroll
    for (int i = 0; i < 2; ++i) { int R, C; stage_rc(tid * 16 + i * 8192, R, C); const int Rb = Epi::PERM ? ((R & ~31) + perm32(R & 31)) : R;
        voffA[i] = (unsigned)(R * K + C) * 2u; voffB[i] = (unsigned)(Rb * K + C) * 2u; }
    const size_t kstep = (size_t)(BK * 2);
    const size_t hstep = (size_t)HALF * K * 2;
    const size_t tstep = 2 * hstep;
    const unsigned ldsw = (unsigned)wid * 1024u;
    const int aoff = lds_byte(wr * 64 + fr, fq * 8), boff = lds_byte(wc * 32 + fr, fq * 8);
#define PG8_SA(b, h) (((b) * 2 + (h)) * HTB)
#define PG8_SB(b, h) ((4 + (b) * 2 + (h)) * HTB)
#define PG8_STAGE(bufoff, gbase, voff) do { _Pragma("unroll") for (int _i = 0; _i < 2; ++_i) \
        __builtin_amdgcn_global_load_lds((const unsigned*)((const char*)(gbase) + (voff)[_i]), (LAS unsigned*)(lds + (bufoff) + ldsw + _i * 8192), 16, 0, 0); } while (0)
#define PG8_LDA(dst, b, h) do { _Pragma("unroll") for (int m = 0; m < 4; ++m) _Pragma("unroll") for (int k = 0; k < 2; ++k) dst[m][k] = *(const LAS bf16x8*)(lds + PG8_SA(b, h) + aoff + m * 2048 + k * 1024); } while (0)
#define PG8_LDB(dst, b, h) do { _Pragma("unroll") for (int n = 0; n < 2; ++n) _Pragma("unroll") for (int k = 0; k < 2; ++k) dst[n][k] = *(const LAS bf16x8*)(lds + PG8_SB(b, h) + boff + n * 2048 + k * 1024); } while (0)
#define PG8_MMA(ai, bj, At, Bt) do { __builtin_amdgcn_s_setprio(1); _Pragma("unroll") for (int m = 0; m < 4; ++m) _Pragma("unroll") for (int n = 0; n < 2; ++n) _Pragma("unroll") for (int k = 0; k < 2; ++k) \
        acc[ai][bj][m][n] = __builtin_amdgcn_mfma_f32_16x16x32_bf16(Bt[n][k], At[m][k], acc[ai][bj][m][n], 0, 0, 0); __builtin_amdgcn_s_setprio(0); } while (0)
#define PG8_WAIT_V(n) asm volatile("s_waitcnt vmcnt(" #n ")" ::: "memory")
#define PG8_WAIT_L(n) asm volatile("s_waitcnt lgkmcnt(" #n ")" ::: "memory")
#define PG8_BAR __builtin_amdgcn_s_barrier()
#define PG8_SCHED __builtin_amdgcn_sched_barrier(0)
    Unit cur, nxt; int ui = 0;
    if (!S.next(0, cur)) return;
    f32x4 acc[2][2][4][2];
#pragma unroll
    for (int a = 0; a < 2; ++a)
#pragma unroll
        for (int b = 0; b < 2; ++b)
#pragma unroll
            for (int m = 0; m < 4; ++m)
#pragma unroll
                for (int n = 0; n < 2; ++n) acc[a][b][m][n] = (f32x4){0.f, 0.f, 0.f, 0.f};
    bf16x8 At[4][2], B0[2][2], B1[2][2];
    const char* cA = (const char*)(cur.kind ? g.A1 : g.A0) + (size_t)cur.pm * tstep; const char* cB = (const char*)(cur.kind ? g.B1 : g.B0) + (size_t)cur.pn * tstep;
    PG8_STAGE(PG8_SB(0, 0), cB, voffB); PG8_STAGE(PG8_SA(0, 0), cA, voffA); PG8_STAGE(PG8_SB(0, 1), cB + hstep, voffB); PG8_STAGE(PG8_SA(0, 1), cA + hstep, voffA);
    if (wr == 1) PG8_BAR;
    PG8_WAIT_V(4); PG8_BAR;
    PG8_STAGE(PG8_SB(1, 0), cB + kstep, voffB); PG8_STAGE(PG8_SA(1, 0), cA + kstep, voffA); PG8_STAGE(PG8_SB(1, 1), cB + hstep + kstep, voffB);
    PG8_WAIT_V(6); PG8_BAR;
    for (;;) {
        const bool has_next = S.next(ui + 1, nxt);
        const char* nA = has_next ? (const char*)(nxt.kind ? g.A1 : g.A0) + (size_t)nxt.pm * tstep : cA; const char* nB = has_next ? (const char*)(nxt.kind ? g.B1 : g.B0) + (size_t)nxt.pn * tstep : cB;
        for (int t = 0; t < nt; t += 2) {
            const bool last = (t == nt - 2);
            const char* a1 = cA + (size_t)(t + 1) * kstep;
            const char* a2 = last ? nA : cA + (size_t)(t + 2) * kstep; const char* b2 = last ? nB : cB + (size_t)(t + 2) * kstep;
            const char* a3 = a2 + kstep; const char* b3 = b2 + kstep;
            PG8_LDB(B0, 0, 0); PG8_SCHED; PG8_LDA(At, 0, 0); PG8_STAGE(PG8_SA(1, 1), a1 + hstep, voffA);
            PG8_WAIT_L(8); PG8_BAR; PG8_WAIT_L(0); PG8_MMA(0, 0, At, B0); PG8_BAR; PG8_SCHED;
            PG8_LDB(B1, 0, 1); PG8_STAGE(PG8_SB(0, 0), b2, voffB);
            PG8_BAR; PG8_WAIT_L(0); PG8_MMA(0, 1, At, B1); PG8_BAR;
            PG8_LDA(At, 0, 1); PG8_STAGE(PG8_SA(0, 0), a2, voffA);
            PG8_BAR; PG8_WAIT_L(0); PG8_MMA(1, 0, At, B0); PG8_BAR; PG8_SCHED;
            PG8_STAGE(PG8_SB(0, 1), b2 + hstep, voffB);
            PG8_WAIT_V(6); PG8_BAR; PG8_MMA(1, 1, At, B1); PG8_BAR;
            PG8_LDB(B0, 1, 0); PG8_SCHED; PG8_LDA(At, 1, 0); PG8_STAGE(PG8_SA(0, 1), a2 + hstep, voffA);
            PG8_WAIT_L(8); PG8_BAR; PG8_WAIT_L(0); PG8_MMA(0, 0, At, B0); PG8_BAR; PG8_SCHED;
            PG8_LDB(B1, 1, 1); PG8_STAGE(PG8_SB(1, 0), b3, voffB);
            PG8_BAR; PG8_WAIT_L(0); PG8_MMA(0, 1, At, B1); PG8_BAR;
            PG8_LDA(At, 1, 1); PG8_STAGE(PG8_SA(1, 0), a3, voffA);
            PG8_BAR; PG8_WAIT_L(0); PG8_MMA(1, 0, At, B0); PG8_BAR; PG8_SCHED;
            PG8_STAGE(PG8_SB(1, 1), b3 + hstep, voffB);
            PG8_WAIT_V(6); PG8_BAR; PG8_MMA(1, 1, At, B1); PG8_BAR;
        }
        const bool keep = E(acc, cur, wr, wc, fr, fq);
        if (!has_next) break;
        if (!keep) {
#pragma unroll
            for (int a = 0; a < 2; ++a)
#pragma unroll
                for (int b = 0; b < 2; ++b)
#pragma unroll
                    for (int m = 0; m < 4; ++m)
#pragma unroll
                        for (int n = 0; n < 2; ++n) acc[a][b][m][n] = (f32x4){0.f, 0.f, 0.f, 0.f};
        }
        cur = nxt; cA = nA; cB = nB; ++ui;
    }
    PG8_WAIT_V(0);
    if (wr == 0) PG8_BAR;
    PG8_BAR;
#undef PG8_SA
#undef PG8_SB
#undef PG8_STAGE
#undef PG8_LDA
#undef PG8_LDB
#undef PG8_MMA
#undef PG8_WAIT_V
#undef PG8_WAIT_L
#undef PG8_BAR
#undef PG8_SCHED
}
}

struct EpiProj {
    static constexpr bool PERM = true;
    bf16_t* O;
    __device__ __forceinline__ bool operator()(f32x4 (&acc)[2][2][4][2], const pg8::Unit& u, int wr, int wc, int fr, int fq) const {
        const int pn = u.pn;
        int mode = 0; float scale = 1.0f;
        if ((pn >= 6 && pn < 10) || (pn >= 22 && pn < 26)) mode = 1;
        else if (pn >= 10 && pn < 14) { mode = 1; scale = 0.08838834764831845f; }
        else if (pn >= 26) mode = 2;
        const int row0 = u.pm * 256 + wr * 64 + fr, col0 = pn * 256 + wc * 32 + 8 * fq;
#pragma unroll
        for (int ai = 0; ai < 2; ++ai)
#pragma unroll
            for (int m = 0; m < 4; ++m) { bf16_t* rowp = O + (size_t)(row0 + ai * 128 + m * 16) * INW + col0;
#pragma unroll
                for (int bj = 0; bj < 2; ++bj) { f32x4 v0 = acc[ai][bj][m][0], v1 = acc[ai][bj][m][1];
                    if (mode != 0) {
#pragma unroll
                        for (int j = 0; j < 4; ++j) { const float s0 = sigmoidf_(v0[j]), s1 = sigmoidf_(v1[j]);
                            v0[j] = (mode == 1) ? v0[j] * s0 * scale : s0; v1[j] = (mode == 1) ? v1[j] * s1 * scale : s1; }
                    }
                    u32x4 w; w.x = cvt_pk_bf16(v0[0], v0[1]); w.y = cvt_pk_bf16(v0[2], v0[3]); w.z = cvt_pk_bf16(v1[0], v1[1]); w.w = cvt_pk_bf16(v1[2], v1[3]);
                    *(u32x4*)(rowp + bj * 128) = w; } }
        return false;
    }
};
struct EpiMerge {
    static constexpr bool PERM = true;
    const bf16_t* proj; bf16_t* O;
    __device__ __forceinline__ bool operator()(f32x4 (&acc)[2][2][4][2], const pg8::Unit& u, int wr, int wc, int fr, int fq) const {
        const int row0 = u.pm * 256 + wr * 64 + fr, col0 = u.pn * 256 + wc * 32 + 8 * fq;
#pragma unroll
        for (int ai = 0; ai < 2; ++ai)
#pragma unroll
            for (int m = 0; m < 4; ++m) { const size_t r = (size_t)(row0 + ai * 128 + m * 16);
#pragma unroll
                for (int bj = 0; bj < 2; ++bj) { const int c = col0 + bj * 128;
                    const u32x4 g2 = *(const u32x4*)(proj + r * INW + OMH + c);
                    float s2[8] = {bflo(g2.x), bfhi(g2.x), bflo(g2.y), bfhi(g2.y), bflo(g2.z), bfhi(g2.z), bflo(g2.w), bfhi(g2.w)};
                    if (u.kind == 0) {
                        const u32x4 g1 = *(const u32x4*)(proj + r * INW + OMA + c);
                        float s1[8] = {bflo(g1.x), bfhi(g1.x), bflo(g1.y), bfhi(g1.y), bflo(g1.z), bfhi(g1.z), bflo(g1.w), bfhi(g1.w)};
#pragma unroll
                        for (int j = 0; j < 4; ++j) { acc[ai][bj][m][0][j] *= s1[j] * fast_rcp(fmaxf(s2[j], 1e-20f)); acc[ai][bj][m][1][j] *= s1[4 + j] * fast_rcp(fmaxf(s2[4 + j], 1e-20f)); }
                    } else {
                        const f32x4 v0 = acc[ai][bj][m][0], v1 = acc[ai][bj][m][1];
                        u32x4 w; w.x = cvt_pk_bf16(v0[0] * s2[0], v0[1] * s2[1]); w.y = cvt_pk_bf16(v0[2] * s2[2], v0[3] * s2[3]);
                        w.z = cvt_pk_bf16(v1[0] * s2[4], v1[1] * s2[5]); w.w = cvt_pk_bf16(v1[2] * s2[6], v1[3] * s2[7]);
                        *(u32x4*)(O + r * DM + c) = w;
                    } } }
        return u.kind == 0;
    }
};
struct EpiResid {
    static constexpr bool PERM = true;
    const float* X; bf16_t* O; float* rss;
    __device__ __forceinline__ bool operator()(f32x4 (&acc)[2][2][4][2], const pg8::Unit& u, int wr, int wc, int fr, int fq) const {
        const int row0 = u.pm * 256 + wr * 64 + fr, col0 = u.pn * 256 + wc * 32 + 8 * fq;
#pragma unroll
        for (int ai = 0; ai < 2; ++ai)
#pragma unroll
            for (int m = 0; m < 4; ++m) { const size_t r = (size_t)(row0 + ai * 128 + m * 16); float ss = 0.f;
#pragma unroll
                for (int bj = 0; bj < 2; ++bj) { const size_t o = r * DM + col0 + bj * 128;
                    const f32x4 v0 = *(const f32x4*)(X + o) + acc[ai][bj][m][0], v1 = *(const f32x4*)(X + o + 4) + acc[ai][bj][m][1];
                    ss += v0[0] * v0[0] + v0[1] * v0[1] + v0[2] * v0[2] + v0[3] * v0[3] + v1[0] * v1[0] + v1[1] * v1[1] + v1[2] * v1[2] + v1[3] * v1[3];
                    u32x4 w; w.x = cvt_pk_bf16(v0[0], v0[1]); w.y = cvt_pk_bf16(v0[2], v0[3]); w.z = cvt_pk_bf16(v1[0], v1[1]); w.w = cvt_pk_bf16(v1[2], v1[3]);
                    *(u32x4*)(O + o) = w; }
                ss += __shfl_xor(ss, 16); ss += __shfl_xor(ss, 32);
                if (fq == 0) rss[r * 32 + u.pn * 4 + wc] = ss; }
        return false;
    }
};

__device__ __forceinline__ void transpose_tile_wave(const float* __restrict__ W, int K, int N, bf16_t* __restrict__ WT, int tile, int lane) {
    const int ntn = N >> 6; const int k0 = (tile / ntn) * 64, n0 = (tile % ntn) * 64;
    const float* src = W + (size_t)k0 * N + n0 + lane;
    float v[64];
#pragma unroll
    for (int i = 0; i < 64; ++i) v[i] = src[(size_t)i * N];
    bf16_t* dst = WT + (size_t)(n0 + lane) * K + k0;
#pragma unroll
    for (int i = 0; i < 8; ++i) { u32x4 w; w.x = cvt_pk_bf16(v[8 * i], v[8 * i + 1]); w.y = cvt_pk_bf16(v[8 * i + 2], v[8 * i + 3]); w.z = cvt_pk_bf16(v[8 * i + 4], v[8 * i + 5]); w.w = cvt_pk_bf16(v[8 * i + 6], v[8 * i + 7]);
        *(u32x4*)(dst + 8 * i) = w; }
}

__device__ __forceinline__ void phase_prep(const Params& p, unsigned char* shm) {
    const int tid = threadIdx.x, wid = tid >> 6, lane = tid & 63;
    bf16_t* hA = (bf16_t*)(p.ws + WS_HA);
    for (int r = blockIdx.x * 8 + wid; r < NTOK; r += gridDim.x * 8) {
        const f32x4* xr = (const f32x4*)(p.x + (size_t)r * DM);
        f32x4 v[8]; float ss = 0.f;
#pragma unroll
        for (int i = 0; i < 8; ++i) { v[i] = xr[lane + 64 * i]; ss += v[i][0] * v[i][0] + v[i][1] * v[i][1] + v[i][2] * v[i][2] + v[i][3] * v[i][3]; }
        ss = wave_sum(ss);
        const float rstd = rsqrtf(ss * (1.0f / DM) + 1e-6f);
#pragma unroll
        for (int i = 0; i < 8; ++i) { const f32x4 g = ((const f32x4*)p.norm_gain)[lane + 64 * i];
            u32x2 w; w.x = cvt_pk_bf16(v[i][0] * rstd * g[0], v[i][1] * rstd * g[1]); w.y = cvt_pk_bf16(v[i][2] * rstd * g[2], v[i][3] * rstd * g[3]);
            *(u32x2*)(hA + (size_t)r * DM + (lane + 64 * i) * 4) = w; }
    }
    constexpr int T_IN = (DM / 64) * (INW / 64), T_AO = (1024 / 64) * (DM / 64), T_WO = (DM / 64) * (DM / 64);
    for (int t = blockIdx.x * 8 + wid; t < T_IN + 2 * T_AO + T_WO; t += gridDim.x * 8) {
        if (t < T_IN) transpose_tile_wave(p.w_in, DM, INW, (bf16_t*)(p.ws + WS_WIN), t, lane);
        else if (t < T_IN + T_AO) transpose_tile_wave(p.w_ao, 1024, DM, (bf16_t*)(p.ws + WS_WAO), t - T_IN, lane);
        else if (t < T_IN + 2 * T_AO) transpose_tile_wave(p.w_ho, 1024, DM, (bf16_t*)(p.ws + WS_WHO), t - T_IN - T_AO, lane);
        else transpose_tile_wave(p.w_o, DM, DM, (bf16_t*)(p.ws + WS_WO), t - T_IN - 2 * T_AO, lane);
    }
    f32x2* rope = (f32x2*)(p.ws + WS_ROPE);
    for (int idx = blockIdx.x * 512 + tid; idx < NTOK * 32; idx += gridDim.x * 512) {
        const int tok = idx >> 5, i = idx & 31;
        const float ang = (float)p.pos[tok] * c_inv_freq[i];
        const double a = (double)ang; const double kq = rint(a * 0.63661977236758134308);
        const double r = fma(-kq, 1.5707963267948966192, a) - kq * 6.123233995736766e-17;
        const double r2 = r * r;
        double sn = r2 * (-1.0 / 39916800.0) + (1.0 / 362880.0); sn = sn * r2 - (1.0 / 5040.0); sn = sn * r2 + (1.0 / 120.0); sn = sn * r2 - (1.0 / 6.0); sn = sn * r2 * r + r;
        double cs = r2 * (1.0 / 479001600.0) - (1.0 / 3628800.0); cs = cs * r2 + (1.0 / 40320.0); cs = cs * r2 - (1.0 / 720.0); cs = cs * r2 + (1.0 / 24.0); cs = cs * r2 - 0.5; cs = cs * r2 + 1.0;
        const int q = ((int)(long long)kq) & 3;
        const double c_ = (q == 0) ? cs : (q == 1) ? -sn : (q == 2) ? -cs : sn;
        const double s_ = (q == 0) ? sn : (q == 1) ? cs : (q == 2) ? -sn : -cs;
        f32x2 o; o.x = (float)c_; o.y = (float)s_; rope[idx] = o;
    }
}

constexpr int KS_STRIDE = 72;
constexpr int VT_STRIDE = 264;
__device__ __forceinline__ void attn_unit(const Params& p, unsigned char* shm, int unit) {
    const bf16_t* proj = (const bf16_t*)(p.ws + WS_PROJ);
    const f32x2* rope = (const f32x2*)(p.ws + WS_ROPE);
    bf16_t* Aatt = (bf16_t*)(p.ws + WS_AATT);
    bf16_t* Ks = (bf16_t*)shm;
    bf16_t* Vt = (bf16_t*)(shm + 256 * KS_STRIDE * 2);
    const int tid = threadIdx.x, wid = tid >> 6, lane = tid & 63, fr = lane & 15, fq = lane >> 4;
    const int kvh = unit & 3, blk = unit >> 2, n = blk & 127, b = blk >> 7;
    const int tq0 = b * NT + n * 128;
    const int tk0 = tq0 - 128;
    {
        const int key = tid & 255, hc = tid >> 8; const bool valid = (n > 0) || (key >= 128);
        u32x4 o1a = {0, 0, 0, 0}, o1b = {0, 0, 0, 0}, o2a = {0, 0, 0, 0}, o2b = {0, 0, 0, 0};
        if (valid) {
            const size_t tok = (size_t)(tk0 + key);
            const bf16_t* kp = proj + tok * INW + OKK + kvh * 64 + hc * 16;
            const u32x4 x1a = *(const u32x4*)kp, x1b = *(const u32x4*)(kp + 8), x2a = *(const u32x4*)(kp + 32), x2b = *(const u32x4*)(kp + 40);
            const f32x4* rp = (const f32x4*)(rope + tok * 32 + hc * 16);
            unsigned x1[8] = {x1a.x, x1a.y, x1a.z, x1a.w, x1b.x, x1b.y, x1b.z, x1b.w};
            unsigned x2[8] = {x2a.x, x2a.y, x2a.z, x2a.w, x2b.x, x2b.y, x2b.z, x2b.w};
            unsigned r1[8], r2[8];
#pragma unroll
            for (int i = 0; i < 8; ++i) { const f32x4 cs = rp[i];
                const float a0 = bflo(x1[i]), a1 = bfhi(x1[i]), b0 = bflo(x2[i]), b1 = bfhi(x2[i]);
                r1[i] = cvt_pk_bf16(a0 * cs[0] - b0 * cs[1], a1 * cs[2] - b1 * cs[3]);
                r2[i] = cvt_pk_bf16(b0 * cs[0] + a0 * cs[1], b1 * cs[2] + a1 * cs[3]); }
            o1a = (u32x4){r1[0], r1[1], r1[2], r1[3]}; o1b = (u32x4){r1[4], r1[5], r1[6], r1[7]};
            o2a = (u32x4){r2[0], r2[1], r2[2], r2[3]}; o2b = (u32x4){r2[4], r2[5], r2[6], r2[7]};
        }
        bf16_t* kd = Ks + key * KS_STRIDE + hc * 16;
        *(u32x4*)kd = o1a; *(u32x4*)(kd + 8) = o1b; *(u32x4*)(kd + 32) = o2a; *(u32x4*)(kd + 40) = o2b;
    }
    {
        const int kp = tid & 127, dc = tid >> 7; const bool valid = (n > 0) || (kp >= 64);
        u32x4 va0 = {0, 0, 0, 0}, va1 = {0, 0, 0, 0}, vb0 = {0, 0, 0, 0}, vb1 = {0, 0, 0, 0};
        if (valid) {
            const bf16_t* vp = proj + (size_t)(tk0 + 2 * kp) * INW + OV + kvh * 64 + dc * 16;
            va0 = *(const u32x4*)vp; va1 = *(const u32x4*)(vp + 8); vb0 = *(const u32x4*)(vp + INW); vb1 = *(const u32x4*)(vp + INW + 8);
        }
        const unsigned a[8] = {va0.x, va0.y, va0.z, va0.w, va1.x, va1.y, va1.z, va1.w};
        const unsigned c[8] = {vb0.x, vb0.y, vb0.z, vb0.w, vb1.x, vb1.y, vb1.z, vb1.w};
        unsigned* vd = (unsigned*)(Vt + (dc * 16) * VT_STRIDE + 2 * kp);
#pragma unroll
        for (int i = 0; i < 8; ++i) {
            vd[(2 * i) * (VT_STRIDE / 2)] = (a[i] & 0xffffu) | (c[i] << 16);
            vd[(2 * i + 1) * (VT_STRIDE / 2)] = (a[i] >> 16) | (c[i] & 0xffff0000u);
        }
    }
    __syncthreads();
    const int g = wid >> 1, hq = kvh * 4 + g;
    const float sink = p.sinks[hq];
    for (int qi = 0; qi < 4; ++qi) {
        const int qt = (wid & 1) * 4 + qi, iq = qt * 16 + fr; const size_t tq = (size_t)(tq0 + iq);
        bf16x8 qf0, qf1;
        {
            const bf16_t* qp = proj + tq * INW + OQ + hq * 64 + fq * 8;
            const u32x4 x1 = *(const u32x4*)qp, x2 = *(const u32x4*)(qp + 32);
            const f32x4* rp = (const f32x4*)(rope + tq * 32 + fq * 8);
            const unsigned a[4] = {x1.x, x1.y, x1.z, x1.w}, c[4] = {x2.x, x2.y, x2.z, x2.w}; unsigned r1[4], r2[4];
#pragma unroll
            for (int i = 0; i < 4; ++i) { const f32x4 cs = rp[i];
                const float a0 = bflo(a[i]) * 0.125f, a1 = bfhi(a[i]) * 0.125f, b0 = bflo(c[i]) * 0.125f, b1 = bfhi(c[i]) * 0.125f;
                r1[i] = cvt_pk_bf16(a0 * cs[0] - b0 * cs[1], a1 * cs[2] - b1 * cs[3]);
                r2[i] = cvt_pk_bf16(b0 * cs[0] + a0 * cs[1], b1 * cs[2] + a1 * cs[3]); }
            qf0 = mk8(r1[0], r1[1], r1[2], r1[3]); qf1 = mk8(r2[0], r2[1], r2[2], r2[3]);
        }
        f32x4 s[9];
#pragma unroll
        for (int k9 = 0; k9 < 9; ++k9) {
            const bf16_t* kr = Ks + ((qt + k9) * 16 + fr) * KS_STRIDE + fq * 8;
            const bf16x8 a0 = *(const bf16x8*)kr, a1 = *(const bf16x8*)(kr + 32);
            f32x4 z = {0.f, 0.f, 0.f, 0.f};
            z = __builtin_amdgcn_mfma_f32_16x16x32_bf16(a0, qf0, z, 0, 0, 0);
            s[k9] = __builtin_amdgcn_mfma_f32_16x16x32_bf16(a1, qf1, z, 0, 0, 0);
        }
        float mx = sink;
#pragma unroll
        for (int k9 = 0; k9 < 9; ++k9)
#pragma unroll
            for (int j = 0; j < 4; ++j) { const int jw = (qt + k9) * 16 + fq * 4 + j;
                const bool vis = (jw > iq) && (jw <= iq + 128) && (n > 0 || jw >= 128);
                s[k9][j] = vis ? s[k9][j] : -INFINITY; mx = fmaxf(mx, s[k9][j]); }
        mx = fmaxf(mx, __shfl_xor(mx, 16)); mx = fmaxf(mx, __shfl_xor(mx, 32));
        float l = 0.f;
#pragma unroll
        for (int k9 = 0; k9 < 9; ++k9)
#pragma unroll
            for (int j = 0; j < 4; ++j) { const float e = __expf(s[k9][j] - mx); s[k9][j] = e; l += e; }
        l += __shfl_xor(l, 16); l += __shfl_xor(l, 32);
        l += __expf(sink - mx);
        const float inv_l = 1.0f / l;
        bf16x8 pf[5];
#pragma unroll
        for (int pp = 0; pp < 4; ++pp) pf[pp] = mk8(cvt_pk_bf16(s[2 * pp][0], s[2 * pp][1]), cvt_pk_bf16(s[2 * pp][2], s[2 * pp][3]), cvt_pk_bf16(s[2 * pp + 1][0], s[2 * pp + 1][1]), cvt_pk_bf16(s[2 * pp + 1][2], s[2 * pp + 1][3]));
        pf[4] = mk8(cvt_pk_bf16(s[8][0], s[8][1]), cvt_pk_bf16(s[8][2], s[8][3]), 0u, 0u);
        f32x4 o[4];
#pragma unroll
        for (int nt = 0; nt < 4; ++nt) { o[nt] = (f32x4){0.f, 0.f, 0.f, 0.f};
            const bf16_t* vr = Vt + (nt * 16 + fr) * VT_STRIDE + fq * 4;
#pragma unroll
            for (int pp = 0; pp < 5; ++pp) { const int kta = qt + 2 * pp, ktb = (kta + 1 > 15) ? 15 : kta + 1;
                const u32x2 lo = *(const u32x2*)(vr + kta * 16), hi = *(const u32x2*)(vr + ktb * 16);
                o[nt] = __builtin_amdgcn_mfma_f32_16x16x32_bf16(mk8(lo.x, lo.y, hi.x, hi.y), pf[pp], o[nt], 0, 0, 0); } }
#pragma unroll
        for (int nt = 0; nt < 4; ++nt) { const int col = hq * 64 + nt * 16 + fq * 4;
            const u32x2 gt = *(const u32x2*)(proj + tq * INW + OAG + col);
            u32x2 w; w.x = cvt_pk_bf16(o[nt][0] * inv_l * bflo(gt.x), o[nt][1] * inv_l * bfhi(gt.x)); w.y = cvt_pk_bf16(o[nt][2] * inv_l * bflo(gt.y), o[nt][3] * inv_l * bfhi(gt.y));
            *(u32x2*)(Aatt + tq * 1024 + col) = w; }
    }
    __syncthreads();
}

constexpr int H_STRIDE64 = 72;
constexpr int H_STRIDE128 = 136;
struct HgrnCol { float lf_prefix[16]; float kk[16]; };
__device__ __forceinline__ void hgrn_gates(const Params& p, const bf16_t* proj, size_t r0, int h, int d, int seg, float (&bp)[16], float (&kk)[16]) {
    const int col = h * 128 + d;
    const float a0 = p.lbt[col], a1 = p.lbt[1024 + col];
    const float lb = fast_rcp(1.0f + __expf(a1 - a0));
    float run = 0.f;
#pragma unroll
    for (int i = 0; i < 16; ++i) {
        const float hf = bf2f(proj[(r0 + seg * 16 + i) * INW + OHF + col]);
        const float e = __expf(-hf), inv = fast_rcp(1.0f + e);
        const float f = lb + (1.0f - lb) * inv;
        kk[i] = (1.0f - lb) * e * inv;
        run += __logf(f); bp[i] = run;
    }
}

__device__ __forceinline__ void hgrn_local_unit(const Params& p, unsigned char* shm, int u) {
    const bf16_t* proj = (const bf16_t*)(p.ws + WS_PROJ);
    float* UT = p.out + (size_t)u * 16384; float* dtot = (float*)(p.ws + WS_DTOT) + (size_t)u * 128;
    bf16_t* KdT = (bf16_t*)shm;
    bf16_t* Vt = (bf16_t*)(shm + 128 * H_STRIDE64 * 2);
    float* segsum = (float*)(shm + 2 * 128 * H_STRIDE64 * 2);
    const int tid = threadIdx.x, wid = tid >> 6, lane = tid & 63, fr = lane & 15, fq = lane >> 4;
    const int c = u & 255, sq = u >> 8, h = sq & 7, b = sq >> 3; const size_t r0 = (size_t)b * NT + (size_t)c * 64;
    const int d = tid & 127, seg = tid >> 7;
    float bp[16], kk[16];
    hgrn_gates(p, proj, r0, h, d, seg, bp, kk);
    segsum[seg * 128 + d] = bp[15];
    { unsigned w[8];
#pragma unroll
      for (int i = 0; i < 8; ++i) { const unsigned lo = proj[(r0 + seg * 16 + 2 * i) * INW + OHI + h * 128 + d], hi = proj[(r0 + seg * 16 + 2 * i + 1) * INW + OHI + h * 128 + d]; w[i] = lo | (hi << 16); }
      bf16_t* vd = Vt + d * H_STRIDE64 + seg * 16; *(u32x4*)vd = (u32x4){w[0], w[1], w[2], w[3]}; *(u32x4*)(vd + 8) = (u32x4){w[4], w[5], w[6], w[7]}; }
    __syncthreads();
    float off = 0.f, btot = 0.f;
#pragma unroll
    for (int s2 = 0; s2 < 4; ++s2) { const float v = segsum[s2 * 128 + d]; btot += v; if (s2 < seg) off += v; }
    { unsigned w[8];
#pragma unroll
      for (int i = 0; i < 8; ++i) { const float k0 = kk[2 * i] * __expf(btot - (off + bp[2 * i])), k1 = kk[2 * i + 1] * __expf(btot - (off + bp[2 * i + 1])); w[i] = cvt_pk_bf16(k0, k1); }
      bf16_t* kd = KdT + d * H_STRIDE64 + seg * 16; *(u32x4*)kd = (u32x4){w[0], w[1], w[2], w[3]}; *(u32x4*)(kd + 8) = (u32x4){w[4], w[5], w[6], w[7]}; }
    if (seg == 0) dtot[d] = __expf(btot);
    __syncthreads();
    f32x4 acc[8];
#pragma unroll
    for (int vt = 0; vt < 8; ++vt) acc[vt] = (f32x4){0.f, 0.f, 0.f, 0.f};
#pragma unroll
    for (int ks = 0; ks < 2; ++ks) { const bf16x8 a = *(const bf16x8*)(KdT + (16 * wid + fr) * H_STRIDE64 + ks * 32 + fq * 8);
#pragma unroll
        for (int vt = 0; vt < 8; ++vt) { const bf16x8 bv = *(const bf16x8*)(Vt + (16 * vt + fr) * H_STRIDE64 + ks * 32 + fq * 8);
            acc[vt] = __builtin_amdgcn_mfma_f32_16x16x32_bf16(a, bv, acc[vt], 0, 0, 0); } }
#pragma unroll
    for (int vt = 0; vt < 8; ++vt) *(f32x4*)(UT + (size_t)(16 * vt + fr) * 128 + 16 * wid + fq * 4) = acc[vt];
    __syncthreads();
}

__device__ __forceinline__ void hgrn_scan(const Params& p) {
    const float* dtot = (const float*)(p.ws + WS_DTOT);
    for (int gidx = blockIdx.x * 512 + threadIdx.x; gidx < 16 * 8192; gidx += gridDim.x * 512) {
        const int sq = gidx >> 13, e = (gidx & 8191) * 2, d = e & 127;
        float* base = p.out + (size_t)sq * 256 * 16384 + e; const float* db = dtot + (size_t)sq * 256 * 128 + d;
        f32x2 S = {0.f, 0.f};
        for (int c0 = 0; c0 < 256; c0 += 8) {
            f32x2 U[8], D[8];
#pragma unroll
            for (int i = 0; i < 8; ++i) { U[i] = *(const f32x2*)(base + (size_t)(c0 + i) * 16384); D[i] = *(const f32x2*)(db + (size_t)(c0 + i) * 128); }
#pragma unroll
            for (int i = 0; i < 8; ++i) { *(f32x2*)(base + (size_t)(c0 + i) * 16384) = S; S = D[i] * S + U[i]; }
        }
    }
}

__device__ __forceinline__ void hgrn_out_unit(const Params& p, unsigned char* shm, int u) {
    const bf16_t* proj = (const bf16_t*)(p.ws + WS_PROJ);
    const float* ST = p.out + (size_t)u * 16384;
    bf16_t* Ahg = (bf16_t*)(p.ws + WS_AHGR);
    bf16_t* Qs = (bf16_t*)shm;
    bf16_t* Ks2 = (bf16_t*)(shm + 64 * H_STRIDE128 * 2);
    bf16_t* Vt = (bf16_t*)(shm + 2 * 64 * H_STRIDE128 * 2);
    bf16_t* St = (bf16_t*)(shm + 2 * 64 * H_STRIDE128 * 2 + 128 * H_STRIDE64 * 2);
    float* segsum = (float*)(shm + 2 * 64 * H_STRIDE128 * 2 + 128 * H_STRIDE64 * 2 + 128 * H_STRIDE128 * 2);
    float* eref = segsum + 512;
    float* part = eref + 128;
    const int tid = threadIdx.x, wid = tid >> 6, lane = tid & 63, fr = lane & 15, fq = lane >> 4;
    const int c = u & 255, sq = u >> 8, h = sq & 7, b = sq >> 3; const size_t r0 = (size_t)b * NT + (size_t)c * 64;
    const int d = tid & 127, seg = tid >> 7;
    f32x4 sv[8];
#pragma unroll
    for (int i = 0; i < 8; ++i) sv[i] = *(const f32x4*)(ST + (size_t)(tid + 512 * i) * 4);
    float bp[16], kk[16];
    hgrn_gates(p, proj, r0, h, d, seg, bp, kk);
    segsum[seg * 128 + d] = bp[15];
    { unsigned w[8];
#pragma unroll
      for (int i = 0; i < 8; ++i) { const unsigned lo = proj[(r0 + seg * 16 + 2 * i) * INW + OHI + h * 128 + d], hi = proj[(r0 + seg * 16 + 2 * i + 1) * INW + OHI + h * 128 + d]; w[i] = lo | (hi << 16); }
      bf16_t* vd = Vt + d * H_STRIDE64 + seg * 16; *(u32x4*)vd = (u32x4){w[0], w[1], w[2], w[3]}; *(u32x4*)(vd + 8) = (u32x4){w[4], w[5], w[6], w[7]}; }
    __syncthreads();
    float off = 0.f;
#pragma unroll
    for (int s2 = 0; s2 < 4; ++s2) { const float v = segsum[s2 * 128 + d]; if (s2 < seg) off += v; }
    const float bref = segsum[d] + segsum[128 + d];
    if (seg == 0) eref[d] = __expf(bref);
#pragma unroll
    for (int i = 0; i < 16; ++i) { const float bb = off + bp[i] - bref; const int t = seg * 16 + i;
        const float qv = bf2f(proj[(r0 + t) * INW + OHQ + h * 128 + d]);
        const unsigned qk = cvt_pk_bf16(qv * __expf(bb), kk[i] * __expf(-bb));
        Qs[t * H_STRIDE128 + d] = (bf16_t)(qk & 0xffffu); Ks2[t * H_STRIDE128 + d] = (bf16_t)(qk >> 16); }
    __syncthreads();
#pragma unroll
    for (int i = 0; i < 8; ++i) { const int idx = tid + 512 * i, v = idx >> 5, d4 = (idx & 31) * 4;
        const f32x4 er = *(const f32x4*)(eref + d4);
        u32x2 w; w.x = cvt_pk_bf16(sv[i][0] * er[0], sv[i][1] * er[1]); w.y = cvt_pk_bf16(sv[i][2] * er[2], sv[i][3] * er[3]);
        *(u32x2*)(St + v * H_STRIDE128 + d4) = w; }
    __syncthreads();
    const int tt = wid & 3, vh = wid >> 2;
    bf16x8 bq[4];
#pragma unroll
    for (int ks = 0; ks < 4; ++ks) bq[ks] = *(const bf16x8*)(Qs + (16 * tt + fr) * H_STRIDE128 + ks * 32 + fq * 8);
    f32x4 pa[4];
#pragma unroll
    for (int st = 0; st < 4; ++st) { pa[st] = (f32x4){0.f, 0.f, 0.f, 0.f};
        if (st <= tt) {
#pragma unroll
            for (int ks = 0; ks < 4; ++ks) { const bf16x8 a = *(const bf16x8*)(Ks2 + (16 * st + fr) * H_STRIDE128 + ks * 32 + fq * 8);
                pa[st] = __builtin_amdgcn_mfma_f32_16x16x32_bf16(a, bq[ks], pa[st], 0, 0, 0); }
#pragma unroll
            for (int j = 0; j < 4; ++j) { const int s_ = 16 * st + fq * 4 + j, t_ = 16 * tt + fr; pa[st][j] = (s_ <= t_) ? pa[st][j] : 0.f; }
        } }
    bf16x8 pf[2];
#pragma unroll
    for (int pp = 0; pp < 2; ++pp) pf[pp] = mk8(cvt_pk_bf16(pa[2 * pp][0], pa[2 * pp][1]), cvt_pk_bf16(pa[2 * pp][2], pa[2 * pp][3]), cvt_pk_bf16(pa[2 * pp + 1][0], pa[2 * pp + 1][1]), cvt_pk_bf16(pa[2 * pp + 1][2], pa[2 * pp + 1][3]));
    f32x4 o[4]; float ss = 0.f;
#pragma unroll
    for (int vt = 0; vt < 4; ++vt) { const int vrow = 16 * (vh * 4 + vt) + fr; o[vt] = (f32x4){0.f, 0.f, 0.f, 0.f};
#pragma unroll
        for (int pp = 0; pp < 2; ++pp) { const u32x2 lo = *(const u32x2*)(Vt + vrow * H_STRIDE64 + (2 * pp) * 16 + fq * 4), hi = *(const u32x2*)(Vt + vrow * H_STRIDE64 + (2 * pp + 1) * 16 + fq * 4);
            o[vt] = __builtin_amdgcn_mfma_f32_16x16x32_bf16(mk8(lo.x, lo.y, hi.x, hi.y), pf[pp], o[vt], 0, 0, 0); }
#pragma unroll
        for (int ks = 0; ks < 4; ++ks) { const bf16x8 a = *(const bf16x8*)(St + vrow * H_STRIDE128 + ks * 32 + fq * 8);
            o[vt] = __builtin_amdgcn_mfma_f32_16x16x32_bf16(a, bq[ks], o[vt], 0, 0, 0); }
        ss += o[vt][0] * o[vt][0] + o[vt][1] * o[vt][1] + o[vt][2] * o[vt][2] + o[vt][3] * o[vt][3]; }
    ss += __shfl_xor(ss, 16); ss += __shfl_xor(ss, 32);
    if (fq == 0) part[vh * 64 + 16 * tt + fr] = ss;
    __syncthreads();
    const float tot = part[16 * tt + fr] + part[64 + 16 * tt + fr];
    const float rstd = rsqrtf(tot * (1.0f / 128.0f) + 1e-6f);
    const size_t r = r0 + 16 * tt + fr;
#pragma unroll
    for (int vt = 0; vt < 4; ++vt) { const int col = h * 128 + 16 * (vh * 4 + vt) + fq * 4;
        const f32x4 gn = *(const f32x4*)(p.hgain + col);
        const u32x2 gt = *(const u32x2*)(proj + r * INW + OHG + col);
        u32x2 w; w.x = cvt_pk_bf16(o[vt][0] * rstd * gn[0] * bflo(gt.x), o[vt][1] * rstd * gn[1] * bfhi(gt.x)); w.y = cvt_pk_bf16(o[vt][2] * rstd * gn[2] * bflo(gt.y), o[vt][3] * rstd * gn[3] * bfhi(gt.y));
        *(u32x2*)(Ahg + r * 1024 + col) = w; }
    __syncthreads();
}

__device__ __forceinline__ void phase_final(const Params& p) {
    const int tid = threadIdx.x, wid = tid >> 6, lane = tid & 63;
    const float* rss = (const float*)(p.ws + WS_RSS);
    const bf16_t* xn = (const bf16_t*)(p.ws + WS_AATT);
    for (int r = blockIdx.x * 8 + wid; r < NTOK; r += gridDim.x * 8) {
        u32x4 xv[4];
#pragma unroll
        for (int i = 0; i < 4; ++i) xv[i] = *(const u32x4*)(xn + (size_t)r * DM + (lane + 64 * i) * 8);
        float ss = (lane < 32) ? rss[(size_t)r * 32 + lane] : 0.f;
        ss = wave_sum(ss);
        const float rstd = rsqrtf(ss * (1.0f / DM) + 1e-6f);
        float* orow = p.out + (size_t)r * DM;
#pragma unroll
        for (int i = 0; i < 4; ++i) { const int c0 = (lane + 64 * i) * 8;
            const f32x4 g0 = *(const f32x4*)(p.fgain + c0), g1 = *(const f32x4*)(p.fgain + c0 + 4);
            f32x4 a, b; a[0] = bflo(xv[i].x) * rstd * g0[0]; a[1] = bfhi(xv[i].x) * rstd * g0[1]; a[2] = bflo(xv[i].y) * rstd * g0[2]; a[3] = bfhi(xv[i].y) * rstd * g0[3];
            b[0] = bflo(xv[i].z) * rstd * g1[0]; b[1] = bfhi(xv[i].z) * rstd * g1[1]; b[2] = bflo(xv[i].w) * rstd * g1[2]; b[3] = bfhi(xv[i].w) * rstd * g1[3];
            *(f32x4*)(orow + c0) = a; *(f32x4*)(orow + c0 + 4) = b; }
    }
}

#define REP1 1
#define REP2 1
#define REP4 1
#define REP5 1
#define REP6 1
__global__ void __launch_bounds__(512, 2) fwd_megakernel(Params p) {
    extern __shared__ __attribute__((aligned(16))) unsigned char shm[];
    cg::grid_group grid = cg::this_grid();
    const int G = (int)gridDim.x, c = (int)blockIdx.x;
    phase_prep(p, shm);
    grid.sync();
    { pg8::Gemm g; g.A0 = (const bf16_t*)(p.ws + WS_HA); g.B0 = (const bf16_t*)(p.ws + WS_WIN); g.A1 = g.A0; g.B1 = g.B0; g.M = NTOK; g.N = INW; g.K = DM;
      pg8::StaticOrder S; S.init(NTOK, INW, G, c, 0, REP1); EpiProj E; E.O = (bf16_t*)(p.ws + WS_PROJ);
      pg8::gemm_phase<EpiProj>((LAS unsigned char*)shm, g, S, E); }
    grid.sync();
    for (int rep = 0; rep < REP2; ++rep) {
    for (int u = c; u < NAU; u += G) attn_unit(p, shm, u);
    for (int u = c; u < NHU; u += G) hgrn_local_unit(p, shm, u); }
    grid.sync();
    hgrn_scan(p);
    grid.sync();
    for (int rep = 0; rep < REP4; ++rep) for (int u = c; u < NHU; u += G) hgrn_out_unit(p, shm, u);
    grid.sync();
    { pg8::Gemm g; g.A0 = (const bf16_t*)(p.ws + WS_AATT); g.B0 = (const bf16_t*)(p.ws + WS_WAO); g.A1 = (const bf16_t*)(p.ws + WS_AHGR); g.B1 = (const bf16_t*)(p.ws + WS_WHO); g.M = NTOK; g.N = DM; g.K = 1024;
      pg8::StaticOrder S; S.init(NTOK, DM, G, c, 1, REP5); EpiMerge E; E.proj = (const bf16_t*)(p.ws + WS_PROJ); E.O = (bf16_t*)(p.ws + WS_HA);
      pg8::gemm_phase<EpiMerge>((LAS unsigned char*)shm, g, S, E); }
    grid.sync();
    { pg8::Gemm g; g.A0 = (const bf16_t*)(p.ws + WS_HA); g.B0 = (const bf16_t*)(p.ws + WS_WO); g.A1 = g.A0; g.B1 = g.B0; g.M = NTOK; g.N = DM; g.K = DM;
      pg8::StaticOrder S; S.init(NTOK, DM, G, c, 0, REP6); EpiResid E; E.X = p.x; E.O = (bf16_t*)(p.ws + WS_AATT); E.rss = (float*)(p.ws + WS_RSS);
      pg8::gemm_phase<EpiResid>((LAS unsigned char*)shm, g, S, E); }
    grid.sync();
    phase_final(p);
}

extern "C" void kernel_launch(void* const* d_in, const int* in_sizes, int n_in, void* d_out, int out_size, void* d_ws, size_t ws_size, hipStream_t stream) {
    constexpr size_t kDynLds = pg8::STAGE_BYTES;
    static int grid_blocks = 0;
    if (grid_blocks == 0) {
        if (ws_size < WS_END) { fprintf(stderr, "kernel_launch: workspace too small: %zu < %zu\n", ws_size, (size_t)WS_END); grid_blocks = -1; return; }
        int dev = 0, cus = 0, per_cu = 0;
        (void)hipGetDevice(&dev);
        (void)hipDeviceGetAttribute(&cus, hipDeviceAttributeMultiprocessorCount, dev);
        if (hipFuncSetAttribute((const void*)fwd_megakernel, hipFuncAttributeMaxDynamicSharedMemorySize, (int)kDynLds) != hipSuccess) { fprintf(stderr, "kernel_launch: hipFuncSetAttribute failed\n"); grid_blocks = -1; return; }
        if (hipOccupancyMaxActiveBlocksPerMultiprocessor(&per_cu, (const void*)fwd_megakernel, 512, kDynLds) != hipSuccess || per_cu < 1) { fprintf(stderr, "kernel_launch: occupancy query failed (%d)\n", per_cu); (void)hipGetLastError(); grid_blocks = -1; return; }
        if (per_cu > 1) per_cu = 1;
        grid_blocks = cus * per_cu;
    }
    if (grid_blocks < 0) return;
    Params p{};
    p.x = (const float*)d_in[0]; p.pos = (const int*)d_in[1]; p.norm_gain = (const float*)d_in[2]; p.w_in = (const float*)d_in[3]; p.sinks = (const float*)d_in[4];
    p.lbt = (const float*)d_in[5]; p.hgain = (const float*)d_in[6]; p.w_ao = (const float*)d_in[7]; p.w_ho = (const float*)d_in[8]; p.w_o = (const float*)d_in[9];
    p.fgain = (const float*)d_in[10]; p.out = (float*)d_out; p.ws = (unsigned char*)d_ws;
    void* args[] = {&p};
    hipError_t e = hipLaunchCooperativeKernel((const void*)fwd_megakernel, dim3(grid_blocks), dim3(512), args, kDynLds, stream);
    if (e != hipSuccess) fprintf(stderr, "cooperative launch failed: %s (grid %d)\n", hipGetErrorString(e), grid_blocks);
}
```

```cpp
#include <hip/hip_runtime.h>
#include <hip/hip_cooperative_groups.h>
#include <cstdio>
namespace cg = cooperative_groups;

#define LAS __attribute__((address_space(3)))
typedef unsigned short bf16_t;
typedef short bf16x8 __attribute__((ext_vector_type(8)));
typedef float f32x4 __attribute__((ext_vector_type(4)));
typedef float f32x2 __attribute__((ext_vector_type(2)));
typedef unsigned u32x4 __attribute__((ext_vector_type(4)));
typedef unsigned u32x2 __attribute__((ext_vector_type(2)));

constexpr int NB = 2, NT = 16384, NTOK = NB * NT, DM = 2048, INW = 10752;
constexpr int OQ = 0, OKK = 1024, OV = 1280, OAG = 1536, OHQ = 2560, OHF = 3584, OHI = 4608, OHG = 5632, OMA = 6656, OMH = 8704;
constexpr int NCHUNK = NT / 64;
constexpr int NHU = NB * 8 * NCHUNK;
constexpr int NAU = NB * (NT / 128) * 4;

constexpr size_t WS_HA = 0;
constexpr size_t WS_WIN = WS_HA + (size_t)NTOK * DM * 2;
constexpr size_t WS_WAO = WS_WIN + (size_t)INW * DM * 2;
constexpr size_t WS_WHO = WS_WAO + (size_t)DM * 1024 * 2;
constexpr size_t WS_WO = WS_WHO + (size_t)DM * 1024 * 2;
constexpr size_t WS_PROJ = WS_WO + (size_t)DM * DM * 2;
constexpr size_t WS_ROPE = WS_PROJ + (size_t)NTOK * INW * 2;
constexpr size_t WS_AATT = WS_ROPE + (size_t)NTOK * 32 * 8;
constexpr size_t WS_AHGR = WS_AATT + (size_t)NTOK * 1024 * 2;
constexpr size_t WS_DTOT = WS_AHGR + (size_t)NTOK * 1024 * 2;
constexpr size_t WS_RSS = WS_DTOT + (size_t)NHU * 128 * 4;
constexpr size_t WS_END = WS_RSS + (size_t)NTOK * 32 * 4;

struct Params {
    const float* x; const int* pos; const float* norm_gain; const float* w_in; const float* sinks; const float* lbt;
    const float* hgain; const float* w_ao; const float* w_ho; const float* w_o; const float* fgain;
    float* out; unsigned char* ws;
};

__constant__ float c_inv_freq[32] = {
    1.0f, 0.749894261f, 0.562341332f, 0.421696514f, 0.316227764f, 0.237137377f, 0.177827939f, 0.133352131f, 0.100000001f, 0.0749894157f,
    0.0562341325f, 0.0421696529f, 0.0316227749f, 0.0237137377f, 0.0177827943f, 0.0133352149f, 0.00999999978f, 0.00749894185f,
    0.00562341325f, 0.00421696482f, 0.00316227763f, 0.00237137359f, 0.00177827943f, 0.00133352145f, 0.00100000005f, 0.000749894243f,
    0.000562341302f, 0.000421696517f, 0.000316227757f, 0.00023713737f, 0.00017782794f, 0.00013335215f};

__device__ __forceinline__ float bf2f(bf16_t b) { return __uint_as_float(((unsigned)b) << 16); }
__device__ __forceinline__ float bflo(unsigned w) { return __uint_as_float(w << 16); }
__device__ __forceinline__ float bfhi(unsigned w) { return __uint_as_float(w & 0xffff0000u); }
__device__ __forceinline__ unsigned cvt_pk_bf16(float lo, float hi) { unsigned r; asm volatile("v_cvt_pk_bf16_f32 %0, %1, %2" : "=v"(r) : "v"(lo), "v"(hi)); return r; }
__device__ __forceinline__ float fast_rcp(float x) { return __builtin_amdgcn_rcpf(x); }
__device__ __forceinline__ float sigmoidf_(float v) { return fast_rcp(1.0f + __expf(-v)); }
__device__ __forceinline__ float wave_sum(float v) {
#pragma unroll
    for (int o = 32; o > 0; o >>= 1) v += __shfl_xor(v, o);
    return v;
}
__device__ __forceinline__ bf16x8 mk8(unsigned a, unsigned b, unsigned c, unsigned d) { u32x4 w; w.x = a; w.y = b; w.z = c; w.w = d; return __builtin_bit_cast(bf16x8, w); }

namespace pg8 {
constexpr int BM = 256, BK = 64, HALF = 128, HTB = HALF * BK * 2, STAGE_BYTES = 8 * HTB, NXCD = 8, WGM = 8;
__host__ __device__ __forceinline__ int lds_byte(int r, int c) { const int st = (r >> 4) * 2 + (c >> 5), rr = r & 15, cc = c & 31, ob = rr * 64 + cc * 2; return st * 1024 + (ob ^ (((ob >> 9) & 1) << 5)); }
__host__ __device__ __forceinline__ void stage_rc(int b, int& R, int& C) { const int st = b / 1024, sb = b % 1024, swz = sb ^ (((sb >> 9) & 1) << 5); R = (st >> 1) * 16 + swz / 64; C = (st & 1) * 32 + (swz % 64) / 2; }
__host__ __device__ __forceinline__ int perm32(int rho) { const int n = rho >> 4, i = rho & 15; return 8 * (i >> 2) + 4 * n + (i & 3); }

struct Unit { int pm, pn, kind; };
struct Gemm { const bf16_t* A0; const bf16_t* B0; const bf16_t* A1; const bf16_t* B1; int M, N, K; };

struct StaticOrder {
    int nM, nN, nwg, G, c, dual, R, reps;
    __device__ void init(int M, int N, int G_, int c_, int dual_, int reps_ = 1) { nM = M / BM; nN = N / BM; nwg = nM * nN; G = G_; c = c_; dual = dual_; R = (nwg + G - 1) / G; reps = reps_; }
    __device__ bool next(int i, Unit& u) const {
        if (i >= reps * (R << dual)) return false;
        const int it = (i >> dual) % R;
        const long L = (long)it * G + c; if (L >= nwg) return false;
        int wgid = (int)L; { const int q = nwg / NXCD, r = nwg % NXCD, xcd = wgid % NXCD, off = wgid / NXCD; wgid = (xcd < r ? xcd * (q + 1) : r * (q + 1) + (xcd - r) * q) + off; }
        const int nig = WGM * nN, gid = wgid / nig, fm = gid * WGM, gsz = (nM - fm) < WGM ? (nM - fm) : WGM;
        u.pm = fm + ((wgid % nig) % gsz); u.pn = (wgid % nig) / gsz; u.kind = i & dual; return true;
    }
};

template <class Epi>
__device__ __forceinline__ void gemm_phase(LAS unsigned char* lds, const Gemm g, const StaticOrder& S, const Epi& E) {
    const int tid = threadIdx.x, wid = __builtin_amdgcn_readfirstlane(tid >> 6), lane = tid & 63, wr = wid >> 2, wc = wid & 3, fr = lane & 15, fq = lane >> 4;
    const int K = g.K, nt = K / BK;
    unsigned voffA[2], voffB[2];
#pragma unroll
    for (int i = 0; i < 2; ++i) { int R, C; stage_rc(tid * 16 + i * 8192, R, C); const int Rb = Epi::PERM ? ((R & ~31) + perm32(R & 31)) : R;
        voffA[i] = (unsigned)(R * K + C) * 2u; voffB[i] = (unsigned)(Rb * K + C) * 2u; }
    const size_t kstep = (size_t)(BK * 2);
    const size_t hstep = (size_t)HALF * K * 2;
    const size_t tstep = 2 * hstep;
    const unsigned ldsw = (unsigned)wid * 1024u;
    const int aoff = lds_byte(wr * 64 + fr, fq * 8), boff = lds_byte(wc * 32 + fr, fq * 8);
#define PG8_SA(b, h) (((b) * 2 + (h)) * HTB)
#define PG8_SB(b, h) ((4 + (b) * 2 + (h)) * HTB)
#define PG8_STAGE(bufoff, gbase, voff) do { _Pragma("unroll") for (int _i = 0; _i < 2; ++_i) \
        __builtin_amdgcn_global_load_lds((const unsigned*)((const char*)(gbase) + (voff)[_i]), (LAS unsigned*)(lds + (bufoff) + ldsw + _i * 8192), 16, 0, 0); } while (0)
#define PG8_LDA(dst, b, h) do { _Pragma("unroll") for (int m = 0; m < 4; ++m) _Pragma("unroll") for (int k = 0; k < 2; ++k) dst[m][k] = *(const LAS bf16x8*)(lds + PG8_SA(b, h) + aoff + m * 2048 + k * 1024); } while (0)
#define PG8_LDB(dst, b, h) do { _Pragma("unroll") for (int n = 0; n < 2; ++n) _Pragma("unroll") for (int k = 0; k < 2; ++k) dst[n][k] = *(const LAS bf16x8*)(lds + PG8_SB(b, h) + boff + n * 2048 + k * 1024); } while (0)
#define PG8_MMA(ai, bj, At, Bt) do { __builtin_amdgcn_s_setprio(1); _Pragma("unroll") for (int m = 0; m < 4; ++m) _Pragma("unroll") for (int n = 0; n < 2; ++n) _Pragma("unroll") for (int k = 0; k < 2; ++k) \
        acc[ai][bj][m][n] = __builtin_amdgcn_mfma_f32_16x16x32_bf16(Bt[n][k], At[m][k], acc[ai][bj][m][n], 0, 0, 0); __builtin_amdgcn_s_setprio(0); } while (0)
#define PG8_WAIT_V(n) asm volatile("s_waitcnt vmcnt(" #n ")" ::: "memory")
#define PG8_WAIT_L(n) asm volatile("s_waitcnt lgkmcnt(" #n ")" ::: "memory")
#define PG8_BAR __builtin_amdgcn_s_barrier()
#define PG8_SCHED __builtin_amdgcn_sched_barrier(0)
    Unit cur, nxt; int ui = 0;
    if (!S.next(0, cur)) return;
    f32x4 acc[2][2][4][2];
#pragma unroll
    for (int a = 0; a < 2; ++a)
#pragma unroll
        for (int b = 0; b < 2; ++b)
#pragma unroll
            for (int m = 0; m < 4; ++m)
#pragma unroll
                for (int n = 0; n < 2; ++n) acc[a][b][m][n] = (f32x4){0.f, 0.f, 0.f, 0.f};
    bf16x8 At[4][2], B0[2][2], B1[2][2];
    const char* cA = (const char*)(cur.kind ? g.A1 : g.A0) + (size_t)cur.pm * tstep; const char* cB = (const char*)(cur.kind ? g.B1 : g.B0) + (size_t)cur.pn * tstep;
    PG8_STAGE(PG8_SB(0, 0), cB, voffB); PG8_STAGE(PG8_SA(0, 0), cA, voffA); PG8_STAGE(PG8_SB(0, 1), cB + hstep, voffB); PG8_STAGE(PG8_SA(0, 1), cA + hstep, voffA);
    if (wr == 1) PG8_BAR;
    PG8_WAIT_V(4); PG8_BAR;
    PG8_STAGE(PG8_SB(1, 0), cB + kstep, voffB); PG8_STAGE(PG8_SA(1, 0), cA + kstep, voffA); PG8_STAGE(PG8_SB(1, 1), cB + hstep + kstep, voffB);
    PG8_WAIT_V(6); PG8_BAR;
    for (;;) {
        const bool has_next = S.next(ui + 1, nxt);
        const char* nA = has_next ? (const char*)(nxt.kind ? g.A1 : g.A0) + (size_t)nxt.pm * tstep : cA; const char* nB = has_next ? (const char*)(nxt.kind ? g.B1 : g.B0) + (size_t)nxt.pn * tstep : cB;
        for (int t = 0; t < nt; t += 2) {
            const bool last = (t == nt - 2);
            const char* a1 = cA + (size_t)(t + 1) * kstep;
            const char* a2 = last ? nA : cA + (size_t)(t + 2) * kstep; const char* b2 = last ? nB : cB + (size_t)(t + 2) * kstep;
            const char* a3 = a2 + kstep; const char* b3 = b2 + kstep;
            PG8_LDB(B0, 0, 0); PG8_SCHED; PG8_LDA(At, 0, 0); PG8_STAGE(PG8_SA(1, 1), a1 + hstep, voffA);
            PG8_WAIT_L(8); PG8_BAR; PG8_WAIT_L(0); PG8_MMA(0, 0, At, B0); PG8_BAR; PG8_SCHED;
            PG8_LDB(B1, 0, 1); PG8_STAGE(PG8_SB(0, 0), b2, voffB);
            PG8_BAR; PG8_WAIT_L(0); PG8_MMA(0, 1, At, B1); PG8_BAR;
            PG8_LDA(At, 0, 1); PG8_STAGE(PG8_SA(0, 0), a2, voffA);
            PG8_BAR; PG8_WAIT_L(0); PG8_MMA(1, 0, At, B0); PG8_BAR; PG8_SCHED;
            PG8_STAGE(PG8_SB(0, 1), b2 + hstep, voffB);
            PG8_WAIT_V(6); PG8_BAR; PG8_MMA(1, 1, At, B1); PG8_BAR;
            PG8_LDB(B0, 1, 0); PG8_SCHED; PG8_LDA(At, 1, 0); PG8_STAGE(PG8_SA(0, 1), a2 + hstep, voffA);
            PG8_WAIT_L(8); PG8_BAR; PG8_WAIT_L(0); PG8_MMA(0, 0, At, B0); PG8_BAR; PG8_SCHED;
            PG8_LDB(B1, 1, 1); PG8_STAGE(PG8_SB(1, 0), b3, voffB);
            PG8_BAR; PG8_WAIT_L(0); PG8_MMA(0, 1, At, B1); PG8_BAR;
            PG8_LDA(At, 1, 1); PG8_STAGE(PG8_SA(1, 0), a3, voffA);
            PG8_BAR; PG8_WAIT_L(0); PG8_MMA(1, 0, At, B0); PG8_BAR; PG8_SCHED;
            PG8_STAGE(PG8_SB(1, 1), b3 + hstep, voffB);
            PG8_WAIT_V(6); PG8_BAR; PG8_MMA(1, 1, At, B1); PG8_BAR;
        }
        const bool keep = E(acc, cur, wr, wc, fr, fq);
        if (!has_next) break;
        if (!keep) {
#pragma unroll
            for (int a = 0; a < 2; ++a)
#pragma unroll
                for (int b = 0; b < 2; ++b)
#pragma unroll
                    for (int m = 0; m < 4; ++m)
#pragma unroll
                        for (int n = 0; n < 2; ++n) acc[a][b][m][n] = (f32x4){0.f, 0.f, 0.f, 0.f};
        }
        cur = nxt; cA = nA; cB = nB; ++ui;
    }
    PG8_WAIT_V(0);
    if (wr == 0) PG8_BAR;
    PG8_BAR;
#undef PG8_SA
#undef PG8_SB
#undef PG8_STAGE
#undef PG8_LDA
#undef PG8_LDB
#undef PG8_MMA
#undef PG8_WAIT_V
#undef PG8_WAIT_L
#undef PG8_BAR
#undef PG8_SCHED
}
}

struct EpiProj {
    static constexpr bool PERM = true;
    bf16_t* O;
    __device__ __forceinline__ bool operator()(f32x4 (&acc)[2][2][4][2], const pg8::Unit& u, int wr, int wc, int fr, int fq) const {
        const int pn = u.pn;
        int mode = 0; float scale = 1.0f;
        if ((pn >= 6 && pn < 10) || (pn >= 22 && pn < 26)) mode = 1;
        else if (pn >= 10 && pn < 14) { mode = 1; scale = 0.08838834764831845f; }
        else if (pn >= 26) mode = 2;
        const int row0 = u.pm * 256 + wr * 64 + fr, col0 = pn * 256 + wc * 32 + 8 * fq;
#pragma unroll
        for (int ai = 0; ai < 2; ++ai)
#pragma unroll
            for (int m = 0; m < 4; ++m) { bf16_t* rowp = O + (size_t)(row0 + ai * 128 + m * 16) * INW + col0;
#pragma unroll
                for (int bj = 0; bj < 2; ++bj) { f32x4 v0 = acc[ai][bj][m][0], v1 = acc[ai][bj][m][1];
                    if (mode != 0) {
#pragma unroll
                        for (int j = 0; j < 4; ++j) { const float s0 = sigmoidf_(v0[j]), s1 = sigmoidf_(v1[j]);
                            v0[j] = (mode == 1) ? v0[j] * s0 * scale : s0; v1[j] = (mode == 1) ? v1[j] * s1 * scale : s1; }
                    }
                    u32x4 w; w.x = cvt_pk_bf16(v0[0], v0[1]); w.y = cvt_pk_bf16(v0[2], v0[3]); w.z = cvt_pk_bf16(v1[0], v1[1]); w.w = cvt_pk_bf16(v1[2], v1[3]);
                    *(u32x4*)(rowp + bj * 128) = w; } }
        return false;
    }
};
struct EpiMerge {
    static constexpr bool PERM = true;
    const bf16_t* proj; bf16_t* O;
    __device__ __forceinline__ bool operator()(f32x4 (&acc)[2][2][4][2], const pg8::Unit& u, int wr, int wc, int fr, int fq) const {
        const int row0 = u.pm * 256 + wr * 64 + fr, col0 = u.pn * 256 + wc * 32 + 8 * fq;
#pragma unroll
        for (int ai = 0; ai < 2; ++ai)
#pragma unroll
            for (int m = 0; m < 4; ++m) { const size_t r = (size_t)(row0 + ai * 128 + m * 16);
#pragma unroll
                for (int bj = 0; bj < 2; ++bj) { const int c = col0 + bj * 128;
                    const u32x4 g2 = *(const u32x4*)(proj + r * INW + OMH + c);
                    float s2[8] = {bflo(g2.x), bfhi(g2.x), bflo(g2.y), bfhi(g2.y), bflo(g2.z), bfhi(g2.z), bflo(g2.w), bfhi(g2.w)};
                    if (u.kind == 0) {
                        const u32x4 g1 = *(const u32x4*)(proj + r * INW + OMA + c);
                        float s1[8] = {bflo(g1.x), bfhi(g1.x), bflo(g1.y), bfhi(g1.y), bflo(g1.z), bfhi(g1.z), bflo(g1.w), bfhi(g1.w)};
#pragma unroll
                        for (int j = 0; j < 4; ++j) { acc[ai][bj][m][0][j] *= s1[j] * fast_rcp(fmaxf(s2[j], 1e-20f)); acc[ai][bj][m][1][j] *= s1[4 + j] * fast_rcp(fmaxf(s2[4 + j], 1e-20f)); }
                    } else {
                        const f32x4 v0 = acc[ai][bj][m][0], v1 = acc[ai][bj][m][1];
                        u32x4 w; w.x = cvt_pk_bf16(v0[0] * s2[0], v0[1] * s2[1]); w.y = cvt_pk_bf16(v0[2] * s2[2], v0[3] * s2[3]);
                        w.z = cvt_pk_bf16(v1[0] * s2[4], v1[1] * s2[5]); w.w = cvt_pk_bf16(v1[2] * s2[6], v1[3] * s2[7]);
                        *(u32x4*)(O + r * DM + c) = w;
                    } } }
        return u.kind == 0;
    }
};
struct EpiResid {
    static constexpr bool PERM = true;
    const float* X; bf16_t* O; float* rss;
    __device__ __forceinline__ bool operator()(f32x4 (&acc)[2][2][4][2], const pg8::Unit& u, int wr, int wc, int fr, int fq) const {
        const int row0 = u.pm * 256 + wr * 64 + fr, col0 = u.pn * 256 + wc * 32 + 8 * fq;
#pragma unroll
        for (int ai = 0; ai < 2; ++ai)
#pragma unroll
            for (int m = 0; m < 4; ++m) { const size_t r = (size_t)(row0 + ai * 128 + m * 16); float ss = 0.f;
#pragma unroll
                for (int bj = 0; bj < 2; ++bj) { const size_t o = r * DM + col0 + bj * 128;
                    const f32x4 v0 = *(const f32x4*)(X + o) + acc[ai][bj][m][0], v1 = *(const f32x4*)(X + o + 4) + acc[ai][bj][m][1];
                    ss += v0[0] * v0[0] + v0[1] * v0[1] + v0[2] * v0[2] + v0[3] * v0[3] + v1[0] * v1[0] + v1[1] * v1[1] + v1[2] * v1[2] + v1[3] * v1[3];
                    u32x4 w; w.x = cvt_pk_bf16(v0[0], v0[1]); w.y = cvt_pk_bf16(v0[2], v0[3]); w.z = cvt_pk_bf16(v1[0], v1[1]); w.w = cvt_pk_bf16(v1[2], v1[3]);
                    *(u32x4*)(O + o) = w; }
                ss += __shfl_xor(ss, 16); ss += __shfl_xor(ss, 32);
                if (fq == 0) rss[r * 32 + u.pn * 4 + wc] = ss; }
        return false;
    }
};

__device__ __forceinline__ void transpose_tile_wave(const float* __restrict__ W, int K, int N, bf16_t* __restrict__ WT, int tile, int lane) {
    const int ntn = N >> 6; const int k0 = (tile / ntn) * 64, n0 = (tile % ntn) * 64;
    const float* src = W + (size_t)k0 * N + n0 + lane;
    float v[64];
#pragma unroll
    for (int i = 0; i < 64; ++i) v[i] = src[(size_t)i * N];
    bf16_t* dst = WT + (size_t)(n0 + lane) * K + k0;
#pragma unroll
    for (int i = 0; i < 8; ++i) { u32x4 w; w.x = cvt_pk_bf16(v[8 * i], v[8 * i + 1]); w.y = cvt_pk_bf16(v[8 * i + 2], v[8 * i + 3]); w.z = cvt_pk_bf16(v[8 * i + 4], v[8 * i + 5]); w.w = cvt_pk_bf16(v[8 * i + 6], v[8 * i + 7]);
        *(u32x4*)(dst + 8 * i) = w; }
}

__device__ __forceinline__ void phase_prep(const Params& p, unsigned char* shm) {
    const int tid = threadIdx.x, wid = tid >> 6, lane = tid & 63;
    bf16_t* hA = (bf16_t*)(p.ws + WS_HA);
    for (int r = blockIdx.x * 8 + wid; r < NTOK; r += gridDim.x * 8) {
        const f32x4* xr = (const f32x4*)(p.x + (size_t)r * DM);
        f32x4 v[8]; float ss = 0.f;
#pragma unroll
        for (int i = 0; i < 8; ++i) { v[i] = xr[lane + 64 * i]; ss += v[i][0] * v[i][0] + v[i][1] * v[i][1] + v[i][2] * v[i][2] + v[i][3] * v[i][3]; }
        ss = wave_sum(ss);
        const float rstd = rsqrtf(ss * (1.0f / DM) + 1e-6f);
#pragma unroll
        for (int i = 0; i < 8; ++i) { const f32x4 g = ((const f32x4*)p.norm_gain)[lane + 64 * i];
            u32x2 w; w.x = cvt_pk_bf16(v[i][0] * rstd * g[0], v[i][1] * rstd * g[1]); w.y = cvt_pk_bf16(v[i][2] * rstd * g[2], v[i][3] * rstd * g[3]);
            *(u32x2*)(hA + (size_t)r * DM + (lane + 64 * i) * 4) = w; }
    }
    constexpr int T_IN = (DM / 64) * (INW / 64), T_AO = (1024 / 64) * (DM / 64), T_WO = (DM / 64) * (DM / 64);
    for (int t = blockIdx.x * 8 + wid; t < T_IN + 2 * T_AO + T_WO; t += gridDim.x * 8) {
        if (t < T_IN) transpose_tile_wave(p.w_in, DM, INW, (bf16_t*)(p.ws + WS_WIN), t, lane);
        else if (t < T_IN + T_AO) transpose_tile_wave(p.w_ao, 1024, DM, (bf16_t*)(p.ws + WS_WAO), t - T_IN, lane);
        else if (t < T_IN + 2 * T_AO) transpose_tile_wave(p.w_ho, 1024, DM, (bf16_t*)(p.ws + WS_WHO), t - T_IN - T_AO, lane);
        else transpose_tile_wave(p.w_o, DM, DM, (bf16_t*)(p.ws + WS_WO), t - T_IN - 2 * T_AO, lane);
    }
    f32x2* rope = (f32x2*)(p.ws + WS_ROPE);
    for (int idx = blockIdx.x * 512 + tid; idx < NTOK * 32; idx += gridDim.x * 512) {
        const int tok = idx >> 5, i = idx & 31;
        const float ang = (float)p.pos[tok] * c_inv_freq[i];
        const double a = (double)ang; const double kq = rint(a * 0.63661977236758134308);
        const double r = fma(-kq, 1.5707963267948966192, a) - kq * 6.123233995736766e-17;
        const double r2 = r * r;
        double sn = r2 * (-1.0 / 39916800.0) + (1.0 / 362880.0); sn = sn * r2 - (1.0 / 5040.0); sn = sn * r2 + (1.0 / 120.0); sn = sn * r2 - (1.0 / 6.0); sn = sn * r2 * r + r;
        double cs = r2 * (1.0 / 479001600.0) - (1.0 / 3628800.0); cs = cs * r2 + (1.0 / 40320.0); cs = cs * r2 - (1.0 / 720.0); cs = cs * r2 + (1.0 / 24.0); cs = cs * r2 - 0.5; cs = cs * r2 + 1.0;
        const int q = ((int)(long long)kq) & 3;
        const double c_ = (q == 0) ? cs : (q == 1) ? -sn : (q == 2) ? -cs : sn;
        const double s_ = (q == 0) ? sn : (q == 1) ? cs : (q == 2) ? -sn : -cs;
        f32x2 o; o.x = (float)c_; o.y = (float)s_; rope[idx] = o;
    }
}

constexpr int KS_STRIDE = 72;
constexpr int VT_STRIDE = 264;
__device__ __forceinline__ void attn_unit(const Params& p, unsigned char* shm, int unit) {
    const bf16_t* proj = (const bf16_t*)(p.ws + WS_PROJ);
    const f32x2* rope = (const f32x2*)(p.ws + WS_ROPE);
    bf16_t* Aatt = (bf16_t*)(p.ws + WS_AATT);
    bf16_t* Ks = (bf16_t*)shm;
    bf16_t* Vt = (bf16_t*)(shm + 256 * KS_STRIDE * 2);
    const int tid = threadIdx.x, wid = tid >> 6, lane = tid & 63, fr = lane & 15, fq = lane >> 4;
    const int kvh = unit & 3, blk = unit >> 2, n = blk & 127, b = blk >> 7;
    const int tq0 = b * NT + n * 128;
    const int tk0 = tq0 - 128;
    {
        const int key = tid & 255, hc = tid >> 8; const bool valid = (n > 0) || (key >= 128);
        u32x4 o1a = {0, 0, 0, 0}, o1b = {0, 0, 0, 0}, o2a = {0, 0, 0, 0}, o2b = {0, 0, 0, 0};
        if (valid) {
            const size_t tok = (size_t)(tk0 + key);
            const bf16_t* kp = proj + tok * INW + OKK + kvh * 64 + hc * 16;
            const u32x4 x1a = *(const u32x4*)kp, x1b = *(const u32x4*)(kp + 8), x2a = *(const u32x4*)(kp + 32), x2b = *(const u32x4*)(kp + 40);
            const f32x4* rp = (const f32x4*)(rope + tok * 32 + hc * 16);
            unsigned x1[8] = {x1a.x, x1a.y, x1a.z, x1a.w, x1b.x, x1b.y, x1b.z, x1b.w};
            unsigned x2[8] = {x2a.x, x2a.y, x2a.z, x2a.w, x2b.x, x2b.y, x2b.z, x2b.w};
            unsigned r1[8], r2[8];
#pragma unroll
            for (int i = 0; i < 8; ++i) { const f32x4 cs = rp[i];
                const float a0 = bflo(x1[i]), a1 = bfhi(x1[i]), b0 = bflo(x2[i]), b1 = bfhi(x2[i]);
                r1[i] = cvt_pk_bf16(a0 * cs[0] - b0 * cs[1], a1 * cs[2] - b1 * cs[3]);
                r2[i] = cvt_pk_bf16(b0 * cs[0] + a0 * cs[1], b1 * cs[2] + a1 * cs[3]); }
            o1a = (u32x4){r1[0], r1[1], r1[2], r1[3]}; o1b = (u32x4){r1[4], r1[5], r1[6], r1[7]};
            o2a = (u32x4){r2[0], r2[1], r2[2], r2[3]}; o2b = (u32x4){r2[4], r2[5], r2[6], r2[7]};
        }
        bf16_t* kd = Ks + key * KS_STRIDE + hc * 16;
        *(u32x4*)kd = o1a; *(u32x4*)(kd + 8) = o1b; *(u32x4*)(kd + 32) = o2a; *(u32x4*)(kd + 40) = o2b;
    }
    {
        const int kp = tid & 127, dc = tid >> 7; const bool valid = (n > 0) || (kp >= 64);
        u32x4 va0 = {0, 0, 0, 0}, va1 = {0, 0, 0, 0}, vb0 = {0, 0, 0, 0}, vb1 = {0, 0, 0, 0};
        if (valid) {
            const bf16_t* vp = proj + (size_t)(tk0 + 2 * kp) * INW + OV + kvh * 64 + dc * 16;
            va0 = *(const u32x4*)vp; va1 = *(const u32x4*)(vp + 8); vb0 = *(const u32x4*)(vp + INW); vb1 = *(const u32x4*)(vp + INW + 8);
        }
        const unsigned a[8] = {va0.x, va0.y, va0.z, va0.w, va1.x, va1.y, va1.z, va1.w};
        const unsigned c[8] = {vb0.x, vb0.y, vb0.z, vb0.w, vb1.x, vb1.y, vb1.z, vb1.w};
        unsigned* vd = (unsigned*)(Vt + (dc * 16) * VT_STRIDE + 2 * kp);
#pragma unroll
        for (int i = 0; i < 8; ++i) {
            vd[(2 * i) * (VT_STRIDE / 2)] = (a[i] & 0xffffu) | (c[i] << 16);
            vd[(2 * i + 1) * (VT_STRIDE / 2)] = (a[i] >> 16) | (c[i] & 0xffff0000u);
        }
    }
    __syncthreads();
    const int g = wid >> 1, hq = kvh * 4 + g;
    const float sink = p.sinks[hq];
    for (int qi = 0; qi < 4; ++qi) {
        const int qt = (wid & 1) * 4 + qi, iq = qt * 16 + fr; const size_t tq = (size_t)(tq0 + iq);
        bf16x8 qf0, qf1;
        {
            const bf16_t* qp = proj + tq * INW + OQ + hq * 64 + fq * 8;
            const u32x4 x1 = *(const u32x4*)qp, x2 = *(const u32x4*)(qp + 32);
            const f32x4* rp = (const f32x4*)(rope + tq * 32 + fq * 8);
            const unsigned a[4] = {x1.x, x1.y, x1.z, x1.w}, c[4] = {x2.x, x2.y, x2.z, x2.w}; unsigned r1[4], r2[4];
#pragma unroll
            for (int i = 0; i < 4; ++i) { const f32x4 cs = rp[i];
                const float a0 = bflo(a[i]) * 0.125f, a1 = bfhi(a[i]) * 0.125f, b0 = bflo(c[i]) * 0.125f, b1 = bfhi(c[i]) * 0.125f;
                r1[i] = cvt_pk_bf16(a0 * cs[0] - b0 * cs[1], a1 * cs[2] - b1 * cs[3]);
                r2[i] = cvt_pk_bf16(b0 * cs[0] + a0 * cs[1], b1 * cs[2] + a1 * cs[3]); }
            qf0 = mk8(r1[0], r1[1], r1[2], r1[3]); qf1 = mk8(r2[0], r2[1], r2[2], r2[3]);
        }
        f32x4 s[9];
#pragma unroll
        for (int k9 = 0; k9 < 9; ++k9) {
            const bf16_t* kr = Ks + ((qt + k9) * 16 + fr) * KS_STRIDE + fq * 8;
            const bf16x8 a0 = *(const bf16x8*)kr, a1 = *(const bf16x8*)(kr + 32);
            f32x4 z = {0.f, 0.f, 0.f, 0.f};
            z = __builtin_amdgcn_mfma_f32_16x16x32_bf16(a0, qf0, z, 0, 0, 0);
            s[k9] = __builtin_amdgcn_mfma_f32_16x16x32_bf16(a1, qf1, z, 0, 0, 0);
        }
        float mx = sink;
#pragma unroll
        for (int k9 = 0; k9 < 9; ++k9)
#pragma unroll
            for (int j = 0; j < 4; ++j) { const int jw = (qt + k9) * 16 + fq * 4 + j;
                const bool vis = (jw > iq) && (jw <= iq + 128) && (n > 0 || jw >= 128);
                s[k9][j] = vis ? s[k9][j] : -INFINITY; mx = fmaxf(mx, s[k9][j]); }
        mx = fmaxf(mx, __shfl_xor(mx, 16)); mx = fmaxf(mx, __shfl_xor(mx, 32));
        float l = 0.f;
#pragma unroll
        for (int k9 = 0; k9 < 9; ++k9)
#pragma unroll
            for (int j = 0; j < 4; ++j) { const float e = __expf(s[k9][j] - mx); s[k9][j] = e; l += e; }
        l += __shfl_xor(l, 16); l += __shfl_xor(l, 32);
        l += __expf(sink - mx);
        const float inv_l = 1.0f / l;
        bf16x8 pf[5];
#pragma unroll
        for (int pp = 0; pp < 4; ++pp) pf[pp] = mk8(cvt_pk_bf16(s[2 * pp][0], s[2 * pp][1]), cvt_pk_bf16(s[2 * pp][2], s[2 * pp][3]), cvt_pk_bf16(s[2 * pp + 1][0], s[2 * pp + 1][1]), cvt_pk_bf16(s[2 * pp + 1][2], s[2 * pp + 1][3]));
        pf[4] = mk8(cvt_pk_bf16(s[8][0], s[8][1]), cvt_pk_bf16(s[8][2], s[8][3]), 0u, 0u);
        f32x4 o[4];
#pragma unroll
        for (int nt = 0; nt < 4; ++nt) { o[nt] = (f32x4){0.f, 0.f, 0.f, 0.f};
            const bf16_t* vr = Vt + (nt * 16 + fr) * VT_STRIDE + fq * 4;
#pragma unroll
            for (int pp = 0; pp < 5; ++pp) { const int kta = qt + 2 * pp, ktb = (kta + 1 > 15) ? 15 : kta + 1;
                const u32x2 lo = *(const u32x2*)(vr + kta * 16), hi = *(const u32x2*)(vr + ktb * 16);
                o[nt] = __builtin_amdgcn_mfma_f32_16x16x32_bf16(mk8(lo.x, lo.y, hi.x, hi.y), pf[pp], o[nt], 0, 0, 0); } }
#pragma unroll
        for (int nt = 0; nt < 4; ++nt) { const int col = hq * 64 + nt * 16 + fq * 4;
            const u32x2 gt = *(const u32x2*)(proj + tq * INW + OAG + col);
            u32x2 w; w.x = cvt_pk_bf16(o[nt][0] * inv_l * bflo(gt.x), o[nt][1] * inv_l * bfhi(gt.x)); w.y = cvt_pk_bf16(o[nt][2] * inv_l * bflo(gt.y), o[nt][3] * inv_l * bfhi(gt.y));
            *(u32x2*)(Aatt + tq * 1024 + col) = w; }
    }
    __syncthreads();
}

constexpr int H_STRIDE64 = 72;
constexpr int H_STRIDE128 = 136;
constexpr int NSC = NT / 256;
constexpr int NSU = NB * 8 * NSC;
struct HgrnRaw { unsigned hf[16]; unsigned hi[16]; };
__device__ __forceinline__ void hgrn_load_raw(const bf16_t* proj, size_t rc, int h, int d, int seg, HgrnRaw& R) {
    const bf16_t* bp = proj + (rc + seg * 16) * INW + h * 128 + d;
#pragma unroll
    for (int i = 0; i < 16; ++i) { R.hf[i] = bp[(size_t)i * INW + OHF]; R.hi[i] = bp[(size_t)i * INW + OHI]; }
}
__device__ __forceinline__ void hgrn_gates(const HgrnRaw& R, float lb, float (&bp)[16], float (&kk)[16]) {
    float run = 0.f;
#pragma unroll
    for (int i = 0; i < 16; ++i) {
        const float hf = __uint_as_float(R.hf[i] << 16);
        const float e = __expf(-hf), inv = fast_rcp(1.0f + e);
        const float f = lb + (1.0f - lb) * inv;
        kk[i] = (1.0f - lb) * e * inv;
        run += __logf(f); bp[i] = run;
    }
}
__device__ __forceinline__ void hgrn_store_vt(const HgrnRaw& R, bf16_t* Vt, int d, int seg) {
    unsigned w[8];
#pragma unroll
    for (int i = 0; i < 8; ++i) w[i] = R.hi[2 * i] | (R.hi[2 * i + 1] << 16);
    bf16_t* vd = Vt + d * H_STRIDE64 + seg * 16; *(u32x4*)vd = (u32x4){w[0], w[1], w[2], w[3]}; *(u32x4*)(vd + 8) = (u32x4){w[4], w[5], w[6], w[7]};
}

__device__ __forceinline__ void hgrn_local_unit(const Params& p, unsigned char* shm, int u) {
    const bf16_t* proj = (const bf16_t*)(p.ws + WS_PROJ);
    float* UT = p.out + (size_t)u * 16384; float* dtot = (float*)(p.ws + WS_DTOT) + (size_t)u * 128;
    bf16_t* KdT = (bf16_t*)shm;
    bf16_t* Vt = (bf16_t*)(shm + 128 * H_STRIDE64 * 2);
    float* segsum = (float*)(shm + 2 * 128 * H_STRIDE64 * 2);
    float* dsh = segsum + 512;
    const int tid = threadIdx.x, wid = tid >> 6, lane = tid & 63, fr = lane & 15, fq = lane >> 4;
    const int sc = u & 63, sq = u >> 6, h = sq & 7, b = sq >> 3; const size_t r0 = (size_t)b * NT + (size_t)sc * 256;
    const int d = tid & 127, seg = tid >> 7;
    const float lb = fast_rcp(1.0f + __expf(p.lbt[1024 + h * 128 + d] - p.lbt[h * 128 + d]));
    f32x4 acc[8];
#pragma unroll
    for (int vt = 0; vt < 8; ++vt) acc[vt] = (f32x4){0.f, 0.f, 0.f, 0.f};
    float bsum = 0.f;
    HgrnRaw R; hgrn_load_raw(proj, r0, h, d, seg, R);
#pragma unroll 1
    for (int cc = 0; cc < 4; ++cc) {
        float bp[16], kk[16];
        hgrn_gates(R, lb, bp, kk);
        segsum[seg * 128 + d] = bp[15];
        hgrn_store_vt(R, Vt, d, seg);
        if (cc < 3) hgrn_load_raw(proj, r0 + (size_t)(cc + 1) * 64, h, d, seg, R);
        __syncthreads();
        float off = 0.f, btot = 0.f;
#pragma unroll
        for (int s2 = 0; s2 < 4; ++s2) { const float v = segsum[s2 * 128 + d]; btot += v; if (s2 < seg) off += v; }
        { unsigned w[8];
#pragma unroll
          for (int i = 0; i < 8; ++i) { const float k0 = kk[2 * i] * __expf(btot - (off + bp[2 * i])), k1 = kk[2 * i + 1] * __expf(btot - (off + bp[2 * i + 1])); w[i] = cvt_pk_bf16(k0, k1); }
          bf16_t* kd = KdT + d * H_STRIDE64 + seg * 16; *(u32x4*)kd = (u32x4){w[0], w[1], w[2], w[3]}; *(u32x4*)(kd + 8) = (u32x4){w[4], w[5], w[6], w[7]}; }
        if (seg == 0) dsh[d] = __expf(btot);
        bsum += btot;
        __syncthreads();
        const f32x4 dv = *(const f32x4*)(dsh + 16 * wid + fq * 4);
#pragma unroll
        for (int vt = 0; vt < 8; ++vt) acc[vt] *= dv;
#pragma unroll
        for (int ks = 0; ks < 2; ++ks) { const bf16x8 a = *(const bf16x8*)(KdT + (16 * wid + fr) * H_STRIDE64 + ks * 32 + fq * 8);
#pragma unroll
            for (int vt = 0; vt < 8; ++vt) { const bf16x8 bv = *(const bf16x8*)(Vt + (16 * vt + fr) * H_STRIDE64 + ks * 32 + fq * 8);
                acc[vt] = __builtin_amdgcn_mfma_f32_16x16x32_bf16(a, bv, acc[vt], 0, 0, 0); } }
        __syncthreads();
    }
#pragma unroll
    for (int vt = 0; vt < 8; ++vt) *(f32x4*)(UT + (size_t)(16 * vt + fr) * 128 + 16 * wid + fq * 4) = acc[vt];
    if (seg == 0) dtot[d] = __expf(bsum);
}

__device__ __forceinline__ void hgrn_scan(const Params& p) {
    const float* dtot = (const float*)(p.ws + WS_DTOT);
    for (int gidx = blockIdx.x * 512 + threadIdx.x; gidx < 16 * 8192; gidx += gridDim.x * 512) {
        const int sq = gidx >> 13, e = (gidx & 8191) * 2, d = e & 127;
        float* base = p.out + (size_t)sq * NSC * 16384 + e; const float* db = dtot + (size_t)sq * NSC * 128 + d;
        f32x2 S = {0.f, 0.f};
        for (int c0 = 0; c0 < NSC; c0 += 8) {
            f32x2 U[8], D[8];
#pragma unroll
            for (int i = 0; i < 8; ++i) { U[i] = *(const f32x2*)(base + (size_t)(c0 + i) * 16384); D[i] = *(const f32x2*)(db + (size_t)(c0 + i) * 128); }
#pragma unroll
            for (int i = 0; i < 8; ++i) { *(f32x2*)(base + (size_t)(c0 + i) * 16384) = S; S = D[i] * S + U[i]; }
        }
    }
}

__device__ __forceinline__ void hgrn_out_unit(const Params& p, unsigned char* shm, int u) {
    const bf16_t* proj = (const bf16_t*)(p.ws + WS_PROJ);
    const float* ST = p.out + (size_t)u * 16384;
    bf16_t* Ahg = (bf16_t*)(p.ws + WS_AHGR);
    bf16_t* Qs = (bf16_t*)shm;
    bf16_t* Ks2 = (bf16_t*)(shm + 17408);
    bf16_t* Vt = (bf16_t*)(shm + 34816);
    bf16_t* KdT = (bf16_t*)(shm + 53248);
    bf16_t* St = (bf16_t*)(shm + 71680);
    float* segsum = (float*)(shm + 106496);
    float* eref = segsum + 512;
    float* dsh = eref + 128;
    float* part = dsh + 128;
    const int tid = threadIdx.x, wid = tid >> 6, lane = tid & 63, fr = lane & 15, fq = lane >> 4;
    const int sc = u & 63, sq = u >> 6, h = sq & 7, b = sq >> 3; const size_t r0 = (size_t)b * NT + (size_t)sc * 256;
    const int d = tid & 127, seg = tid >> 7;
    const int tt = wid & 3, vh = wid >> 2;
    const float lb = fast_rcp(1.0f + __expf(p.lbt[1024 + h * 128 + d] - p.lbt[h * 128 + d]));
    f32x4 acc[8];
#pragma unroll
    for (int vt = 0; vt < 8; ++vt) acc[vt] = *(const f32x4*)(ST + (size_t)(16 * vt + fr) * 128 + 16 * wid + fq * 4);
    f32x4 gn[4];
#pragma unroll
    for (int vt = 0; vt < 4; ++vt) gn[vt] = *(const f32x4*)(p.hgain + h * 128 + 16 * (vh * 4 + vt) + fq * 4);
    HgrnRaw R; hgrn_load_raw(proj, r0, h, d, seg, R);
    unsigned hq[16];
#pragma unroll
    for (int i = 0; i < 16; ++i) hq[i] = proj[(r0 + seg * 16 + i) * INW + OHQ + h * 128 + d];
#pragma unroll 1
    for (int cc = 0; cc < 4; ++cc) {
        const size_t rc = r0 + (size_t)cc * 64;
        float bp[16], kk[16];
        hgrn_gates(R, lb, bp, kk);
        segsum[seg * 128 + d] = bp[15];
        hgrn_store_vt(R, Vt, d, seg);
        __syncthreads();
        float off = 0.f, btot = 0.f;
#pragma unroll
        for (int s2 = 0; s2 < 4; ++s2) { const float v = segsum[s2 * 128 + d]; btot += v; if (s2 < seg) off += v; }
        const float bref = segsum[d] + segsum[128 + d];
        if (seg == 0) { eref[d] = __expf(bref); dsh[d] = __expf(btot); }
        { unsigned w[8];
#pragma unroll
          for (int i = 0; i < 8; ++i) { const float k0 = kk[2 * i] * __expf(btot - (off + bp[2 * i])), k1 = kk[2 * i + 1] * __expf(btot - (off + bp[2 * i + 1])); w[i] = cvt_pk_bf16(k0, k1); }
          bf16_t* kd = KdT + d * H_STRIDE64 + seg * 16; *(u32x4*)kd = (u32x4){w[0], w[1], w[2], w[3]}; *(u32x4*)(kd + 8) = (u32x4){w[4], w[5], w[6], w[7]}; }
#pragma unroll
        for (int i = 0; i < 16; ++i) { const float bb = off + bp[i] - bref; const int t = seg * 16 + i;
            const float qv = __uint_as_float(hq[i] << 16);
            const unsigned qk = cvt_pk_bf16(qv * __expf(bb), kk[i] * __expf(-bb));
            Qs[t * H_STRIDE128 + d] = (bf16_t)(qk & 0xffffu); Ks2[t * H_STRIDE128 + d] = (bf16_t)(qk >> 16); }
        if (cc < 3) { hgrn_load_raw(proj, rc + 64, h, d, seg, R);
#pragma unroll
            for (int i = 0; i < 16; ++i) hq[i] = proj[(rc + 64 + seg * 16 + i) * INW + OHQ + h * 128 + d]; }
        const size_t r = rc + 16 * tt + fr;
        u32x2 gt[4];
#pragma unroll
        for (int vt = 0; vt < 4; ++vt) gt[vt] = *(const u32x2*)(proj + r * INW + OHG + h * 128 + 16 * (vh * 4 + vt) + fq * 4);
        __syncthreads();
        { const f32x4 er = *(const f32x4*)(eref + 16 * wid + fq * 4);
#pragma unroll
          for (int vt = 0; vt < 8; ++vt) { const f32x4 sv = acc[vt] * er; u32x2 w; w.x = cvt_pk_bf16(sv[0], sv[1]); w.y = cvt_pk_bf16(sv[2], sv[3]);
              *(u32x2*)(St + (16 * vt + fr) * H_STRIDE128 + 16 * wid + fq * 4) = w; } }
        __syncthreads();
        bf16x8 bq[4];
#pragma unroll
        for (int ks = 0; ks < 4; ++ks) bq[ks] = *(const bf16x8*)(Qs + (16 * tt + fr) * H_STRIDE128 + ks * 32 + fq * 8);
        f32x4 pa[4];
#pragma unroll
        for (int st = 0; st < 4; ++st) { pa[st] = (f32x4){0.f, 0.f, 0.f, 0.f};
            if (st <= tt) {
#pragma unroll
                for (int ks = 0; ks < 4; ++ks) { const bf16x8 a = *(const bf16x8*)(Ks2 + (16 * st + fr) * H_STRIDE128 + ks * 32 + fq * 8);
                    pa[st] = __builtin_amdgcn_mfma_f32_16x16x32_bf16(a, bq[ks], pa[st], 0, 0, 0); }
#pragma unroll
                for (int j = 0; j < 4; ++j) { const int s_ = 16 * st + fq * 4 + j, t_ = 16 * tt + fr; pa[st][j] = (s_ <= t_) ? pa[st][j] : 0.f; }
            } }
        bf16x8 pf[2];
#pragma unroll
        for (int pp = 0; pp < 2; ++pp) pf[pp] = mk8(cvt_pk_bf16(pa[2 * pp][0], pa[2 * pp][1]), cvt_pk_bf16(pa[2 * pp][2], pa[2 * pp][3]), cvt_pk_bf16(pa[2 * pp + 1][0], pa[2 * pp + 1][1]), cvt_pk_bf16(pa[2 * pp + 1][2], pa[2 * pp + 1][3]));
        f32x4 o[4]; float ss = 0.f;
#pragma unroll
        for (int vt = 0; vt < 4; ++vt) { const int vrow = 16 * (vh * 4 + vt) + fr; o[vt] = (f32x4){0.f, 0.f, 0.f, 0.f};
#pragma unroll
            for (int pp = 0; pp < 2; ++pp) { const u32x2 lo = *(const u32x2*)(Vt + vrow * H_STRIDE64 + (2 * pp) * 16 + fq * 4), hi = *(const u32x2*)(Vt + vrow * H_STRIDE64 + (2 * pp + 1) * 16 + fq * 4);
                o[vt] = __builtin_amdgcn_mfma_f32_16x16x32_bf16(mk8(lo.x, lo.y, hi.x, hi.y), pf[pp], o[vt], 0, 0, 0); }
#pragma unroll
            for (int ks = 0; ks < 4; ++ks) { const bf16x8 a = *(const bf16x8*)(St + vrow * H_STRIDE128 + ks * 32 + fq * 8);
                o[vt] = __builtin_amdgcn_mfma_f32_16x16x32_bf16(a, bq[ks], o[vt], 0, 0, 0); }
            ss += o[vt][0] * o[vt][0] + o[vt][1] * o[vt][1] + o[vt][2] * o[vt][2] + o[vt][3] * o[vt][3]; }
        ss += __shfl_xor(ss, 16); ss += __shfl_xor(ss, 32);
        if (fq == 0) part[vh * 64 + 16 * tt + fr] = ss;
        if (cc < 3) {
            const f32x4 dv = *(const f32x4*)(dsh + 16 * wid + fq * 4);
#pragma unroll
            for (int vt = 0; vt < 8; ++vt) acc[vt] *= dv;
#pragma unroll
            for (int ks = 0; ks < 2; ++ks) { const bf16x8 a = *(const bf16x8*)(KdT + (16 * wid + fr) * H_STRIDE64 + ks * 32 + fq * 8);
#pragma unroll
                for (int vt = 0; vt < 8; ++vt) { const bf16x8 bv = *(const bf16x8*)(Vt + (16 * vt + fr) * H_STRIDE64 + ks * 32 + fq * 8);
                    acc[vt] = __builtin_amdgcn_mfma_f32_16x16x32_bf16(a, bv, acc[vt], 0, 0, 0); } }
        }
        __syncthreads();
        const float tot = part[16 * tt + fr] + part[64 + 16 * tt + fr];
        const float rstd = rsqrtf(tot * (1.0f / 128.0f) + 1e-6f);
#pragma unroll
        for (int vt = 0; vt < 4; ++vt) { const int col = h * 128 + 16 * (vh * 4 + vt) + fq * 4;
            u32x2 w; w.x = cvt_pk_bf16(o[vt][0] * rstd * gn[vt][0] * bflo(gt[vt].x), o[vt][1] * rstd * gn[vt][1] * bfhi(gt[vt].x)); w.y = cvt_pk_bf16(o[vt][2] * rstd * gn[vt][2] * bflo(gt[vt].y), o[vt][3] * rstd * gn[vt][3] * bfhi(gt[vt].y));
            *(u32x2*)(Ahg + r * 1024 + col) = w; }
    }
}

__device__ __forceinline__ void phase_final(const Params& p) {
    const int tid = threadIdx.x, wid = tid >> 6, lane = tid & 63;
    const float* rss = (const float*)(p.ws + WS_RSS);
    const bf16_t* xn = (const bf16_t*)(p.ws + WS_AATT);
    for (int r = blockIdx.x * 8 + wid; r < NTOK; r += gridDim.x * 8) {
        u32x4 xv[4];
#pragma unroll
        for (int i = 0; i < 4; ++i) xv[i] = *(const u32x4*)(xn + (size_t)r * DM + (lane + 64 * i) * 8);
        float ss = (lane < 32) ? rss[(size_t)r * 32 + lane] : 0.f;
        ss = wave_sum(ss);
        const float rstd = rsqrtf(ss * (1.0f / DM) + 1e-6f);
        float* orow = p.out + (size_t)r * DM;
#pragma unroll
        for (int i = 0; i < 4; ++i) { const int c0 = (lane + 64 * i) * 8;
            const f32x4 g0 = *(const f32x4*)(p.fgain + c0), g1 = *(const f32x4*)(p.fgain + c0 + 4);
            f32x4 a, b; a[0] = bflo(xv[i].x) * rstd * g0[0]; a[1] = bfhi(xv[i].x) * rstd * g0[1]; a[2] = bflo(xv[i].y) * rstd * g0[2]; a[3] = bfhi(xv[i].y) * rstd * g0[3];
            b[0] = bflo(xv[i].z) * rstd * g1[0]; b[1] = bfhi(xv[i].z) * rstd * g1[1]; b[2] = bflo(xv[i].w) * rstd * g1[2]; b[3] = bfhi(xv[i].w) * rstd * g1[3];
            *(f32x4*)(orow + c0) = a; *(f32x4*)(orow + c0 + 4) = b; }
    }
}

#define REP1 1
#define REP2 1
#define REP4 1
#define REP5 1
#define REP6 1
__global__ void __launch_bounds__(512, 2) fwd_megakernel(Params p) {
    extern __shared__ __attribute__((aligned(16))) unsigned char shm[];
    cg::grid_group grid = cg::this_grid();
    const int G = (int)gridDim.x, c = (int)blockIdx.x;
    phase_prep(p, shm);
    grid.sync();
    { pg8::Gemm g; g.A0 = (const bf16_t*)(p.ws + WS_HA); g.B0 = (const bf16_t*)(p.ws + WS_WIN); g.A1 = g.A0; g.B1 = g.B0; g.M = NTOK; g.N = INW; g.K = DM;
      pg8::StaticOrder S; S.init(NTOK, INW, G, c, 0, REP1); EpiProj E; E.O = (bf16_t*)(p.ws + WS_PROJ);
      pg8::gemm_phase<EpiProj>((LAS unsigned char*)shm, g, S, E); }
    grid.sync();
    for (int rep = 0; rep < REP2; ++rep) {
    for (int u = c; u < NAU; u += G) attn_unit(p, shm, u);
    for (int u = c; u < NSU; u += G) hgrn_local_unit(p, shm, u); }
    grid.sync();
    hgrn_scan(p);
    grid.sync();
    for (int rep = 0; rep < REP4; ++rep) for (int u = c; u < NSU; u += G) hgrn_out_unit(p, shm, u);
    grid.sync();
    { pg8::Gemm g; g.A0 = (const bf16_t*)(p.ws + WS_AATT); g.B0 = (const bf16_t*)(p.ws + WS_WAO); g.A1 = (const bf16_t*)(p.ws + WS_AHGR); g.B1 = (const bf16_t*)(p.ws + WS_WHO); g.M = NTOK; g.N = DM; g.K = 1024;
      pg8::StaticOrder S; S.init(NTOK, DM, G, c, 1, REP5); EpiMerge E; E.proj = (const bf16_t*)(p.ws + WS_PROJ); E.O = (bf16_t*)(p.ws + WS_HA);
      pg8::gemm_phase<EpiMerge>((LAS unsigned char*)shm, g, S, E); }
    grid.sync();
    { pg8::Gemm g; g.A0 = (const bf16_t*)(p.ws + WS_HA); g.B0 = (const bf16_t*)(p.ws + WS_WO); g.A1 = g.A0; g.B1 = g.B0; g.M = NTOK; g.N = DM; g.K = DM;
      pg8::StaticOrder S; S.init(NTOK, DM, G, c, 0, REP6); EpiResid E; E.X = p.x; E.O = (bf16_t*)(p.ws + WS_AATT); E.rss = (float*)(p.ws + WS_RSS);
      pg8::gemm_phase<EpiResid>((LAS unsigned char*)shm, g, S, E); }
    grid.sync();
    phase_final(p);
}

extern "C" void kernel_launch(void* const* d_in, const int* in_sizes, int n_in, void* d_out, int out_size, void* d_ws, size_t ws_size, hipStream_t stream) {
    constexpr size_t kDynLds = pg8::STAGE_BYTES;
    static int grid_blocks = 0;
    if (grid_blocks == 0) {
        if (ws_size < WS_END) { fprintf(stderr, "kernel_launch: workspace too small: %zu < %zu\n", ws_size, (size_t)WS_END); grid_blocks = -1; return; }
        int dev = 0, cus = 0, per_cu = 0;
        (void)hipGetDevice(&dev);
        (void)hipDeviceGetAttribute(&cus, hipDeviceAttributeMultiprocessorCount, dev);
        if (hipFuncSetAttribute((const void*)fwd_megakernel, hipFuncAttributeMaxDynamicSharedMemorySize, (int)kDynLds) != hipSuccess) { fprintf(stderr, "kernel_launch: hipFuncSetAttribute failed\n"); grid_blocks = -1; return; }
        if (hipOccupancyMaxActiveBlocksPerMultiprocessor(&per_cu, (const void*)fwd_megakernel, 512, kDynLds) != hipSuccess || per_cu < 1) { fprintf(stderr, "kernel_launch: occupancy query failed (%d)\n", per_cu); (void)hipGetLastError(); grid_blocks = -1; return; }
        if (per_cu > 1) per_cu = 1;
        grid_blocks = cus * per_cu;
    }
    if (grid_blocks < 0) return;
    Params p{};
    p.x = (const float*)d_in[0]; p.pos = (const int*)d_in[1]; p.norm_gain = (const float*)d_in[2]; p.w_in = (const float*)d_in[3]; p.sinks = (const float*)d_in[4];
    p.lbt = (const float*)d_in[5]; p.hgain = (const float*)d_in[6]; p.w_ao = (const float*)d_in[7]; p.w_ho = (const float*)d_in[8]; p.w_o = (const float*)d_in[9];
    p.fgain = (const float*)d_in[10]; p.out = (float*)d_out; p.ws = (unsigned char*)d_ws;
    void* args[] = {&p};
    hipError_t e = hipLaunchCooperativeKernel((const void*)fwd_megakernel, dim3(grid_blocks), dim3(512), args, kDynLds, stream);
    if (e != hipSuccess) fprintf(stderr, "cooperative launch failed: %s (grid %d)\n", hipGetErrorString(e), grid_blocks);
}
```

```cpp
#include <hip/hip_runtime.h>
#include <hip/hip_cooperative_groups.h>
#include <cstdio>
namespace cg = cooperative_groups;

#define LAS __attribute__((address_space(3)))
typedef unsigned short bf16_t;
typedef short bf16x8 __attribute__((ext_vector_type(8)));
typedef float f32x4 __attribute__((ext_vector_type(4)));
typedef float f32x2 __attribute__((ext_vector_type(2)));
typedef unsigned u32x4 __attribute__((ext_vector_type(4)));
typedef unsigned u32x2 __attribute__((ext_vector_type(2)));

constexpr int NB = 2, NT = 16384, NTOK = NB * NT, DM = 2048, INW = 10752;
constexpr int OQ = 0, OKK = 1024, OV = 1280, OAG = 1536, OHQ = 2560, OHF = 3584, OHI = 4608, OHG = 5632, OMA = 6656, OMH = 8704;
constexpr int NCHUNK = NT / 64;
constexpr int NHU = NB * 8 * NCHUNK;
constexpr int NAU = NB * (NT / 128) * 4;

constexpr size_t WS_HA = 0;
constexpr size_t WS_WIN = WS_HA + (size_t)NTOK * DM * 2;
constexpr size_t WS_WAO = WS_WIN + (size_t)INW * DM * 2;
constexpr size_t WS_WHO = WS_WAO + (size_t)DM * 1024 * 2;
constexpr size_t WS_WO = WS_WHO + (size_t)DM * 1024 * 2;
constexpr size_t WS_PROJ = WS_WO + (size_t)DM * DM * 2;
constexpr size_t WS_ROPE = WS_PROJ + (size_t)NTOK * INW * 2;
constexpr size_t WS_AATT = WS_ROPE + (size_t)NTOK * 32 * 8;
constexpr size_t WS_AHGR = WS_AATT + (size_t)NTOK * 1024 * 2;
constexpr size_t WS_DTOT = WS_AHGR + (size_t)NTOK * 1024 * 2;
constexpr size_t WS_RSS = WS_DTOT + (size_t)NHU * 128 * 4;
constexpr size_t WS_END = WS_RSS + (size_t)NTOK * 32 * 4;

struct Params {
    const float* x; const int* pos; const float* norm_gain; const float* w_in; const float* sinks; const float* lbt;
    const float* hgain; const float* w_ao; const float* w_ho; const float* w_o; const float* fgain;
    float* out; unsigned char* ws;
};

__constant__ float c_inv_freq[32] = {
    1.0f, 0.749894261f, 0.562341332f, 0.421696514f, 0.316227764f, 0.237137377f, 0.177827939f, 0.133352131f, 0.100000001f, 0.0749894157f,
    0.0562341325f, 0.0421696529f, 0.0316227749f, 0.0237137377f, 0.0177827943f, 0.0133352149f, 0.00999999978f, 0.00749894185f,
    0.00562341325f, 0.00421696482f, 0.00316227763f, 0.00237137359f, 0.00177827943f, 0.00133352145f, 0.00100000005f, 0.000749894243f,
    0.000562341302f, 0.000421696517f, 0.000316227757f, 0.00023713737f, 0.00017782794f, 0.00013335215f};

__device__ __forceinline__ float bf2f(bf16_t b) { return __uint_as_float(((unsigned)b) << 16); }
__device__ __forceinline__ float bflo(unsigned w) { return __uint_as_float(w << 16); }
__device__ __forceinline__ float bfhi(unsigned w) { return __uint_as_float(w & 0xffff0000u); }
__device__ __forceinline__ unsigned cvt_pk_bf16(float lo, float hi) { unsigned r; asm volatile("v_cvt_pk_bf16_f32 %0, %1, %2" : "=v"(r) : "v"(lo), "v"(hi)); return r; }
__device__ __forceinline__ float fast_rcp(float x) { return __builtin_amdgcn_rcpf(x); }
__device__ __forceinline__ float sigmoidf_(float v) { return fast_rcp(1.0f + __expf(-v)); }
__device__ __forceinline__ float wave_sum(float v) {
#pragma unroll
    for (int o = 32; o > 0; o >>= 1) v += __shfl_xor(v, o);
    return v;
}
__device__ __forceinline__ bf16x8 mk8(unsigned a, unsigned b, unsigned c, unsigned d) { u32x4 w; w.x = a; w.y = b; w.z = c; w.w = d; return __builtin_bit_cast(bf16x8, w); }

namespace pg8 {
constexpr int BM = 256, BK = 64, HALF = 128, HTB = HALF * BK * 2, STAGE_BYTES = 8 * HTB, NXCD = 8, WGM = 8;
__host__ __device__ __forceinline__ int lds_byte(int r, int c) { const int st = (r >> 4) * 2 + (c >> 5), rr = r & 15, cc = c & 31, ob = rr * 64 + cc * 2; return st * 1024 + (ob ^ (((ob >> 9) & 1) << 5)); }
__host__ __device__ __forceinline__ void stage_rc(int b, int& R, int& C) { const int st = b / 1024, sb = b % 1024, swz = sb ^ (((sb >> 9) & 1) << 5); R = (st >> 1) * 16 + swz / 64; C = (st & 1) * 32 + (swz % 64) / 2; }
__host__ __device__ __forceinline__ int perm32(int rho) { const int n = rho >> 4, i = rho & 15; return 8 * (i >> 2) + 4 * n + (i & 3); }

struct Unit { int pm, pn, kind, rep; };
struct Gemm { const bf16_t* A0; const bf16_t* B0; const bf16_t* A1; const bf16_t* B1; int M, N, K; };

struct StaticOrder {
    int nM, nN, nwg, G, c, dual, R, reps;
    __device__ void init(int M, int N, int G_, int c_, int dual_, int reps_ = 1) { nM = M / BM; nN = N / BM; nwg = nM * nN; G = G_; c = c_; dual = dual_; R = (nwg + G - 1) / G; reps = reps_; }
    __device__ bool next(int i, Unit& u) const {
        if (i >= reps * (R << dual)) return false;
        const int it = (i >> dual) % R;
        const long L = (long)it * G + c; if (L >= nwg) return false;
        int wgid = (int)L; { const int q = nwg / NXCD, r = nwg % NXCD, xcd = wgid % NXCD, off = wgid / NXCD; wgid = (xcd < r ? xcd * (q + 1) : r * (q + 1) + (xcd - r) * q) + off; }
        const int nig = WGM * nN, gid = wgid / nig, fm = gid * WGM, gsz = (nM - fm) < WGM ? (nM - fm) : WGM;
        u.pm = fm + ((wgid % nig) % gsz); u.pn = (wgid % nig) / gsz; u.kind = i & dual; u.rep = (i >> dual) / R; return true;
    }
};

template <class Epi>
__device__ __forceinline__ void gemm_phase(LAS unsigned char* lds, const Gemm g, const StaticOrder& S, const Epi& E) {
    const int tid = threadIdx.x, wid = __builtin_amdgcn_readfirstlane(tid >> 6), lane = tid & 63, wr = wid >> 2, wc = wid & 3, fr = lane & 15, fq = lane >> 4;
    const int K = g.K, nt = K / BK;
    unsigned voffA[2], voffB[2];
#pragma unroll
    for (int i = 0; i < 2; ++i) { int R, C; stage_rc(tid * 16 + i * 8192, R, C); const int Rb = Epi::PERM ? ((R & ~31) + perm32(R & 31)) : R;
        voffA[i] = (unsigned)(R * K + C) * 2u; voffB[i] = (unsigned)(Rb * K + C) * 2u; }
    const size_t kstep = (size_t)(BK * 2);
    const size_t hstep = (size_t)HALF * K * 2;
    const size_t tstep = 2 * hstep;
    const unsigned ldsw = (unsigned)wid * 1024u;
    const int aoff = lds_byte(wr * 64 + fr, fq * 8), boff = lds_byte(wc * 32 + fr, fq * 8);
#define PG8_SA(b, h) (((b) * 2 + (h)) * HTB)
#define PG8_SB(b, h) ((4 + (b) * 2 + (h)) * HTB)
#define PG8_STAGE(bufoff, gbase, voff) do { _Pragma("unroll") for (int _i = 0; _i < 2; ++_i) \
        __builtin_amdgcn_global_load_lds((const unsigned*)((const char*)(gbase) + (voff)[_i]), (LAS unsigned*)(lds + (bufoff) + ldsw + _i * 8192), 16, 0, 0); } while (0)
#define PG8_LDA(dst, b, h) do { _Pragma("unroll") for (int m = 0; m < 4; ++m) _Pragma("unroll") for (int k = 0; k < 2; ++k) dst[m][k] = *(const LAS bf16x8*)(lds + PG8_SA(b, h) + aoff + m * 2048 + k * 1024); } while (0)
#define PG8_LDB(dst, b, h) do { _Pragma("unroll") for (int n = 0; n < 2; ++n) _Pragma("unroll") for (int k = 0; k < 2; ++k) dst[n][k] = *(const LAS bf16x8*)(lds + PG8_SB(b, h) + boff + n * 2048 + k * 1024); } while (0)
#define PG8_MMA(ai, bj, At, Bt) do { __builtin_amdgcn_s_setprio(1); _Pragma("unroll") for (int m = 0; m < 4; ++m) _Pragma("unroll") for (int n = 0; n < 2; ++n) _Pragma("unroll") for (int k = 0; k < 2; ++k) \
        acc[ai][bj][m][n] = __builtin_amdgcn_mfma_f32_16x16x32_bf16(Bt[n][k], At[m][k], acc[ai][bj][m][n], 0, 0, 0); __builtin_amdgcn_s_setprio(0); } while (0)
#define PG8_WAIT_V(n) asm volatile("s_waitcnt vmcnt(" #n ")" ::: "memory")
#define PG8_WAIT_L(n) asm volatile("s_waitcnt lgkmcnt(" #n ")" ::: "memory")
#define PG8_BAR __builtin_amdgcn_s_barrier()
#define PG8_SCHED __builtin_amdgcn_sched_barrier(0)
    Unit cur, nxt; int ui = 0;
    if (!S.next(0, cur)) return;
    f32x4 acc[2][2][4][2];
#pragma unroll
    for (int a = 0; a < 2; ++a)
#pragma unroll
        for (int b = 0; b < 2; ++b)
#pragma unroll
            for (int m = 0; m < 4; ++m)
#pragma unroll
                for (int n = 0; n < 2; ++n) acc[a][b][m][n] = (f32x4){0.f, 0.f, 0.f, 0.f};
    bf16x8 At[4][2], B0[2][2], B1[2][2];
    const char* cA = (const char*)(cur.kind ? g.A1 : g.A0) + (size_t)cur.pm * tstep; const char* cB = (const char*)(cur.kind ? g.B1 : g.B0) + (size_t)cur.pn * tstep;
    PG8_STAGE(PG8_SB(0, 0), cB, voffB); PG8_STAGE(PG8_SA(0, 0), cA, voffA); PG8_STAGE(PG8_SB(0, 1), cB + hstep, voffB); PG8_STAGE(PG8_SA(0, 1), cA + hstep, voffA);
    if (wr == 1) PG8_BAR;
    PG8_WAIT_V(4); PG8_BAR;
    PG8_STAGE(PG8_SB(1, 0), cB + kstep, voffB); PG8_STAGE(PG8_SA(1, 0), cA + kstep, voffA); PG8_STAGE(PG8_SB(1, 1), cB + hstep + kstep, voffB);
    PG8_WAIT_V(6); PG8_BAR;
    for (;;) {
        const bool has_next = S.next(ui + 1, nxt);
        const char* nA = has_next ? (const char*)(nxt.kind ? g.A1 : g.A0) + (size_t)nxt.pm * tstep : cA; const char* nB = has_next ? (const char*)(nxt.kind ? g.B1 : g.B0) + (size_t)nxt.pn * tstep : cB;
        for (int t = 0; t < nt; t += 2) {
            const bool last = (t == nt - 2);
            const char* a1 = cA + (size_t)(t + 1) * kstep;
            const char* a2 = last ? nA : cA + (size_t)(t + 2) * kstep; const char* b2 = last ? nB : cB + (size_t)(t + 2) * kstep;
            const char* a3 = a2 + kstep; const char* b3 = b2 + kstep;
            PG8_LDB(B0, 0, 0); PG8_SCHED; PG8_LDA(At, 0, 0); PG8_STAGE(PG8_SA(1, 1), a1 + hstep, voffA);
            PG8_WAIT_L(8); PG8_BAR; PG8_WAIT_L(0); PG8_MMA(0, 0, At, B0); PG8_BAR; PG8_SCHED;
            PG8_LDB(B1, 0, 1); PG8_STAGE(PG8_SB(0, 0), b2, voffB);
            PG8_BAR; PG8_WAIT_L(0); PG8_MMA(0, 1, At, B1); PG8_BAR;
            PG8_LDA(At, 0, 1); PG8_STAGE(PG8_SA(0, 0), a2, voffA);
            PG8_BAR; PG8_WAIT_L(0); PG8_MMA(1, 0, At, B0); PG8_BAR; PG8_SCHED;
            PG8_STAGE(PG8_SB(0, 1), b2 + hstep, voffB);
            PG8_WAIT_V(6); PG8_BAR; PG8_MMA(1, 1, At, B1); PG8_BAR;
            PG8_LDB(B0, 1, 0); PG8_SCHED; PG8_LDA(At, 1, 0); PG8_STAGE(PG8_SA(0, 1), a2 + hstep, voffA);
            PG8_WAIT_L(8); PG8_BAR; PG8_WAIT_L(0); PG8_MMA(0, 0, At, B0); PG8_BAR; PG8_SCHED;
            PG8_LDB(B1, 1, 1); PG8_STAGE(PG8_SB(1, 0), b3, voffB);
            PG8_BAR; PG8_WAIT_L(0); PG8_MMA(0, 1, At, B1); PG8_BAR;
            PG8_LDA(At, 1, 1); PG8_STAGE(PG8_SA(1, 0), a3, voffA);
            PG8_BAR; PG8_WAIT_L(0); PG8_MMA(1, 0, At, B0); PG8_BAR; PG8_SCHED;
            PG8_STAGE(PG8_SB(1, 1), b3 + hstep, voffB);
            PG8_WAIT_V(6); PG8_BAR; PG8_MMA(1, 1, At, B1); PG8_BAR;
        }
        const bool keep = E(acc, cur, wr, wc, fr, fq);
        if (!has_next) break;
        if (!keep) {
#pragma unroll
            for (int a = 0; a < 2; ++a)
#pragma unroll
                for (int b = 0; b < 2; ++b)
#pragma unroll
                    for (int m = 0; m < 4; ++m)
#pragma unroll
                        for (int n = 0; n < 2; ++n) acc[a][b][m][n] = (f32x4){0.f, 0.f, 0.f, 0.f};
        }
        cur = nxt; cA = nA; cB = nB; ++ui;
    }
    PG8_WAIT_V(0);
    if (wr == 0) PG8_BAR;
    PG8_BAR;
#undef PG8_SA
#undef PG8_SB
#undef PG8_STAGE
#undef PG8_LDA
#undef PG8_LDB
#undef PG8_MMA
#undef PG8_WAIT_V
#undef PG8_WAIT_L
#undef PG8_BAR
#undef PG8_SCHED
}
}

#define PROBE_SKIP_EPI 0
struct EpiProj {
    static constexpr bool PERM = true;
    bf16_t* O;
    __device__ __forceinline__ bool operator()(f32x4 (&acc)[2][2][4][2], const pg8::Unit& u, int wr, int wc, int fr, int fq) const {
        if (PROBE_SKIP_EPI && u.rep) return false;
        const int pn = u.pn;
        int mode = 0; float scale = 1.0f;
        if ((pn >= 6 && pn < 10) || (pn >= 22 && pn < 26)) mode = 1;
        else if (pn >= 10 && pn < 14) { mode = 1; scale = 0.08838834764831845f; }
        else if (pn >= 26) mode = 2;
        const int row0 = u.pm * 256 + wr * 64 + fr, col0 = pn * 256 + wc * 32 + 8 * fq;
#pragma unroll
        for (int ai = 0; ai < 2; ++ai)
#pragma unroll
            for (int m = 0; m < 4; ++m) { bf16_t* rowp = O + (size_t)(row0 + ai * 128 + m * 16) * INW + col0;
#pragma unroll
                for (int bj = 0; bj < 2; ++bj) { f32x4 v0 = acc[ai][bj][m][0], v1 = acc[ai][bj][m][1];
                    if (mode != 0) {
#pragma unroll
                        for (int j = 0; j < 4; ++j) { const float s0 = sigmoidf_(v0[j]), s1 = sigmoidf_(v1[j]);
                            v0[j] = (mode == 1) ? v0[j] * s0 * scale : s0; v1[j] = (mode == 1) ? v1[j] * s1 * scale : s1; }
                    }
                    u32x4 w; w.x = cvt_pk_bf16(v0[0], v0[1]); w.y = cvt_pk_bf16(v0[2], v0[3]); w.z = cvt_pk_bf16(v1[0], v1[1]); w.w = cvt_pk_bf16(v1[2], v1[3]);
                    __builtin_nontemporal_store(w, (u32x4*)(rowp + bj * 128)); } }
        return false;
    }
};
struct EpiMerge {
    static constexpr bool PERM = true;
    const bf16_t* proj; bf16_t* O;
    __device__ __forceinline__ bool operator()(f32x4 (&acc)[2][2][4][2], const pg8::Unit& u, int wr, int wc, int fr, int fq) const {
        const int row0 = u.pm * 256 + wr * 64 + fr, col0 = u.pn * 256 + wc * 32 + 8 * fq;
#pragma unroll
        for (int ai = 0; ai < 2; ++ai)
#pragma unroll
            for (int m = 0; m < 4; ++m) { const size_t r = (size_t)(row0 + ai * 128 + m * 16);
#pragma unroll
                for (int bj = 0; bj < 2; ++bj) { const int c = col0 + bj * 128;
                    const u32x4 g2 = *(const u32x4*)(proj + r * INW + OMH + c);
                    float s2[8] = {bflo(g2.x), bfhi(g2.x), bflo(g2.y), bfhi(g2.y), bflo(g2.z), bfhi(g2.z), bflo(g2.w), bfhi(g2.w)};
                    if (u.kind == 0) {
                        const u32x4 g1 = *(const u32x4*)(proj + r * INW + OMA + c);
                        float s1[8] = {bflo(g1.x), bfhi(g1.x), bflo(g1.y), bfhi(g1.y), bflo(g1.z), bfhi(g1.z), bflo(g1.w), bfhi(g1.w)};
#pragma unroll
                        for (int j = 0; j < 4; ++j) { acc[ai][bj][m][0][j] *= s1[j] * fast_rcp(fmaxf(s2[j], 1e-20f)); acc[ai][bj][m][1][j] *= s1[4 + j] * fast_rcp(fmaxf(s2[4 + j], 1e-20f)); }
                    } else {
                        const f32x4 v0 = acc[ai][bj][m][0], v1 = acc[ai][bj][m][1];
                        u32x4 w; w.x = cvt_pk_bf16(v0[0] * s2[0], v0[1] * s2[1]); w.y = cvt_pk_bf16(v0[2] * s2[2], v0[3] * s2[3]);
                        w.z = cvt_pk_bf16(v1[0] * s2[4], v1[1] * s2[5]); w.w = cvt_pk_bf16(v1[2] * s2[6], v1[3] * s2[7]);
                        *(u32x4*)(O + r * DM + c) = w;
                    } } }
        return u.kind == 0;
    }
};
struct EpiY {
    static constexpr bool PERM = true;
    bf16_t* O;
    __device__ __forceinline__ bool operator()(f32x4 (&acc)[2][2][4][2], const pg8::Unit& u, int wr, int wc, int fr, int fq) const {
        const int row0 = u.pm * 256 + wr * 64 + fr, col0 = u.pn * 256 + wc * 32 + 8 * fq;
#pragma unroll
        for (int ai = 0; ai < 2; ++ai)
#pragma unroll
            for (int m = 0; m < 4; ++m) { bf16_t* rowp = O + (size_t)(row0 + ai * 128 + m * 16) * DM + col0;
#pragma unroll
                for (int bj = 0; bj < 2; ++bj) { const f32x4 v0 = acc[ai][bj][m][0], v1 = acc[ai][bj][m][1];
                    u32x4 w; w.x = cvt_pk_bf16(v0[0], v0[1]); w.y = cvt_pk_bf16(v0[2], v0[3]); w.z = cvt_pk_bf16(v1[0], v1[1]); w.w = cvt_pk_bf16(v1[2], v1[3]);
                    __builtin_nontemporal_store(w, (u32x4*)(rowp + bj * 128)); } }
        return false;
    }
};

__device__ __forceinline__ void transpose_tile_wave(const float* __restrict__ W, int K, int N, bf16_t* __restrict__ WT, int tile, int lane) {
    const int ntn = N >> 6; const int k0 = (tile / ntn) * 64, n0 = (tile % ntn) * 64;
    const float* src = W + (size_t)k0 * N + n0 + lane;
    float v[64];
#pragma unroll
    for (int i = 0; i < 64; ++i) v[i] = src[(size_t)i * N];
    bf16_t* dst = WT + (size_t)(n0 + lane) * K + k0;
#pragma unroll
    for (int i = 0; i < 8; ++i) { u32x4 w; w.x = cvt_pk_bf16(v[8 * i], v[8 * i + 1]); w.y = cvt_pk_bf16(v[8 * i + 2], v[8 * i + 3]); w.z = cvt_pk_bf16(v[8 * i + 4], v[8 * i + 5]); w.w = cvt_pk_bf16(v[8 * i + 6], v[8 * i + 7]);
        *(u32x4*)(dst + 8 * i) = w; }
}

__device__ __forceinline__ void phase_prep(const Params& p, unsigned char* shm) {
    const int tid = threadIdx.x, wid = tid >> 6, lane = tid & 63;
    bf16_t* hA = (bf16_t*)(p.ws + WS_HA);
    for (int r = blockIdx.x * 8 + wid; r < NTOK; r += gridDim.x * 8) {
        const f32x4* xr = (const f32x4*)(p.x + (size_t)r * DM);
        f32x4 v[8]; float ss = 0.f;
#pragma unroll
        for (int i = 0; i < 8; ++i) { v[i] = xr[lane + 64 * i]; ss += v[i][0] * v[i][0] + v[i][1] * v[i][1] + v[i][2] * v[i][2] + v[i][3] * v[i][3]; }
        ss = wave_sum(ss);
        const float rstd = rsqrtf(ss * (1.0f / DM) + 1e-6f);
#pragma unroll
        for (int i = 0; i < 8; ++i) { const f32x4 g = ((const f32x4*)p.norm_gain)[lane + 64 * i];
            u32x2 w; w.x = cvt_pk_bf16(v[i][0] * rstd * g[0], v[i][1] * rstd * g[1]); w.y = cvt_pk_bf16(v[i][2] * rstd * g[2], v[i][3] * rstd * g[3]);
            *(u32x2*)(hA + (size_t)r * DM + (lane + 64 * i) * 4) = w; }
    }
    constexpr int T_IN = (DM / 64) * (INW / 64), T_AO = (1024 / 64) * (DM / 64), T_WO = (DM / 64) * (DM / 64);
    for (int t = blockIdx.x * 8 + wid; t < T_IN + 2 * T_AO + T_WO; t += gridDim.x * 8) {
        if (t < T_IN) transpose_tile_wave(p.w_in, DM, INW, (bf16_t*)(p.ws + WS_WIN), t, lane);
        else if (t < T_IN + T_AO) transpose_tile_wave(p.w_ao, 1024, DM, (bf16_t*)(p.ws + WS_WAO), t - T_IN, lane);
        else if (t < T_IN + 2 * T_AO) transpose_tile_wave(p.w_ho, 1024, DM, (bf16_t*)(p.ws + WS_WHO), t - T_IN - T_AO, lane);
        else transpose_tile_wave(p.w_o, DM, DM, (bf16_t*)(p.ws + WS_WO), t - T_IN - 2 * T_AO, lane);
    }
    f32x2* rope = (f32x2*)(p.ws + WS_ROPE);
    for (int idx = blockIdx.x * 512 + tid; idx < NTOK * 32; idx += gridDim.x * 512) {
        const int tok = idx >> 5, i = idx & 31;
        const float ang = (float)p.pos[tok] * c_inv_freq[i];
        const double a = (double)ang; const double kq = rint(a * 0.63661977236758134308);
        const double r = fma(-kq, 1.5707963267948966192, a) - kq * 6.123233995736766e-17;
        const double r2 = r * r;
        double sn = r2 * (-1.0 / 39916800.0) + (1.0 / 362880.0); sn = sn * r2 - (1.0 / 5040.0); sn = sn * r2 + (1.0 / 120.0); sn = sn * r2 - (1.0 / 6.0); sn = sn * r2 * r + r;
        double cs = r2 * (1.0 / 479001600.0) - (1.0 / 3628800.0); cs = cs * r2 + (1.0 / 40320.0); cs = cs * r2 - (1.0 / 720.0); cs = cs * r2 + (1.0 / 24.0); cs = cs * r2 - 0.5; cs = cs * r2 + 1.0;
        const int q = ((int)(long long)kq) & 3;
        const double c_ = (q == 0) ? cs : (q == 1) ? -sn : (q == 2) ? -cs : sn;
        const double s_ = (q == 0) ? sn : (q == 1) ? cs : (q == 2) ? -sn : -cs;
        f32x2 o; o.x = (float)c_; o.y = (float)s_; rope[idx] = o;
    }
}

constexpr int KS_STRIDE = 72;
constexpr int VT_STRIDE = 264;
__device__ __forceinline__ void attn_unit(const Params& p, unsigned char* shm, int unit) {
    const bf16_t* proj = (const bf16_t*)(p.ws + WS_PROJ);
    const f32x2* rope = (const f32x2*)(p.ws + WS_ROPE);
    bf16_t* Aatt = (bf16_t*)(p.ws + WS_AATT);
    bf16_t* Ks = (bf16_t*)shm;
    bf16_t* Vt = (bf16_t*)(shm + 256 * KS_STRIDE * 2);
    const int tid = threadIdx.x, wid = tid >> 6, lane = tid & 63, fr = lane & 15, fq = lane >> 4;
    const int kvh = unit & 3, blk = unit >> 2, n = blk & 127, b = blk >> 7;
    const int tq0 = b * NT + n * 128;
    const int tk0 = tq0 - 128;
    {
        const int key = tid & 255, hc = tid >> 8; const bool valid = (n > 0) || (key >= 128);
        u32x4 o1a = {0, 0, 0, 0}, o1b = {0, 0, 0, 0}, o2a = {0, 0, 0, 0}, o2b = {0, 0, 0, 0};
        if (valid) {
            const size_t tok = (size_t)(tk0 + key);
            const bf16_t* kp = proj + tok * INW + OKK + kvh * 64 + hc * 16;
            const u32x4 x1a = *(const u32x4*)kp, x1b = *(const u32x4*)(kp + 8), x2a = *(const u32x4*)(kp + 32), x2b = *(const u32x4*)(kp + 40);
            const f32x4* rp = (const f32x4*)(rope + tok * 32 + hc * 16);
            unsigned x1[8] = {x1a.x, x1a.y, x1a.z, x1a.w, x1b.x, x1b.y, x1b.z, x1b.w};
            unsigned x2[8] = {x2a.x, x2a.y, x2a.z, x2a.w, x2b.x, x2b.y, x2b.z, x2b.w};
            unsigned r1[8], r2[8];
#pragma unroll
            for (int i = 0; i < 8; ++i) { const f32x4 cs = rp[i];
                const float a0 = bflo(x1[i]), a1 = bfhi(x1[i]), b0 = bflo(x2[i]), b1 = bfhi(x2[i]);
                r1[i] = cvt_pk_bf16(a0 * cs[0] - b0 * cs[1], a1 * cs[2] - b1 * cs[3]);
                r2[i] = cvt_pk_bf16(b0 * cs[0] + a0 * cs[1], b1 * cs[2] + a1 * cs[3]); }
            o1a = (u32x4){r1[0], r1[1], r1[2], r1[3]}; o1b = (u32x4){r1[4], r1[5], r1[6], r1[7]};
            o2a = (u32x4){r2[0], r2[1], r2[2], r2[3]}; o2b = (u32x4){r2[4], r2[5], r2[6], r2[7]};
        }
        bf16_t* kd = Ks + key * KS_STRIDE + hc * 16;
        *(u32x4*)kd = o1a; *(u32x4*)(kd + 8) = o1b; *(u32x4*)(kd + 32) = o2a; *(u32x4*)(kd + 40) = o2b;
    }
    {
        const int kp = tid & 127, dc = tid >> 7; const bool valid = (n > 0) || (kp >= 64);
        u32x4 va0 = {0, 0, 0, 0}, va1 = {0, 0, 0, 0}, vb0 = {0, 0, 0, 0}, vb1 = {0, 0, 0, 0};
        if (valid) {
            const bf16_t* vp = proj + (size_t)(tk0 + 2 * kp) * INW + OV + kvh * 64 + dc * 16;
            va0 = *(const u32x4*)vp; va1 = *(const u32x4*)(vp + 8); vb0 = *(const u32x4*)(vp + INW); vb1 = *(const u32x4*)(vp + INW + 8);
        }
        const unsigned a[8] = {va0.x, va0.y, va0.z, va0.w, va1.x, va1.y, va1.z, va1.w};
        const unsigned c[8] = {vb0.x, vb0.y, vb0.z, vb0.w, vb1.x, vb1.y, vb1.z, vb1.w};
        unsigned* vd = (unsigned*)(Vt + (dc * 16) * VT_STRIDE + 2 * kp);
#pragma unroll
        for (int i = 0; i < 8; ++i) {
            vd[(2 * i) * (VT_STRIDE / 2)] = (a[i] & 0xffffu) | (c[i] << 16);
            vd[(2 * i + 1) * (VT_STRIDE / 2)] = (a[i] >> 16) | (c[i] & 0xffff0000u);
        }
    }
    __syncthreads();
    const int g = wid >> 1, hq = kvh * 4 + g;
    const float sink = p.sinks[hq];
    for (int qi = 0; qi < 4; ++qi) {
        const int qt = (wid & 1) * 4 + qi, iq = qt * 16 + fr; const size_t tq = (size_t)(tq0 + iq);
        bf16x8 qf0, qf1;
        {
            const bf16_t* qp = proj + tq * INW + OQ + hq * 64 + fq * 8;
            const u32x4 x1 = *(const u32x4*)qp, x2 = *(const u32x4*)(qp + 32);
            const f32x4* rp = (const f32x4*)(rope + tq * 32 + fq * 8);
            const unsigned a[4] = {x1.x, x1.y, x1.z, x1.w}, c[4] = {x2.x, x2.y, x2.z, x2.w}; unsigned r1[4], r2[4];
#pragma unroll
            for (int i = 0; i < 4; ++i) { const f32x4 cs = rp[i];
                const float a0 = bflo(a[i]) * 0.125f, a1 = bfhi(a[i]) * 0.125f, b0 = bflo(c[i]) * 0.125f, b1 = bfhi(c[i]) * 0.125f;
                r1[i] = cvt_pk_bf16(a0 * cs[0] - b0 * cs[1], a1 * cs[2] - b1 * cs[3]);
                r2[i] = cvt_pk_bf16(b0 * cs[0] + a0 * cs[1], b1 * cs[2] + a1 * cs[3]); }
            qf0 = mk8(r1[0], r1[1], r1[2], r1[3]); qf1 = mk8(r2[0], r2[1], r2[2], r2[3]);
        }
        f32x4 s[9];
#pragma unroll
        for (int k9 = 0; k9 < 9; ++k9) {
            const bf16_t* kr = Ks + ((qt + k9) * 16 + fr) * KS_STRIDE + fq * 8;
            const bf16x8 a0 = *(const bf16x8*)kr, a1 = *(const bf16x8*)(kr + 32);
            f32x4 z = {0.f, 0.f, 0.f, 0.f};
            z = __builtin_amdgcn_mfma_f32_16x16x32_bf16(a0, qf0, z, 0, 0, 0);
            s[k9] = __builtin_amdgcn_mfma_f32_16x16x32_bf16(a1, qf1, z, 0, 0, 0);
        }
        float mx = sink;
#pragma unroll
        for (int k9 = 0; k9 < 9; ++k9)
#pragma unroll
            for (int j = 0; j < 4; ++j) { const int jw = (qt + k9) * 16 + fq * 4 + j;
                const bool vis = (jw > iq) && (jw <= iq + 128) && (n > 0 || jw >= 128);
                s[k9][j] = vis ? s[k9][j] : -INFINITY; mx = fmaxf(mx, s[k9][j]); }
        mx = fmaxf(mx, __shfl_xor(mx, 16)); mx = fmaxf(mx, __shfl_xor(mx, 32));
        float l = 0.f;
#pragma unroll
        for (int k9 = 0; k9 < 9; ++k9)
#pragma unroll
            for (int j = 0; j < 4; ++j) { const float e = __expf(s[k9][j] - mx); s[k9][j] = e; l += e; }
        l += __shfl_xor(l, 16); l += __shfl_xor(l, 32);
        l += __expf(sink - mx);
        const float inv_l = 1.0f / l;
        bf16x8 pf[5];
#pragma unroll
        for (int pp = 0; pp < 4; ++pp) pf[pp] = mk8(cvt_pk_bf16(s[2 * pp][0], s[2 * pp][1]), cvt_pk_bf16(s[2 * pp][2], s[2 * pp][3]), cvt_pk_bf16(s[2 * pp + 1][0], s[2 * pp + 1][1]), cvt_pk_bf16(s[2 * pp + 1][2], s[2 * pp + 1][3]));
        pf[4] = mk8(cvt_pk_bf16(s[8][0], s[8][1]), cvt_pk_bf16(s[8][2], s[8][3]), 0u, 0u);
        f32x4 o[4];
#pragma unroll
        for (int nt = 0; nt < 4; ++nt) { o[nt] = (f32x4){0.f, 0.f, 0.f, 0.f};
            const bf16_t* vr = Vt + (nt * 16 + fr) * VT_STRIDE + fq * 4;
#pragma unroll
            for (int pp = 0; pp < 5; ++pp) { const int kta = qt + 2 * pp, ktb = (kta + 1 > 15) ? 15 : kta + 1;
                const u32x2 lo = *(const u32x2*)(vr + kta * 16), hi = *(const u32x2*)(vr + ktb * 16);
                o[nt] = __builtin_amdgcn_mfma_f32_16x16x32_bf16(mk8(lo.x, lo.y, hi.x, hi.y), pf[pp], o[nt], 0, 0, 0); } }
#pragma unroll
        for (int nt = 0; nt < 4; ++nt) { const int col = hq * 64 + nt * 16 + fq * 4;
            const u32x2 gt = *(const u32x2*)(proj + tq * INW + OAG + col);
            u32x2 w; w.x = cvt_pk_bf16(o[nt][0] * inv_l * bflo(gt.x), o[nt][1] * inv_l * bfhi(gt.x)); w.y = cvt_pk_bf16(o[nt][2] * inv_l * bflo(gt.y), o[nt][3] * inv_l * bfhi(gt.y));
            *(u32x2*)(Aatt + tq * 1024 + col) = w; }
    }
    __syncthreads();
}

constexpr int H_STRIDE64 = 72;
constexpr int H_STRIDE128 = 136;
constexpr int NSC = NT / 256;
constexpr int NSU = NB * 8 * NSC;
struct HgrnRaw { unsigned hf[16]; unsigned hi[16]; };
__device__ __forceinline__ void hgrn_load_raw(const bf16_t* proj, size_t rc, int h, int d, int seg, HgrnRaw& R) {
    const bf16_t* bp = proj + (rc + seg * 16) * INW + h * 128 + d;
#pragma unroll
    for (int i = 0; i < 16; ++i) { R.hf[i] = bp[(size_t)i * INW + OHF]; R.hi[i] = bp[(size_t)i * INW + OHI]; }
}
__device__ __forceinline__ void hgrn_gates(const HgrnRaw& R, float lb, float (&bp)[16], float (&kk)[16]) {
    float run = 0.f;
#pragma unroll
    for (int i = 0; i < 16; ++i) {
        const float hf = __uint_as_float(R.hf[i] << 16);
        const float e = __expf(-hf), inv = fast_rcp(1.0f + e);
        const float f = lb + (1.0f - lb) * inv;
        kk[i] = (1.0f - lb) * e * inv;
        run += __logf(f); bp[i] = run;
    }
}
__device__ __forceinline__ void hgrn_store_vt(const HgrnRaw& R, bf16_t* Vt, int d, int seg) {
    unsigned w[8];
#pragma unroll
    for (int i = 0; i < 8; ++i) w[i] = R.hi[2 * i] | (R.hi[2 * i + 1] << 16);
    bf16_t* vd = Vt + d * H_STRIDE64 + seg * 16; *(u32x4*)vd = (u32x4){w[0], w[1], w[2], w[3]}; *(u32x4*)(vd + 8) = (u32x4){w[4], w[5], w[6], w[7]};
}

__device__ __forceinline__ void hgrn_local_unit(const Params& p, unsigned char* shm, int u) {
    const bf16_t* proj = (const bf16_t*)(p.ws + WS_PROJ);
    float* UT = p.out + (size_t)u * 16384; float* dtot = (float*)(p.ws + WS_DTOT) + (size_t)u * 128;
    bf16_t* KdT = (bf16_t*)shm;
    bf16_t* Vt = (bf16_t*)(shm + 128 * H_STRIDE64 * 2);
    float* segsum = (float*)(shm + 2 * 128 * H_STRIDE64 * 2);
    float* dsh = segsum + 512;
    const int tid = threadIdx.x, wid = tid >> 6, lane = tid & 63, fr = lane & 15, fq = lane >> 4;
    const int sc = u & 63, sq = u >> 6, h = sq & 7, b = sq >> 3; const size_t r0 = (size_t)b * NT + (size_t)sc * 256;
    const int d = tid & 127, seg = tid >> 7;
    const float lb = fast_rcp(1.0f + __expf(p.lbt[1024 + h * 128 + d] - p.lbt[h * 128 + d]));
    f32x4 acc[8];
#pragma unroll
    for (int vt = 0; vt < 8; ++vt) acc[vt] = (f32x4){0.f, 0.f, 0.f, 0.f};
    float bsum = 0.f;
    HgrnRaw R; hgrn_load_raw(proj, r0, h, d, seg, R);
#pragma unroll 1
    for (int cc = 0; cc < 4; ++cc) {
        float bp[16], kk[16];
        hgrn_gates(R, lb, bp, kk);
        segsum[seg * 128 + d] = bp[15];
        hgrn_store_vt(R, Vt, d, seg);
        if (cc < 3) hgrn_load_raw(proj, r0 + (size_t)(cc + 1) * 64, h, d, seg, R);
        __syncthreads();
        float off = 0.f, btot = 0.f;
#pragma unroll
        for (int s2 = 0; s2 < 4; ++s2) { const float v = segsum[s2 * 128 + d]; btot += v; if (s2 < seg) off += v; }
        { unsigned w[8];
#pragma unroll
          for (int i = 0; i < 8; ++i) { const float k0 = kk[2 * i] * __expf(btot - (off + bp[2 * i])), k1 = kk[2 * i + 1] * __expf(btot - (off + bp[2 * i + 1])); w[i] = cvt_pk_bf16(k0, k1); }
          bf16_t* kd = KdT + d * H_STRIDE64 + seg * 16; *(u32x4*)kd = (u32x4){w[0], w[1], w[2], w[3]}; *(u32x4*)(kd + 8) = (u32x4){w[4], w[5], w[6], w[7]}; }
        if (seg == 0) dsh[d] = __expf(btot);
        bsum += btot;
        __syncthreads();
        const f32x4 dv = *(const f32x4*)(dsh + 16 * wid + fq * 4);
#pragma unroll
        for (int vt = 0; vt < 8; ++vt) acc[vt] *= dv;
#pragma unroll
        for (int ks = 0; ks < 2; ++ks) { const bf16x8 a = *(const bf16x8*)(KdT + (16 * wid + fr) * H_STRIDE64 + ks * 32 + fq * 8);
#pragma unroll
            for (int vt = 0; vt < 8; ++vt) { const bf16x8 bv = *(const bf16x8*)(Vt + (16 * vt + fr) * H_STRIDE64 + ks * 32 + fq * 8);
                acc[vt] = __builtin_amdgcn_mfma_f32_16x16x32_bf16(a, bv, acc[vt], 0, 0, 0); } }
        __syncthreads();
    }
#pragma unroll
    for (int vt = 0; vt < 8; ++vt) *(f32x4*)(UT + (size_t)(16 * vt + fr) * 128 + 16 * wid + fq * 4) = acc[vt];
    if (seg == 0) dtot[d] = __expf(bsum);
}

__device__ __forceinline__ void hgrn_scan(const Params& p) {
    const float* dtot = (const float*)(p.ws + WS_DTOT);
    for (int gidx = blockIdx.x * 512 + threadIdx.x; gidx < 16 * 8192; gidx += gridDim.x * 512) {
        const int sq = gidx >> 13, e = (gidx & 8191) * 2, d = e & 127;
        float* base = p.out + (size_t)sq * NSC * 16384 + e; const float* db = dtot + (size_t)sq * NSC * 128 + d;
        f32x2 S = {0.f, 0.f};
        for (int c0 = 0; c0 < NSC; c0 += 8) {
            f32x2 U[8], D[8];
#pragma unroll
            for (int i = 0; i < 8; ++i) { U[i] = *(const f32x2*)(base + (size_t)(c0 + i) * 16384); D[i] = *(const f32x2*)(db + (size_t)(c0 + i) * 128); }
#pragma unroll
            for (int i = 0; i < 8; ++i) { *(f32x2*)(base + (size_t)(c0 + i) * 16384) = S; S = D[i] * S + U[i]; }
        }
    }
}

__device__ __forceinline__ void hgrn_out_unit(const Params& p, unsigned char* shm, int u) {
    const bf16_t* proj = (const bf16_t*)(p.ws + WS_PROJ);
    const float* ST = p.out + (size_t)u * 16384;
    bf16_t* Ahg = (bf16_t*)(p.ws + WS_AHGR);
    bf16_t* Qs = (bf16_t*)shm;
    bf16_t* Ks2 = (bf16_t*)(shm + 17408);
    bf16_t* Vt = (bf16_t*)(shm + 34816);
    bf16_t* KdT = (bf16_t*)(shm + 53248);
    bf16_t* St = (bf16_t*)(shm + 71680);
    float* segsum = (float*)(shm + 106496);
    float* eref = segsum + 512;
    float* dsh = eref + 128;
    float* part = dsh + 128;
    const int tid = threadIdx.x, wid = tid >> 6, lane = tid & 63, fr = lane & 15, fq = lane >> 4;
    const int sc = u & 63, sq = u >> 6, h = sq & 7, b = sq >> 3; const size_t r0 = (size_t)b * NT + (size_t)sc * 256;
    const int d = tid & 127, seg = tid >> 7;
    const int tt = wid & 3, vh = wid >> 2;
    const float lb = fast_rcp(1.0f + __expf(p.lbt[1024 + h * 128 + d] - p.lbt[h * 128 + d]));
    f32x4 acc[8];
#pragma unroll
    for (int vt = 0; vt < 8; ++vt) acc[vt] = *(const f32x4*)(ST + (size_t)(16 * vt + fr) * 128 + 16 * wid + fq * 4);
    f32x4 gn[4];
#pragma unroll
    for (int vt = 0; vt < 4; ++vt) gn[vt] = *(const f32x4*)(p.hgain + h * 128 + 16 * (vh * 4 + vt) + fq * 4);
    HgrnRaw R; hgrn_load_raw(proj, r0, h, d, seg, R);
    unsigned hq[16];
#pragma unroll
    for (int i = 0; i < 16; ++i) hq[i] = proj[(r0 + seg * 16 + i) * INW + OHQ + h * 128 + d];
#pragma unroll 1
    for (int cc = 0; cc < 4; ++cc) {
        const size_t rc = r0 + (size_t)cc * 64;
        float bp[16], kk[16];
        hgrn_gates(R, lb, bp, kk);
        segsum[seg * 128 + d] = bp[15];
        hgrn_store_vt(R, Vt, d, seg);
        __syncthreads();
        float off = 0.f, btot = 0.f;
#pragma unroll
        for (int s2 = 0; s2 < 4; ++s2) { const float v = segsum[s2 * 128 + d]; btot += v; if (s2 < seg) off += v; }
        const float bref = segsum[d] + segsum[128 + d];
        if (seg == 0) { eref[d] = __expf(bref); dsh[d] = __expf(btot); }
        { unsigned w[8];
#pragma unroll
          for (int i = 0; i < 8; ++i) { const float k0 = kk[2 * i] * __expf(btot - (off + bp[2 * i])), k1 = kk[2 * i + 1] * __expf(btot - (off + bp[2 * i + 1])); w[i] = cvt_pk_bf16(k0, k1); }
          bf16_t* kd = KdT + d * H_STRIDE64 + seg * 16; *(u32x4*)kd = (u32x4){w[0], w[1], w[2], w[3]}; *(u32x4*)(kd + 8) = (u32x4){w[4], w[5], w[6], w[7]}; }
#pragma unroll
        for (int i = 0; i < 16; ++i) { const float bb = off + bp[i] - bref; const int t = seg * 16 + i;
            const float qv = __uint_as_float(hq[i] << 16);
            const unsigned qk = cvt_pk_bf16(qv * __expf(bb), kk[i] * __expf(-bb));
            Qs[t * H_STRIDE128 + d] = (bf16_t)(qk & 0xffffu); Ks2[t * H_STRIDE128 + d] = (bf16_t)(qk >> 16); }
        if (cc < 3) { hgrn_load_raw(proj, rc + 64, h, d, seg, R);
#pragma unroll
            for (int i = 0; i < 16; ++i) hq[i] = proj[(rc + 64 + seg * 16 + i) * INW + OHQ + h * 128 + d]; }
        const size_t r = rc + 16 * tt + fr;
        u32x2 gt[4];
#pragma unroll
        for (int vt = 0; vt < 4; ++vt) gt[vt] = *(const u32x2*)(proj + r * INW + OHG + h * 128 + 16 * (vh * 4 + vt) + fq * 4);
        __syncthreads();
        { const f32x4 er = *(const f32x4*)(eref + 16 * wid + fq * 4);
#pragma unroll
          for (int vt = 0; vt < 8; ++vt) { const f32x4 sv = acc[vt] * er; u32x2 w; w.x = cvt_pk_bf16(sv[0], sv[1]); w.y = cvt_pk_bf16(sv[2], sv[3]);
              *(u32x2*)(St + (16 * vt + fr) * H_STRIDE128 + 16 * wid + fq * 4) = w; } }
        __syncthreads();
        bf16x8 bq[4];
#pragma unroll
        for (int ks = 0; ks < 4; ++ks) bq[ks] = *(const bf16x8*)(Qs + (16 * tt + fr) * H_STRIDE128 + ks * 32 + fq * 8);
        f32x4 pa[4];
#pragma unroll
        for (int st = 0; st < 4; ++st) { pa[st] = (f32x4){0.f, 0.f, 0.f, 0.f};
            if (st <= tt) {
#pragma unroll
                for (int ks = 0; ks < 4; ++ks) { const bf16x8 a = *(const bf16x8*)(Ks2 + (16 * st + fr) * H_STRIDE128 + ks * 32 + fq * 8);
                    pa[st] = __builtin_amdgcn_mfma_f32_16x16x32_bf16(a, bq[ks], pa[st], 0, 0, 0); }
#pragma unroll
                for (int j = 0; j < 4; ++j) { const int s_ = 16 * st + fq * 4 + j, t_ = 16 * tt + fr; pa[st][j] = (s_ <= t_) ? pa[st][j] : 0.f; }
            } }
        bf16x8 pf[2];
#pragma unroll
        for (int pp = 0; pp < 2; ++pp) pf[pp] = mk8(cvt_pk_bf16(pa[2 * pp][0], pa[2 * pp][1]), cvt_pk_bf16(pa[2 * pp][2], pa[2 * pp][3]), cvt_pk_bf16(pa[2 * pp + 1][0], pa[2 * pp + 1][1]), cvt_pk_bf16(pa[2 * pp + 1][2], pa[2 * pp + 1][3]));
        f32x4 o[4]; float ss = 0.f;
#pragma unroll
        for (int vt = 0; vt < 4; ++vt) { const int vrow = 16 * (vh * 4 + vt) + fr; o[vt] = (f32x4){0.f, 0.f, 0.f, 0.f};
#pragma unroll
            for (int pp = 0; pp < 2; ++pp) { const u32x2 lo = *(const u32x2*)(Vt + vrow * H_STRIDE64 + (2 * pp) * 16 + fq * 4), hi = *(const u32x2*)(Vt + vrow * H_STRIDE64 + (2 * pp + 1) * 16 + fq * 4);
                o[vt] = __builtin_amdgcn_mfma_f32_16x16x32_bf16(mk8(lo.x, lo.y, hi.x, hi.y), pf[pp], o[vt], 0, 0, 0); }
#pragma unroll
            for (int ks = 0; ks < 4; ++ks) { const bf16x8 a = *(const bf16x8*)(St + vrow * H_STRIDE128 + ks * 32 + fq * 8);
                o[vt] = __builtin_amdgcn_mfma_f32_16x16x32_bf16(a, bq[ks], o[vt], 0, 0, 0); }
            ss += o[vt][0] * o[vt][0] + o[vt][1] * o[vt][1] + o[vt][2] * o[vt][2] + o[vt][3] * o[vt][3]; }
        ss += __shfl_xor(ss, 16); ss += __shfl_xor(ss, 32);
        if (fq == 0) part[vh * 64 + 16 * tt + fr] = ss;
        if (cc < 3) {
            const f32x4 dv = *(const f32x4*)(dsh + 16 * wid + fq * 4);
#pragma unroll
            for (int vt = 0; vt < 8; ++vt) acc[vt] *= dv;
#pragma unroll
            for (int ks = 0; ks < 2; ++ks) { const bf16x8 a = *(const bf16x8*)(KdT + (16 * wid + fr) * H_STRIDE64 + ks * 32 + fq * 8);
#pragma unroll
                for (int vt = 0; vt < 8; ++vt) { const bf16x8 bv = *(const bf16x8*)(Vt + (16 * vt + fr) * H_STRIDE64 + ks * 32 + fq * 8);
                    acc[vt] = __builtin_amdgcn_mfma_f32_16x16x32_bf16(a, bv, acc[vt], 0, 0, 0); } }
        }
        __syncthreads();
        const float tot = part[16 * tt + fr] + part[64 + 16 * tt + fr];
        const float rstd = rsqrtf(tot * (1.0f / 128.0f) + 1e-6f);
#pragma unroll
        for (int vt = 0; vt < 4; ++vt) { const int col = h * 128 + 16 * (vh * 4 + vt) + fq * 4;
            u32x2 w; w.x = cvt_pk_bf16(o[vt][0] * rstd * gn[vt][0] * bflo(gt[vt].x), o[vt][1] * rstd * gn[vt][1] * bfhi(gt[vt].x)); w.y = cvt_pk_bf16(o[vt][2] * rstd * gn[vt][2] * bflo(gt[vt].y), o[vt][3] * rstd * gn[vt][3] * bfhi(gt[vt].y));
            *(u32x2*)(Ahg + r * 1024 + col) = w; }
    }
}

__device__ __forceinline__ void phase_final(const Params& p) {
    const int tid = threadIdx.x, wid = tid >> 6, lane = tid & 63;
    const bf16_t* yb = (const bf16_t*)(p.ws + WS_AATT);
    for (int r = blockIdx.x * 8 + wid; r < NTOK; r += gridDim.x * 8) {
        const float* xr = p.x + (size_t)r * DM;
        f32x4 v[8]; float ss = 0.f;
#pragma unroll
        for (int i = 0; i < 4; ++i) { const int c0 = (lane + 64 * i) * 8;
            const u32x4 yv = __builtin_nontemporal_load((const u32x4*)(yb + (size_t)r * DM + c0));
            const f32x4 x0 = __builtin_nontemporal_load((const f32x4*)(xr + c0)), x1 = __builtin_nontemporal_load((const f32x4*)(xr + c0 + 4));
            f32x4 a, b; a[0] = x0[0] + bflo(yv.x); a[1] = x0[1] + bfhi(yv.x); a[2] = x0[2] + bflo(yv.y); a[3] = x0[3] + bfhi(yv.y);
            b[0] = x1[0] + bflo(yv.z); b[1] = x1[1] + bfhi(yv.z); b[2] = x1[2] + bflo(yv.w); b[3] = x1[3] + bfhi(yv.w);
            ss += a[0] * a[0] + a[1] * a[1] + a[2] * a[2] + a[3] * a[3] + b[0] * b[0] + b[1] * b[1] + b[2] * b[2] + b[3] * b[3];
            v[2 * i] = a; v[2 * i + 1] = b; }
        ss = wave_sum(ss);
        const float rstd = rsqrtf(ss * (1.0f / DM) + 1e-6f);
        float* orow = p.out + (size_t)r * DM;
#pragma unroll
        for (int i = 0; i < 4; ++i) { const int c0 = (lane + 64 * i) * 8;
            const f32x4 g0 = *(const f32x4*)(p.fgain + c0), g1 = *(const f32x4*)(p.fgain + c0 + 4);
            f32x4 a = v[2 * i], b = v[2 * i + 1];
            a[0] = a[0] * rstd * g0[0]; a[1] = a[1] * rstd * g0[1]; a[2] = a[2] * rstd * g0[2]; a[3] = a[3] * rstd * g0[3];
            b[0] = b[0] * rstd * g1[0]; b[1] = b[1] * rstd * g1[1]; b[2] = b[2] * rstd * g1[2]; b[3] = b[3] * rstd * g1[3];
            __builtin_nontemporal_store(a, (f32x4*)(orow + c0)); __builtin_nontemporal_store(b, (f32x4*)(orow + c0 + 4)); }
    }
}

#define REP1 1
#define REP2 1
#define REP4 1
#define REP5 1
#define REP6 1
__global__ void __launch_bounds__(512, 2) fwd_megakernel(Params p) {
    extern __shared__ __attribute__((aligned(16))) unsigned char shm[];
    cg::grid_group grid = cg::this_grid();
    const int G = (int)gridDim.x, c = (int)blockIdx.x;
    phase_prep(p, shm);
    grid.sync();
    { pg8::Gemm g; g.A0 = (const bf16_t*)(p.ws + WS_HA); g.B0 = (const bf16_t*)(p.ws + WS_WIN); g.A1 = g.A0; g.B1 = g.B0; g.M = NTOK; g.N = INW; g.K = DM;
      pg8::StaticOrder S; S.init(NTOK, INW, G, c, 0, REP1); EpiProj E; E.O = (bf16_t*)(p.ws + WS_PROJ);
      pg8::gemm_phase<EpiProj>((LAS unsigned char*)shm, g, S, E); }
    grid.sync();
    for (int rep = 0; rep < REP2; ++rep) {
    for (int u = c; u < NAU; u += G) attn_unit(p, shm, u);
    for (int u = c; u < NSU; u += G) hgrn_local_unit(p, shm, u); }
    grid.sync();
    hgrn_scan(p);
    grid.sync();
    for (int rep = 0; rep < REP4; ++rep) for (int u = c; u < NSU; u += G) hgrn_out_unit(p, shm, u);
    grid.sync();
    { pg8::Gemm g; g.A0 = (const bf16_t*)(p.ws + WS_AATT); g.B0 = (const bf16_t*)(p.ws + WS_WAO); g.A1 = (const bf16_t*)(p.ws + WS_AHGR); g.B1 = (const bf16_t*)(p.ws + WS_WHO); g.M = NTOK; g.N = DM; g.K = 1024;
      pg8::StaticOrder S; S.init(NTOK, DM, G, c, 1, REP5); EpiMerge E; E.proj = (const bf16_t*)(p.ws + WS_PROJ); E.O = (bf16_t*)(p.ws + WS_HA);
      pg8::gemm_phase<EpiMerge>((LAS unsigned char*)shm, g, S, E); }
    grid.sync();
    { pg8::Gemm g; g.A0 = (const bf16_t*)(p.ws + WS_HA); g.B0 = (const bf16_t*)(p.ws + WS_WO); g.A1 = g.A0; g.B1 = g.B0; g.M = NTOK; g.N = DM; g.K = DM;
      pg8::StaticOrder S; S.init(NTOK, DM, G, c, 0, REP6); EpiY E; E.O = (bf16_t*)(p.ws + WS_AATT);
      pg8::gemm_phase<EpiY>((LAS unsigned char*)shm, g, S, E); }
    grid.sync();
    phase_final(p);
}

extern "C" void kernel_launch(void* const* d_in, const int* in_sizes, int n_in, void* d_out, int out_size, void* d_ws, size_t ws_size, hipStream_t stream) {
    constexpr size_t kDynLds = pg8::STAGE_BYTES;
    static int grid_blocks = 0;
    if (grid_blocks == 0) {
        if (ws_size < WS_END) { fprintf(stderr, "kernel_launch: workspace too small: %zu < %zu\n", ws_size, (size_t)WS_END); grid_blocks = -1; return; }
        int dev = 0, cus = 0, per_cu = 0;
        (void)hipGetDevice(&dev);
        (void)hipDeviceGetAttribute(&cus, hipDeviceAttributeMultiprocessorCount, dev);
        if (hipFuncSetAttribute((const void*)fwd_megakernel, hipFuncAttributeMaxDynamicSharedMemorySize, (int)kDynLds) != hipSuccess) { fprintf(stderr, "kernel_launch: hipFuncSetAttribute failed\n"); grid_blocks = -1; return; }
        if (hipOccupancyMaxActiveBlocksPerMultiprocessor(&per_cu, (const void*)fwd_megakernel, 512, kDynLds) != hipSuccess || per_cu < 1) { fprintf(stderr, "kernel_launch: occupancy query failed (%d)\n", per_cu); (void)hipGetLastError(); grid_blocks = -1; return; }
        if (per_cu > 1) per_cu = 1;
        grid_blocks = cus * per_cu;
    }
    if (grid_blocks < 0) return;
    Params p{};
    p.x = (const float*)d_in[0]; p.pos = (const int*)d_in[1]; p.norm_gain = (const float*)d_in[2]; p.w_in = (const float*)d_in[3]; p.sinks = (const float*)d_in[4];
    p.lbt = (const float*)d_in[5]; p.hgain = (const float*)d_in[6]; p.w_ao = (const float*)d_in[7]; p.w_ho = (const float*)d_in[8]; p.w_o = (const float*)d_in[9];
    p.fgain = (const float*)d_in[10]; p.out = (float*)d_out; p.ws = (unsigned char*)d_ws;
    void* args[] = {&p};
    hipError_t e = hipLaunchCooperativeKernel((const void*)fwd_megakernel, dim3(grid_blocks), dim3(512), args, kDynLds, stream);
    if (e != hipSuccess) fprintf(stderr, "cooperative launch failed: %s (grid %d)\n", hipGetErrorString(e), grid_blocks);
}
```

```cpp
#include <hip/hip_runtime.h>
#include <hip/hip_cooperative_groups.h>
#include <cstdio>
namespace cg = cooperative_groups;

#define LAS __attribute__((address_space(3)))
typedef unsigned short bf16_t;
typedef short bf16x8 __attribute__((ext_vector_type(8)));
typedef float f32x4 __attribute__((ext_vector_type(4)));
typedef float f32x2 __attribute__((ext_vector_type(2)));
typedef unsigned u32x4 __attribute__((ext_vector_type(4)));
typedef unsigned u32x2 __attribute__((ext_vector_type(2)));

constexpr int NB = 2, NT = 16384, NTOK = NB * NT, DM = 2048, INW = 10752;
constexpr int OQ = 0, OKK = 1024, OV = 1280, OAG = 1536, OHQ = 2560, OHF = 3584, OHI = 4608, OHG = 5632, OMA = 6656, OMH = 8704;
constexpr int NCHUNK = NT / 64;
constexpr int NHU = NB * 8 * NCHUNK;
constexpr int NAU = NB * (NT / 128) * 4;

constexpr size_t WS_HA = 0;
constexpr size_t WS_WIN = WS_HA + (size_t)NTOK * DM * 2;
constexpr size_t WS_WAO = WS_WIN + (size_t)INW * DM * 2;
constexpr size_t WS_WHO = WS_WAO + (size_t)DM * 1024 * 2;
constexpr size_t WS_WO = WS_WHO + (size_t)DM * 1024 * 2;
constexpr size_t WS_PROJ = WS_WO + (size_t)DM * DM * 2;
constexpr size_t WS_ROPE = WS_PROJ + (size_t)NTOK * INW * 2;
constexpr size_t WS_AATT = WS_ROPE + (size_t)NTOK * 32 * 8;
constexpr size_t WS_AHGR = WS_AATT + (size_t)NTOK * 1024 * 2;
constexpr size_t WS_DTOT = WS_AHGR + (size_t)NTOK * 1024 * 2;
constexpr size_t WS_RSS = WS_DTOT + (size_t)NHU * 128 * 4;
constexpr size_t WS_END = WS_RSS + (size_t)NTOK * 32 * 4;
constexpr size_t WS_BAR = WS_RSS;

struct Params {
    const float* x; const int* pos; const float* norm_gain; const float* w_in; const float* sinks; const float* lbt;
    const float* hgain; const float* w_ao; const float* w_ho; const float* w_o; const float* fgain;
    float* out; unsigned char* ws;
};

__constant__ float c_inv_freq[32] = {
    1.0f, 0.749894261f, 0.562341332f, 0.421696514f, 0.316227764f, 0.237137377f, 0.177827939f, 0.133352131f, 0.100000001f, 0.0749894157f,
    0.0562341325f, 0.0421696529f, 0.0316227749f, 0.0237137377f, 0.0177827943f, 0.0133352149f, 0.00999999978f, 0.00749894185f,
    0.00562341325f, 0.00421696482f, 0.00316227763f, 0.00237137359f, 0.00177827943f, 0.00133352145f, 0.00100000005f, 0.000749894243f,
    0.000562341302f, 0.000421696517f, 0.000316227757f, 0.00023713737f, 0.00017782794f, 0.00013335215f};

__device__ __forceinline__ float bf2f(bf16_t b) { return __uint_as_float(((unsigned)b) << 16); }
__device__ __forceinline__ float bflo(unsigned w) { return __uint_as_float(w << 16); }
__device__ __forceinline__ float bfhi(unsigned w) { return __uint_as_float(w & 0xffff0000u); }
__device__ __forceinline__ unsigned cvt_pk_bf16(float lo, float hi) { unsigned r; asm volatile("v_cvt_pk_bf16_f32 %0, %1, %2" : "=v"(r) : "v"(lo), "v"(hi)); return r; }
__device__ __forceinline__ float fast_rcp(float x) { return __builtin_amdgcn_rcpf(x); }
__device__ __forceinline__ float sigmoidf_(float v) { return fast_rcp(1.0f + __expf(-v)); }
__device__ __forceinline__ float wave_sum(float v) {
#pragma unroll
    for (int o = 32; o > 0; o >>= 1) v += __shfl_xor(v, o);
    return v;
}
__device__ __forceinline__ bf16x8 mk8(unsigned a, unsigned b, unsigned c, unsigned d) { u32x4 w; w.x = a; w.y = b; w.z = c; w.w = d; return __builtin_bit_cast(bf16x8, w); }

namespace pg8 {
constexpr int BM = 256, BK = 64, HALF = 128, HTB = HALF * BK * 2, STAGE_BYTES = 8 * HTB, NXCD = 8, WGM = 8;
__host__ __device__ __forceinline__ int lds_byte(int r, int c) { const int st = (r >> 4) * 2 + (c >> 5), rr = r & 15, cc = c & 31, ob = rr * 64 + cc * 2; return st * 1024 + (ob ^ (((ob >> 9) & 1) << 5)); }
__host__ __device__ __forceinline__ void stage_rc(int b, int& R, int& C) { const int st = b / 1024, sb = b % 1024, swz = sb ^ (((sb >> 9) & 1) << 5); R = (st >> 1) * 16 + swz / 64; C = (st & 1) * 32 + (swz % 64) / 2; }
__host__ __device__ __forceinline__ int perm32(int rho) { const int n = rho >> 4, i = rho & 15; return 8 * (i >> 2) + 4 * n + (i & 3); }

struct Unit { int pm, pn, kind, rep; };
struct Gemm { const bf16_t* A0; const bf16_t* B0; const bf16_t* A1; const bf16_t* B1; int M, N, K; };

struct StaticOrder {
    int nM, nN, nwg, G, c, dual, R, reps;
    __device__ void init(int M, int N, int G_, int c_, int dual_, int reps_ = 1) { nM = M / BM; nN = N / BM; nwg = nM * nN; G = G_; c = c_; dual = dual_; R = (nwg + G - 1) / G; reps = reps_; }
    __device__ bool next(int i, Unit& u) const {
        if (i >= reps * (R << dual)) return false;
        const int it = (i >> dual) % R;
        const long L = (long)it * G + c; if (L >= nwg) return false;
        int wgid = (int)L; { const int q = nwg / NXCD, r = nwg % NXCD, xcd = wgid % NXCD, off = wgid / NXCD; wgid = (xcd < r ? xcd * (q + 1) : r * (q + 1) + (xcd - r) * q) + off; }
        const int nig = WGM * nN, gid = wgid / nig, fm = gid * WGM, gsz = (nM - fm) < WGM ? (nM - fm) : WGM;
        u.pm = fm + ((wgid % nig) % gsz); u.pn = (wgid % nig) / gsz; u.kind = i & dual; u.rep = (i >> dual) / R; return true;
    }
};

template <class Epi>
__device__ __forceinline__ void gemm_phase(LAS unsigned char* lds, const Gemm g, const StaticOrder& S, const Epi& E) {
    const int tid = threadIdx.x, wid = __builtin_amdgcn_readfirstlane(tid >> 6), lane = tid & 63, wr = wid >> 2, wc = wid & 3, fr = lane & 15, fq = lane >> 4;
    const int K = g.K, nt = K / BK;
    unsigned voffA[2], voffB[2];
#pragma unroll
    for (int i = 0; i < 2; ++i) { int R, C; stage_rc(tid * 16 + i * 8192, R, C); const int Rb = Epi::PERM ? ((R & ~31) + perm32(R & 31)) : R;
        voffA[i] = (unsigned)(R * K + C) * 2u; voffB[i] = (unsigned)(Rb * K + C) * 2u; }
    const size_t kstep = (size_t)(BK * 2);
    const size_t hstep = (size_t)HALF * K * 2;
    const size_t tstep = 2 * hstep;
    const unsigned ldsw = (unsigned)wid * 1024u;
    const int aoff = lds_byte(wr * 64 + fr, fq * 8), boff = lds_byte(wc * 32 + fr, fq * 8);
#define PG8_SA(b, h) (((b) * 2 + (h)) * HTB)
#define PG8_SB(b, h) ((4 + (b) * 2 + (h)) * HTB)
#define PG8_STAGE(bufoff, gbase, voff) do { _Pragma("unroll") for (int _i = 0; _i < 2; ++_i) \
        __builtin_amdgcn_global_load_lds((const unsigned*)((const char*)(gbase) + (voff)[_i]), (LAS unsigned*)(lds + (bufoff) + ldsw + _i * 8192), 16, 0, 0); } while (0)
#define PG8_LDA(dst, b, h) do { _Pragma("unroll") for (int m = 0; m < 4; ++m) _Pragma("unroll") for (int k = 0; k < 2; ++k) dst[m][k] = *(const LAS bf16x8*)(lds + PG8_SA(b, h) + aoff + m * 2048 + k * 1024); } while (0)
#define PG8_LDB(dst, b, h) do { _Pragma("unroll") for (int n = 0; n < 2; ++n) _Pragma("unroll") for (int k = 0; k < 2; ++k) dst[n][k] = *(const LAS bf16x8*)(lds + PG8_SB(b, h) + boff + n * 2048 + k * 1024); } while (0)
#define PG8_MMA(ai, bj, At, Bt) do { __builtin_amdgcn_s_setprio(1); _Pragma("unroll") for (int m = 0; m < 4; ++m) _Pragma("unroll") for (int n = 0; n < 2; ++n) _Pragma("unroll") for (int k = 0; k < 2; ++k) \
        acc[ai][bj][m][n] = __builtin_amdgcn_mfma_f32_16x16x32_bf16(Bt[n][k], At[m][k], acc[ai][bj][m][n], 0, 0, 0); __builtin_amdgcn_s_setprio(0); } while (0)
#define PG8_WAIT_V(n) asm volatile("s_waitcnt vmcnt(" #n ")" ::: "memory")
#define PG8_WAIT_L(n) asm volatile("s_waitcnt lgkmcnt(" #n ")" ::: "memory")
#define PG8_BAR __builtin_amdgcn_s_barrier()
#define PG8_SCHED __builtin_amdgcn_sched_barrier(0)
    Unit cur, nxt; int ui = 0;
    if (!S.next(0, cur)) return;
    f32x4 acc[2][2][4][2];
#pragma unroll
    for (int a = 0; a < 2; ++a)
#pragma unroll
        for (int b = 0; b < 2; ++b)
#pragma unroll
            for (int m = 0; m < 4; ++m)
#pragma unroll
                for (int n = 0; n < 2; ++n) acc[a][b][m][n] = (f32x4){0.f, 0.f, 0.f, 0.f};
    bf16x8 At[4][2], B0[2][2], B1[2][2];
    const char* cA = (const char*)(cur.kind ? g.A1 : g.A0) + (size_t)cur.pm * tstep; const char* cB = (const char*)(cur.kind ? g.B1 : g.B0) + (size_t)cur.pn * tstep;
    PG8_STAGE(PG8_SB(0, 0), cB, voffB); PG8_STAGE(PG8_SA(0, 0), cA, voffA); PG8_STAGE(PG8_SB(0, 1), cB + hstep, voffB); PG8_STAGE(PG8_SA(0, 1), cA + hstep, voffA);
    if (wr == 1) PG8_BAR;
    PG8_WAIT_V(4); PG8_BAR;
    PG8_STAGE(PG8_SB(1, 0), cB + kstep, voffB); PG8_STAGE(PG8_SA(1, 0), cA + kstep, voffA); PG8_STAGE(PG8_SB(1, 1), cB + hstep + kstep, voffB);
    PG8_WAIT_V(6); PG8_BAR;
    for (;;) {
        const bool has_next = S.next(ui + 1, nxt);
        const char* nA = has_next ? (const char*)(nxt.kind ? g.A1 : g.A0) + (size_t)nxt.pm * tstep : cA; const char* nB = has_next ? (const char*)(nxt.kind ? g.B1 : g.B0) + (size_t)nxt.pn * tstep : cB;
        for (int t = 0; t < nt; t += 2) {
            const bool last = (t == nt - 2);
            const char* a1 = cA + (size_t)(t + 1) * kstep;
            const char* a2 = last ? nA : cA + (size_t)(t + 2) * kstep; const char* b2 = last ? nB : cB + (size_t)(t + 2) * kstep;
            const char* a3 = a2 + kstep; const char* b3 = b2 + kstep;
            PG8_LDB(B0, 0, 0); PG8_SCHED; PG8_LDA(At, 0, 0); PG8_STAGE(PG8_SA(1, 1), a1 + hstep, voffA);
            PG8_WAIT_L(8); PG8_BAR; PG8_WAIT_L(0); PG8_MMA(0, 0, At, B0); PG8_BAR; PG8_SCHED;
            PG8_LDB(B1, 0, 1); PG8_STAGE(PG8_SB(0, 0), b2, voffB);
            PG8_BAR; PG8_WAIT_L(0); PG8_MMA(0, 1, At, B1); PG8_BAR;
            PG8_LDA(At, 0, 1); PG8_STAGE(PG8_SA(0, 0), a2, voffA);
            PG8_BAR; PG8_WAIT_L(0); PG8_MMA(1, 0, At, B0); PG8_BAR; PG8_SCHED;
            PG8_STAGE(PG8_SB(0, 1), b2 + hstep, voffB);
            PG8_WAIT_V(6); PG8_BAR; PG8_MMA(1, 1, At, B1); PG8_BAR;
            PG8_LDB(B0, 1, 0); PG8_SCHED; PG8_LDA(At, 1, 0); PG8_STAGE(PG8_SA(0, 1), a2 + hstep, voffA);
            PG8_WAIT_L(8); PG8_BAR; PG8_WAIT_L(0); PG8_MMA(0, 0, At, B0); PG8_BAR; PG8_SCHED;
            PG8_LDB(B1, 1, 1); PG8_STAGE(PG8_SB(1, 0), b3, voffB);
            PG8_BAR; PG8_WAIT_L(0); PG8_MMA(0, 1, At, B1); PG8_BAR;
            PG8_LDA(At, 1, 1); PG8_STAGE(PG8_SA(1, 0), a3, voffA);
            PG8_BAR; PG8_WAIT_L(0); PG8_MMA(1, 0, At, B0); PG8_BAR; PG8_SCHED;
            PG8_STAGE(PG8_SB(1, 1), b3 + hstep, voffB);
            PG8_WAIT_V(6); PG8_BAR; PG8_MMA(1, 1, At, B1); PG8_BAR;
        }
        const bool keep = E(acc, cur, wr, wc, fr, fq);
        if (!has_next) break;
        if (!keep) {
#pragma unroll
            for (int a = 0; a < 2; ++a)
#pragma unroll
                for (int b = 0; b < 2; ++b)
#pragma unroll
                    for (int m = 0; m < 4; ++m)
#pragma unroll
                        for (int n = 0; n < 2; ++n) acc[a][b][m][n] = (f32x4){0.f, 0.f, 0.f, 0.f};
        }
        cur = nxt; cA = nA; cB = nB; ++ui;
    }
    PG8_WAIT_V(0);
    if (wr == 0) PG8_BAR;
    PG8_BAR;
#undef PG8_SA
#undef PG8_SB
#undef PG8_STAGE
#undef PG8_LDA
#undef PG8_LDB
#undef PG8_MMA
#undef PG8_WAIT_V
#undef PG8_WAIT_L
#undef PG8_BAR
#undef PG8_SCHED
}
}

#define PROBE_SKIP_EPI 0
struct EpiProj {
    static constexpr bool PERM = true;
    bf16_t* O;
    __device__ __forceinline__ bool operator()(f32x4 (&acc)[2][2][4][2], const pg8::Unit& u, int wr, int wc, int fr, int fq) const {
        if (PROBE_SKIP_EPI && u.rep) return false;
        const int pn = u.pn;
        int mode = 0; float scale = 1.0f;
        if ((pn >= 6 && pn < 10) || (pn >= 22 && pn < 26)) mode = 1;
        else if (pn >= 10 && pn < 14) { mode = 1; scale = 0.08838834764831845f; }
        const int row0 = u.pm * 256 + wr * 64 + fr, col0 = pn * 256 + wc * 32 + 8 * fq;
        if (pn >= 26) {
#pragma unroll
            for (int ai = 0; ai < 2; ++ai)
#pragma unroll
                for (int m = 0; m < 4; ++m) { bf16_t* rowp = O + (size_t)(row0 + ai * 128 + m * 16) * INW + col0;
                    float rr[8], s2[8];
#pragma unroll
                    for (int n = 0; n < 2; ++n)
#pragma unroll
                        for (int j = 0; j < 4; ++j) { const float p1 = 1.0f + fminf(__expf(-acc[ai][0][m][n][j]), 1e15f), p2 = 1.0f + fminf(__expf(-acc[ai][1][m][n][j]), 1e15f);
                            const float inv = fast_rcp(p1 * p2);
                            s2[4 * n + j] = p1 * inv; rr[4 * n + j] = p2 * p2 * inv; }
                    u32x4 w; w.x = cvt_pk_bf16(rr[0], rr[1]); w.y = cvt_pk_bf16(rr[2], rr[3]); w.z = cvt_pk_bf16(rr[4], rr[5]); w.w = cvt_pk_bf16(rr[6], rr[7]);
                    __builtin_nontemporal_store(w, (u32x4*)rowp);
                    w.x = cvt_pk_bf16(s2[0], s2[1]); w.y = cvt_pk_bf16(s2[2], s2[3]); w.z = cvt_pk_bf16(s2[4], s2[5]); w.w = cvt_pk_bf16(s2[6], s2[7]);
                    __builtin_nontemporal_store(w, (u32x4*)(rowp + 128)); }
            return false;
        }
#pragma unroll
        for (int ai = 0; ai < 2; ++ai)
#pragma unroll
            for (int m = 0; m < 4; ++m) { bf16_t* rowp = O + (size_t)(row0 + ai * 128 + m * 16) * INW + col0;
#pragma unroll
                for (int bj = 0; bj < 2; ++bj) { f32x4 v0 = acc[ai][bj][m][0], v1 = acc[ai][bj][m][1];
                    if (mode != 0) {
#pragma unroll
                        for (int j = 0; j < 4; ++j) { v0[j] = v0[j] * sigmoidf_(v0[j]) * scale; v1[j] = v1[j] * sigmoidf_(v1[j]) * scale; }
                    }
                    u32x4 w; w.x = cvt_pk_bf16(v0[0], v0[1]); w.y = cvt_pk_bf16(v0[2], v0[3]); w.z = cvt_pk_bf16(v1[0], v1[1]); w.w = cvt_pk_bf16(v1[2], v1[3]);
                    __builtin_nontemporal_store(w, (u32x4*)(rowp + bj * 128)); } }
        return false;
    }
};
struct EpiMerge {
    static constexpr bool PERM = true;
    const bf16_t* proj; bf16_t* O;
    __device__ __forceinline__ bool operator()(f32x4 (&acc)[2][2][4][2], const pg8::Unit& u, int wr, int wc, int fr, int fq) const {
        const int row0 = u.pm * 256 + wr * 64 + fr, lc = wc * 32 + 8 * fq;
        const int goff = OMA + u.pn * 512 + (u.kind ? 128 : 0) + lc;
        u32x4 Gv[2][4][2];
#pragma unroll
        for (int ai = 0; ai < 2; ++ai)
#pragma unroll
            for (int m = 0; m < 4; ++m)
#pragma unroll
                for (int bj = 0; bj < 2; ++bj) Gv[ai][m][bj] = __builtin_nontemporal_load((const u32x4*)(proj + (size_t)(row0 + ai * 128 + m * 16) * INW + goff + bj * 256));
#pragma unroll
        for (int ai = 0; ai < 2; ++ai)
#pragma unroll
            for (int m = 0; m < 4; ++m)
#pragma unroll
                for (int bj = 0; bj < 2; ++bj) { const u32x4 g = Gv[ai][m][bj];
                    const float gs[8] = {bflo(g.x), bfhi(g.x), bflo(g.y), bfhi(g.y), bflo(g.z), bfhi(g.z), bflo(g.w), bfhi(g.w)};
                    f32x4 v0 = acc[ai][bj][m][0], v1 = acc[ai][bj][m][1];
#pragma unroll
                    for (int j = 0; j < 4; ++j) { v0[j] *= gs[j]; v1[j] *= gs[4 + j]; }
                    if (u.kind == 0) { acc[ai][bj][m][0] = v0; acc[ai][bj][m][1] = v1; }
                    else { u32x4 w; w.x = cvt_pk_bf16(v0[0], v0[1]); w.y = cvt_pk_bf16(v0[2], v0[3]); w.z = cvt_pk_bf16(v1[0], v1[1]); w.w = cvt_pk_bf16(v1[2], v1[3]);
                        *(u32x4*)(O + (size_t)(row0 + ai * 128 + m * 16) * DM + u.pn * 256 + bj * 128 + lc) = w; } }
        return u.kind == 0;
    }
};
struct EpiY {
    static constexpr bool PERM = true;
    bf16_t* O;
    __device__ __forceinline__ bool operator()(f32x4 (&acc)[2][2][4][2], const pg8::Unit& u, int wr, int wc, int fr, int fq) const {
        const int row0 = u.pm * 256 + wr * 64 + fr, col0 = u.pn * 256 + wc * 32 + 8 * fq;
#pragma unroll
        for (int ai = 0; ai < 2; ++ai)
#pragma unroll
            for (int m = 0; m < 4; ++m) { bf16_t* rowp = O + (size_t)(row0 + ai * 128 + m * 16) * DM + col0;
#pragma unroll
                for (int bj = 0; bj < 2; ++bj) { const f32x4 v0 = acc[ai][bj][m][0], v1 = acc[ai][bj][m][1];
                    u32x4 w; w.x = cvt_pk_bf16(v0[0], v0[1]); w.y = cvt_pk_bf16(v0[2], v0[3]); w.z = cvt_pk_bf16(v1[0], v1[1]); w.w = cvt_pk_bf16(v1[2], v1[3]);
                    __builtin_nontemporal_store(w, (u32x4*)(rowp + bj * 128)); } }
        return false;
    }
};

template <bool GATE_MAP>
__device__ __forceinline__ void transpose_tile_wave(const float* __restrict__ W, int K, int N, bf16_t* __restrict__ WT, int tile, int lane) {
    const int ntn = N >> 6; const int k0 = (tile / ntn) * 64, n0 = (tile % ntn) * 64;
    const float* src = W + (size_t)k0 * N + n0 + lane;
    float v[64];
#pragma unroll
    for (int i = 0; i < 64; ++i) v[i] = src[(size_t)i * N];
    int nrow = n0;
    if (GATE_MAP && n0 >= OMA) { const int hg = (n0 >= OMH) ? 1 : 0, ch = n0 - (hg ? OMH : OMA); nrow = OMA + (ch >> 7) * 256 + hg * 128 + (ch & 127); }
    bf16_t* dst = WT + (size_t)(nrow + lane) * K + k0;
#pragma unroll
    for (int i = 0; i < 8; ++i) { u32x4 w; w.x = cvt_pk_bf16(v[8 * i], v[8 * i + 1]); w.y = cvt_pk_bf16(v[8 * i + 2], v[8 * i + 3]); w.z = cvt_pk_bf16(v[8 * i + 4], v[8 * i + 5]); w.w = cvt_pk_bf16(v[8 * i + 6], v[8 * i + 7]);
        *(u32x4*)(dst + 8 * i) = w; }
}

__device__ __forceinline__ void phase_prep(const Params& p, unsigned char* shm) {
    const int tid = threadIdx.x, wid = tid >> 6, lane = tid & 63;
    bf16_t* hA = (bf16_t*)(p.ws + WS_HA);
    for (int r = blockIdx.x * 8 + wid; r < NTOK; r += gridDim.x * 8) {
        const f32x4* xr = (const f32x4*)(p.x + (size_t)r * DM);
        f32x4 v[8]; float ss = 0.f;
#pragma unroll
        for (int i = 0; i < 8; ++i) { v[i] = xr[lane + 64 * i]; ss += v[i][0] * v[i][0] + v[i][1] * v[i][1] + v[i][2] * v[i][2] + v[i][3] * v[i][3]; }
        ss = wave_sum(ss);
        const float rstd = rsqrtf(ss * (1.0f / DM) + 1e-6f);
#pragma unroll
        for (int i = 0; i < 8; ++i) { const f32x4 g = ((const f32x4*)p.norm_gain)[lane + 64 * i];
            u32x2 w; w.x = cvt_pk_bf16(v[i][0] * rstd * g[0], v[i][1] * rstd * g[1]); w.y = cvt_pk_bf16(v[i][2] * rstd * g[2], v[i][3] * rstd * g[3]);
            *(u32x2*)(hA + (size_t)r * DM + (lane + 64 * i) * 4) = w; }
    }
    constexpr int T_IN = (DM / 64) * (INW / 64), T_AO = (1024 / 64) * (DM / 64), T_WO = (DM / 64) * (DM / 64);
    for (int t = blockIdx.x * 8 + wid; t < T_IN + 2 * T_AO + T_WO; t += gridDim.x * 8) {
        if (t < T_IN) transpose_tile_wave<true>(p.w_in, DM, INW, (bf16_t*)(p.ws + WS_WIN), t, lane);
        else if (t < T_IN + T_AO) transpose_tile_wave<false>(p.w_ao, 1024, DM, (bf16_t*)(p.ws + WS_WAO), t - T_IN, lane);
        else if (t < T_IN + 2 * T_AO) transpose_tile_wave<false>(p.w_ho, 1024, DM, (bf16_t*)(p.ws + WS_WHO), t - T_IN - T_AO, lane);
        else transpose_tile_wave<false>(p.w_o, DM, DM, (bf16_t*)(p.ws + WS_WO), t - T_IN - 2 * T_AO, lane);
    }
    f32x2* rope = (f32x2*)(p.ws + WS_ROPE);
    for (int idx = blockIdx.x * 512 + tid; idx < NTOK * 32; idx += gridDim.x * 512) {
        const int tok = idx >> 5, i = idx & 31;
        const float ang = (float)p.pos[tok] * c_inv_freq[i];
        const double a = (double)ang; const double kq = rint(a * 0.63661977236758134308);
        const double r = fma(-kq, 1.5707963267948966192, a) - kq * 6.123233995736766e-17;
        const double r2 = r * r;
        double sn = r2 * (-1.0 / 39916800.0) + (1.0 / 362880.0); sn = sn * r2 - (1.0 / 5040.0); sn = sn * r2 + (1.0 / 120.0); sn = sn * r2 - (1.0 / 6.0); sn = sn * r2 * r + r;
        double cs = r2 * (1.0 / 479001600.0) - (1.0 / 3628800.0); cs = cs * r2 + (1.0 / 40320.0); cs = cs * r2 - (1.0 / 720.0); cs = cs * r2 + (1.0 / 24.0); cs = cs * r2 - 0.5; cs = cs * r2 + 1.0;
        const int q = ((int)(long long)kq) & 3;
        const double c_ = (q == 0) ? cs : (q == 1) ? -sn : (q == 2) ? -cs : sn;
        const double s_ = (q == 0) ? sn : (q == 1) ? cs : (q == 2) ? -sn : -cs;
        f32x2 o; o.x = (float)c_; o.y = (float)s_; rope[idx] = o;
    }
}

constexpr int KS_STRIDE = 72;
constexpr int VT_STRIDE = 264;
struct AttnStage { u32x4 k1a, k1b, k2a, k2b; u32x4 va0, va1, vb0, vb1; };
struct AttnQ { u32x4 x1, x2; f32x4 rp[4]; };
__device__ __forceinline__ void attn_unit_coords(int unit, int& kvh, int& n, int& tq0) { kvh = unit & 3; const int blk = unit >> 2; n = blk & 127; tq0 = (blk >> 7) * NT + n * 128; }
__device__ __forceinline__ void attn_load_stage(const bf16_t* proj, const f32x2* rope, int unit, int tid, AttnStage& S) {
    int kvh, n, tq0; attn_unit_coords(unit, kvh, n, tq0); const int tk0 = tq0 - 128;
    { const int key = tid & 255, hc = tid >> 8;
      if ((n > 0) || (key >= 128)) { const size_t tok = (size_t)(tk0 + key);
          const bf16_t* kp = proj + tok * INW + OKK + kvh * 64 + hc * 16;
          S.k1a = *(const u32x4*)kp; S.k1b = *(const u32x4*)(kp + 8); S.k2a = *(const u32x4*)(kp + 32); S.k2b = *(const u32x4*)(kp + 40);
      } else { S.k1a = S.k1b = S.k2a = S.k2b = (u32x4){0, 0, 0, 0}; } }
    { const int kp = tid & 127, dc = tid >> 7;
      if ((n > 0) || (kp >= 64)) { const bf16_t* vp = proj + (size_t)(tk0 + 2 * kp) * INW + OV + kvh * 64 + dc * 16;
          S.va0 = *(const u32x4*)vp; S.va1 = *(const u32x4*)(vp + 8); S.vb0 = *(const u32x4*)(vp + INW); S.vb1 = *(const u32x4*)(vp + INW + 8);
      } else { S.va0 = S.va1 = S.vb0 = S.vb1 = (u32x4){0, 0, 0, 0}; } }
}
__device__ __forceinline__ void attn_write_stage(const AttnStage& S, const f32x2* rope, int tk0, bf16_t* Ks, bf16_t* Vt, int tid) {
    { const int key = tid & 255, hc = tid >> 8;
      const int tokc = (tk0 + key) < 0 ? 0 : (tk0 + key);
      const f32x4* rp = (const f32x4*)(rope + (size_t)tokc * 32 + hc * 16);
      const unsigned x1[8] = {S.k1a.x, S.k1a.y, S.k1a.z, S.k1a.w, S.k1b.x, S.k1b.y, S.k1b.z, S.k1b.w};
      const unsigned x2[8] = {S.k2a.x, S.k2a.y, S.k2a.z, S.k2a.w, S.k2b.x, S.k2b.y, S.k2b.z, S.k2b.w};
      unsigned r1[8], r2[8];
#pragma unroll
      for (int i = 0; i < 8; ++i) { const f32x4 cs = rp[i];
          const float a0 = bflo(x1[i]), a1 = bfhi(x1[i]), b0 = bflo(x2[i]), b1 = bfhi(x2[i]);
          r1[i] = cvt_pk_bf16(a0 * cs[0] - b0 * cs[1], a1 * cs[2] - b1 * cs[3]);
          r2[i] = cvt_pk_bf16(b0 * cs[0] + a0 * cs[1], b1 * cs[2] + a1 * cs[3]); }
      bf16_t* kd = Ks + key * KS_STRIDE + hc * 16;
      *(u32x4*)kd = (u32x4){r1[0], r1[1], r1[2], r1[3]}; *(u32x4*)(kd + 8) = (u32x4){r1[4], r1[5], r1[6], r1[7]};
      *(u32x4*)(kd + 32) = (u32x4){r2[0], r2[1], r2[2], r2[3]}; *(u32x4*)(kd + 40) = (u32x4){r2[4], r2[5], r2[6], r2[7]}; }
    { const int kp = tid & 127, dc = tid >> 7;
      const unsigned a[8] = {S.va0.x, S.va0.y, S.va0.z, S.va0.w, S.va1.x, S.va1.y, S.va1.z, S.va1.w};
      const unsigned c[8] = {S.vb0.x, S.vb0.y, S.vb0.z, S.vb0.w, S.vb1.x, S.vb1.y, S.vb1.z, S.vb1.w};
      unsigned* vd = (unsigned*)(Vt + (dc * 16) * VT_STRIDE + 2 * kp);
#pragma unroll
      for (int i = 0; i < 8; ++i) {
          vd[(2 * i) * (VT_STRIDE / 2)] = (a[i] & 0xffffu) | (c[i] << 16);
          vd[(2 * i + 1) * (VT_STRIDE / 2)] = (a[i] >> 16) | (c[i] & 0xffff0000u); } }
}
__device__ __forceinline__ void attn_load_q(const bf16_t* proj, const f32x2* rope, size_t tq, int hq, int fq, AttnQ& Q) {
    const bf16_t* qp = proj + tq * INW + OQ + hq * 64 + fq * 8;
    Q.x1 = *(const u32x4*)qp; Q.x2 = *(const u32x4*)(qp + 32);
    const f32x4* rp = (const f32x4*)(rope + tq * 32 + fq * 8);
#pragma unroll
    for (int i = 0; i < 4; ++i) Q.rp[i] = rp[i];
}
__device__ __forceinline__ void attn_qtile(const AttnQ& Q, const bf16_t* proj, const bf16_t* Ks, const bf16_t* Vt, bf16_t* Aatt, size_t tq, int hq, int qt, int n, float sink, int fr, int fq) {
    u32x2 gtv[4];
#pragma unroll
    for (int nt = 0; nt < 4; ++nt) gtv[nt] = *(const u32x2*)(proj + tq * INW + OAG + hq * 64 + nt * 16 + fq * 4);
    bf16x8 qf0, qf1;
    { const unsigned a[4] = {Q.x1.x, Q.x1.y, Q.x1.z, Q.x1.w}, c[4] = {Q.x2.x, Q.x2.y, Q.x2.z, Q.x2.w}; unsigned r1[4], r2[4];
#pragma unroll
      for (int i = 0; i < 4; ++i) { const f32x4 cs = Q.rp[i];
          const float a0 = bflo(a[i]) * 0.125f, a1 = bfhi(a[i]) * 0.125f, b0 = bflo(c[i]) * 0.125f, b1 = bfhi(c[i]) * 0.125f;
          r1[i] = cvt_pk_bf16(a0 * cs[0] - b0 * cs[1], a1 * cs[2] - b1 * cs[3]);
          r2[i] = cvt_pk_bf16(b0 * cs[0] + a0 * cs[1], b1 * cs[2] + a1 * cs[3]); }
      qf0 = mk8(r1[0], r1[1], r1[2], r1[3]); qf1 = mk8(r2[0], r2[1], r2[2], r2[3]); }
    f32x4 s[9];
#pragma unroll
    for (int k9 = 0; k9 < 9; ++k9) {
        const bf16_t* kr = Ks + ((qt + k9) * 16 + fr) * KS_STRIDE + fq * 8;
        const bf16x8 a0 = *(const bf16x8*)kr, a1 = *(const bf16x8*)(kr + 32);
        f32x4 z = {0.f, 0.f, 0.f, 0.f};
        z = __builtin_amdgcn_mfma_f32_16x16x32_bf16(a0, qf0, z, 0, 0, 0);
        s[k9] = __builtin_amdgcn_mfma_f32_16x16x32_bf16(a1, qf1, z, 0, 0, 0);
    }
    const int d0 = fq * 4 - fr;
    float mx = sink;
#pragma unroll
    for (int k9 = 0; k9 < 9; ++k9) { const bool tile_ok = (n > 0) || (qt + k9 >= 8);
#pragma unroll
        for (int j = 0; j < 4; ++j) { bool vis = tile_ok;
            if (k9 == 0) vis = vis && (d0 + j > 0);
            if (k9 == 8) vis = vis && (d0 + j <= 0);
            s[k9][j] = vis ? s[k9][j] : -INFINITY; mx = fmaxf(mx, s[k9][j]); } }
    mx = fmaxf(mx, __shfl_xor(mx, 16)); mx = fmaxf(mx, __shfl_xor(mx, 32));
    float l = 0.f;
#pragma unroll
    for (int k9 = 0; k9 < 9; ++k9)
#pragma unroll
        for (int j = 0; j < 4; ++j) { const float e = __expf(s[k9][j] - mx); s[k9][j] = e; l += e; }
    l += __shfl_xor(l, 16); l += __shfl_xor(l, 32);
    l += __expf(sink - mx);
    const float inv_l = fast_rcp(l);
    bf16x8 pf[5];
#pragma unroll
    for (int pp = 0; pp < 4; ++pp) pf[pp] = mk8(cvt_pk_bf16(s[2 * pp][0], s[2 * pp][1]), cvt_pk_bf16(s[2 * pp][2], s[2 * pp][3]), cvt_pk_bf16(s[2 * pp + 1][0], s[2 * pp + 1][1]), cvt_pk_bf16(s[2 * pp + 1][2], s[2 * pp + 1][3]));
    pf[4] = mk8(cvt_pk_bf16(s[8][0], s[8][1]), cvt_pk_bf16(s[8][2], s[8][3]), 0u, 0u);
#pragma unroll
    for (int nt = 0; nt < 4; ++nt) { f32x4 o = {0.f, 0.f, 0.f, 0.f};
        const bf16_t* vr = Vt + (nt * 16 + fr) * VT_STRIDE + fq * 4;
#pragma unroll
        for (int pp = 0; pp < 5; ++pp) { const int kta = qt + 2 * pp, ktb = (kta + 1 > 15) ? 15 : kta + 1;
            const u32x2 lo = *(const u32x2*)(vr + kta * 16), hi = *(const u32x2*)(vr + ktb * 16);
            o = __builtin_amdgcn_mfma_f32_16x16x32_bf16(mk8(lo.x, lo.y, hi.x, hi.y), pf[pp], o, 0, 0, 0); }
        const u32x2 gt = gtv[nt];
        u32x2 w; w.x = cvt_pk_bf16(o[0] * inv_l * bflo(gt.x), o[1] * inv_l * bfhi(gt.x)); w.y = cvt_pk_bf16(o[2] * inv_l * bflo(gt.y), o[3] * inv_l * bfhi(gt.y));
        *(u32x2*)(Aatt + tq * 1024 + hq * 64 + nt * 16 + fq * 4) = w; }
}
__device__ __forceinline__ void attn_phase(const Params& p, unsigned char* shm, int c, int G) {
    const bf16_t* proj = (const bf16_t*)(p.ws + WS_PROJ);
    const f32x2* rope = (const f32x2*)(p.ws + WS_ROPE);
    bf16_t* Aatt = (bf16_t*)(p.ws + WS_AATT);
    bf16_t* Ks = (bf16_t*)shm;
    bf16_t* Vt = (bf16_t*)(shm + 256 * KS_STRIDE * 2);
    const int tid = threadIdx.x, wid = tid >> 6, lane = tid & 63, fr = lane & 15, fq = lane >> 4;
    const int g = wid >> 1, qb = (wid & 1) * 4;
    if (c >= NAU) return;
    AttnStage S; attn_load_stage(proj, rope, c, tid, S);
#pragma unroll 1
    for (int unit = c; unit < NAU; unit += G) {
        int kvh, n, tq0; attn_unit_coords(unit, kvh, n, tq0);
        const int hq = kvh * 4 + g; const float sink = p.sinks[hq];
        AttnQ Q0, Q1;
        attn_load_q(proj, rope, (size_t)(tq0 + (qb + 0) * 16 + fr), hq, fq, Q0);
        attn_write_stage(S, rope, tq0 - 128, Ks, Vt, tid);
        __syncthreads();
        attn_load_q(proj, rope, (size_t)(tq0 + (qb + 1) * 16 + fr), hq, fq, Q1);
        attn_qtile(Q0, proj, Ks, Vt, Aatt, (size_t)(tq0 + (qb + 0) * 16 + fr), hq, qb + 0, n, sink, fr, fq);
        attn_load_q(proj, rope, (size_t)(tq0 + (qb + 2) * 16 + fr), hq, fq, Q0);
        attn_qtile(Q1, proj, Ks, Vt, Aatt, (size_t)(tq0 + (qb + 1) * 16 + fr), hq, qb + 1, n, sink, fr, fq);
        attn_load_q(proj, rope, (size_t)(tq0 + (qb + 3) * 16 + fr), hq, fq, Q1);
        attn_qtile(Q0, proj, Ks, Vt, Aatt, (size_t)(tq0 + (qb + 2) * 16 + fr), hq, qb + 2, n, sink, fr, fq);
        if (unit + G < NAU) attn_load_stage(proj, rope, unit + G, tid, S);
        attn_qtile(Q1, proj, Ks, Vt, Aatt, (size_t)(tq0 + (qb + 3) * 16 + fr), hq, qb + 3, n, sink, fr, fq);
        __syncthreads();
    }
}

constexpr int H_STRIDE64 = 72;
constexpr int H_STRIDE128 = 136;
constexpr int SCN = 16;
constexpr int NSC = NT / (64 * SCN);
constexpr int NSU = NB * 8 * NSC;
struct HgrnRaw { unsigned hf[16]; unsigned hi[16]; };
__device__ __forceinline__ void hgrn_load_raw(const bf16_t* proj, size_t rc, int h, int d, int seg, HgrnRaw& R) {
    const bf16_t* bp = proj + (rc + seg * 16) * INW + h * 128 + d;
#pragma unroll
    for (int i = 0; i < 16; ++i) { R.hf[i] = bp[(size_t)i * INW + OHF]; R.hi[i] = bp[(size_t)i * INW + OHI]; }
}
__device__ __forceinline__ void hgrn_gates(const HgrnRaw& R, float lb, float (&bp)[16], float (&kk)[16]) {
    float run = 0.f;
#pragma unroll
    for (int i = 0; i < 16; ++i) {
        const float hf = __uint_as_float(R.hf[i] << 16);
        const float e = __expf(-hf), inv = fast_rcp(1.0f + e);
        const float f = lb + (1.0f - lb) * inv;
        kk[i] = (1.0f - lb) * e * inv;
        run += __logf(f); bp[i] = run;
    }
}
__device__ __forceinline__ void hgrn_store_vt(const HgrnRaw& R, bf16_t* Vt, int d, int seg) {
    unsigned w[8];
#pragma unroll
    for (int i = 0; i < 8; ++i) w[i] = R.hi[2 * i] | (R.hi[2 * i + 1] << 16);
    bf16_t* vd = Vt + d * H_STRIDE64 + seg * 16; *(u32x4*)vd = (u32x4){w[0], w[1], w[2], w[3]}; *(u32x4*)(vd + 8) = (u32x4){w[4], w[5], w[6], w[7]};
}

__device__ __forceinline__ void hgrn_local_unit(const Params& p, unsigned char* shm, int u) {
    const bf16_t* proj = (const bf16_t*)(p.ws + WS_PROJ);
    float* UT = p.out + (size_t)u * 16384; float* dtot = (float*)(p.ws + WS_DTOT) + (size_t)u * 128;
    bf16_t* KdT = (bf16_t*)shm;
    bf16_t* Vt = (bf16_t*)(shm + 128 * H_STRIDE64 * 2);
    float* segsum = (float*)(shm + 2 * 128 * H_STRIDE64 * 2);
    float* dsh = segsum + 512;
    const int tid = threadIdx.x, wid = tid >> 6, lane = tid & 63, fr = lane & 15, fq = lane >> 4;
    const int sc = u % NSC, sq = u / NSC, h = sq & 7, b = sq >> 3; const size_t r0 = (size_t)b * NT + (size_t)sc * (64 * SCN);
    const int d = tid & 127, seg = tid >> 7;
    const float lb = fast_rcp(1.0f + __expf(p.lbt[1024 + h * 128 + d] - p.lbt[h * 128 + d]));
    f32x4 acc[8];
#pragma unroll
    for (int vt = 0; vt < 8; ++vt) acc[vt] = (f32x4){0.f, 0.f, 0.f, 0.f};
    float bsum = 0.f;
    HgrnRaw R; hgrn_load_raw(proj, r0, h, d, seg, R);
#pragma unroll 1
    for (int cc = 0; cc < SCN; ++cc) {
        float bp[16], kk[16];
        hgrn_gates(R, lb, bp, kk);
        segsum[seg * 128 + d] = bp[15];
        hgrn_store_vt(R, Vt, d, seg);
        if (cc < SCN - 1) hgrn_load_raw(proj, r0 + (size_t)(cc + 1) * 64, h, d, seg, R);
        __syncthreads();
        float off = 0.f, btot = 0.f;
#pragma unroll
        for (int s2 = 0; s2 < 4; ++s2) { const float v = segsum[s2 * 128 + d]; btot += v; if (s2 < seg) off += v; }
        { unsigned w[8];
#pragma unroll
          for (int i = 0; i < 8; ++i) { const float k0 = kk[2 * i] * __expf(btot - (off + bp[2 * i])), k1 = kk[2 * i + 1] * __expf(btot - (off + bp[2 * i + 1])); w[i] = cvt_pk_bf16(k0, k1); }
          bf16_t* kd = KdT + d * H_STRIDE64 + seg * 16; *(u32x4*)kd = (u32x4){w[0], w[1], w[2], w[3]}; *(u32x4*)(kd + 8) = (u32x4){w[4], w[5], w[6], w[7]}; }
        if (seg == 0) dsh[d] = __expf(btot);
        bsum += btot;
        __syncthreads();
        const f32x4 dv = *(const f32x4*)(dsh + 16 * wid + fq * 4);
#pragma unroll
        for (int vt = 0; vt < 8; ++vt) acc[vt] *= dv;
#pragma unroll
        for (int ks = 0; ks < 2; ++ks) { const bf16x8 a = *(const bf16x8*)(KdT + (16 * wid + fr) * H_STRIDE64 + ks * 32 + fq * 8);
#pragma unroll
            for (int vt = 0; vt < 8; ++vt) { const bf16x8 bv = *(const bf16x8*)(Vt + (16 * vt + fr) * H_STRIDE64 + ks * 32 + fq * 8);
                acc[vt] = __builtin_amdgcn_mfma_f32_16x16x32_bf16(a, bv, acc[vt], 0, 0, 0); } }
        __syncthreads();
    }
#pragma unroll
    for (int vt = 0; vt < 8; ++vt) *(f32x4*)(UT + (size_t)(16 * vt + fr) * 128 + 16 * wid + fq * 4) = acc[vt];
    if (seg == 0) dtot[d] = __expf(bsum);
}

__device__ __forceinline__ void hgrn_scan(const Params& p) {
    const float* dtot = (const float*)(p.ws + WS_DTOT);
    for (int gidx = blockIdx.x * 512 + threadIdx.x; gidx < 16 * 8192; gidx += gridDim.x * 512) {
        const int sq = gidx >> 13, e = (gidx & 8191) * 2, d = e & 127;
        float* base = p.out + (size_t)sq * NSC * 16384 + e; const float* db = dtot + (size_t)sq * NSC * 128 + d;
        f32x2 S = {0.f, 0.f};
        for (int c0 = 0; c0 < NSC; c0 += 8) {
            f32x2 U[8], D[8];
#pragma unroll
            for (int i = 0; i < 8; ++i) { U[i] = *(const f32x2*)(base + (size_t)(c0 + i) * 16384); D[i] = *(const f32x2*)(db + (size_t)(c0 + i) * 128); }
#pragma unroll
            for (int i = 0; i < 8; ++i) { *(f32x2*)(base + (size_t)(c0 + i) * 16384) = S; S = D[i] * S + U[i]; }
        }
    }
}

__device__ __forceinline__ void hgrn_out_unit(const Params& p, unsigned char* shm, int u) {
    const bf16_t* proj = (const bf16_t*)(p.ws + WS_PROJ);
    const float* ST = p.out + (size_t)u * 16384;
    bf16_t* Ahg = (bf16_t*)(p.ws + WS_AHGR);
    bf16_t* Qs = (bf16_t*)shm;
    bf16_t* Ks2 = (bf16_t*)(shm + 17408);
    bf16_t* Vt = (bf16_t*)(shm + 34816);
    bf16_t* KdT = (bf16_t*)(shm + 53248);
    bf16_t* St = (bf16_t*)(shm + 71680);
    float* segsum = (float*)(shm + 106496);
    float* eref = segsum + 512;
    float* dsh = eref + 128;
    float* part = dsh + 128;
    const int tid = threadIdx.x, wid = tid >> 6, lane = tid & 63, fr = lane & 15, fq = lane >> 4;
    const int sc = u % NSC, sq = u / NSC, h = sq & 7, b = sq >> 3; const size_t r0 = (size_t)b * NT + (size_t)sc * (64 * SCN);
    const int d = tid & 127, seg = tid >> 7;
    const int tt = wid & 3, vh = wid >> 2;
    const float lb = fast_rcp(1.0f + __expf(p.lbt[1024 + h * 128 + d] - p.lbt[h * 128 + d]));
    f32x4 acc[8];
#pragma unroll
    for (int vt = 0; vt < 8; ++vt) acc[vt] = *(const f32x4*)(ST + (size_t)(16 * vt + fr) * 128 + 16 * wid + fq * 4);
    f32x4 gn[4];
#pragma unroll
    for (int vt = 0; vt < 4; ++vt) gn[vt] = *(const f32x4*)(p.hgain + h * 128 + 16 * (vh * 4 + vt) + fq * 4);
    HgrnRaw R; hgrn_load_raw(proj, r0, h, d, seg, R);
    unsigned hq[16];
#pragma unroll
    for (int i = 0; i < 16; ++i) hq[i] = proj[(r0 + seg * 16 + i) * INW + OHQ + h * 128 + d];
#pragma unroll 1
    for (int cc = 0; cc < SCN; ++cc) {
        const size_t rc = r0 + (size_t)cc * 64;
        float bp[16], kk[16];
        hgrn_gates(R, lb, bp, kk);
        segsum[seg * 128 + d] = bp[15];
        hgrn_store_vt(R, Vt, d, seg);
        __syncthreads();
        float off = 0.f, btot = 0.f;
#pragma unroll
        for (int s2 = 0; s2 < 4; ++s2) { const float v = segsum[s2 * 128 + d]; btot += v; if (s2 < seg) off += v; }
        const float bref = segsum[d] + segsum[128 + d];
        if (seg == 0) { eref[d] = __expf(bref); dsh[d] = __expf(btot); }
        { unsigned w[8];
#pragma unroll
          for (int i = 0; i < 8; ++i) { const float k0 = kk[2 * i] * __expf(btot - (off + bp[2 * i])), k1 = kk[2 * i + 1] * __expf(btot - (off + bp[2 * i + 1])); w[i] = cvt_pk_bf16(k0, k1); }
          bf16_t* kd = KdT + d * H_STRIDE64 + seg * 16; *(u32x4*)kd = (u32x4){w[0], w[1], w[2], w[3]}; *(u32x4*)(kd + 8) = (u32x4){w[4], w[5], w[6], w[7]}; }
#pragma unroll
        for (int i = 0; i < 16; ++i) { const float bb = off + bp[i] - bref; const int t = seg * 16 + i;
            const float qv = __uint_as_float(hq[i] << 16);
            const unsigned qk = cvt_pk_bf16(qv * __expf(bb), kk[i] * __expf(-bb));
            Qs[t * H_STRIDE128 + d] = (bf16_t)(qk & 0xffffu); Ks2[t * H_STRIDE128 + d] = (bf16_t)(qk >> 16); }
        if (cc < SCN - 1) { hgrn_load_raw(proj, rc + 64, h, d, seg, R);
#pragma unroll
            for (int i = 0; i < 16; ++i) hq[i] = proj[(rc + 64 + seg * 16 + i) * INW + OHQ + h * 128 + d]; }
        const size_t r = rc + 16 * tt + fr;
        u32x2 gt[4];
#pragma unroll
        for (int vt = 0; vt < 4; ++vt) gt[vt] = *(const u32x2*)(proj + r * INW + OHG + h * 128 + 16 * (vh * 4 + vt) + fq * 4);
        __syncthreads();
        { const f32x4 er = *(const f32x4*)(eref + 16 * wid + fq * 4);
#pragma unroll
          for (int vt = 0; vt < 8; ++vt) { const f32x4 sv = acc[vt] * er; u32x2 w; w.x = cvt_pk_bf16(sv[0], sv[1]); w.y = cvt_pk_bf16(sv[2], sv[3]);
              *(u32x2*)(St + (16 * vt + fr) * H_STRIDE128 + 16 * wid + fq * 4) = w; } }
        __syncthreads();
        bf16x8 bq[4];
#pragma unroll
        for (int ks = 0; ks < 4; ++ks) bq[ks] = *(const bf16x8*)(Qs + (16 * tt + fr) * H_STRIDE128 + ks * 32 + fq * 8);
        f32x4 pa[4];
#pragma unroll
        for (int st = 0; st < 4; ++st) { pa[st] = (f32x4){0.f, 0.f, 0.f, 0.f};
            if (st <= tt) {
#pragma unroll
                for (int ks = 0; ks < 4; ++ks) { const bf16x8 a = *(const bf16x8*)(Ks2 + (16 * st + fr) * H_STRIDE128 + ks * 32 + fq * 8);
                    pa[st] = __builtin_amdgcn_mfma_f32_16x16x32_bf16(a, bq[ks], pa[st], 0, 0, 0); }
#pragma unroll
                for (int j = 0; j < 4; ++j) { const int s_ = 16 * st + fq * 4 + j, t_ = 16 * tt + fr; pa[st][j] = (s_ <= t_) ? pa[st][j] : 0.f; }
            } }
        bf16x8 pf[2];
#pragma unroll
        for (int pp = 0; pp < 2; ++pp) pf[pp] = mk8(cvt_pk_bf16(pa[2 * pp][0], pa[2 * pp][1]), cvt_pk_bf16(pa[2 * pp][2], pa[2 * pp][3]), cvt_pk_bf16(pa[2 * pp + 1][0], pa[2 * pp + 1][1]), cvt_pk_bf16(pa[2 * pp + 1][2], pa[2 * pp + 1][3]));
        f32x4 o[4]; float ss = 0.f;
#pragma unroll
        for (int vt = 0; vt < 4; ++vt) { const int vrow = 16 * (vh * 4 + vt) + fr; o[vt] = (f32x4){0.f, 0.f, 0.f, 0.f};
#pragma unroll
            for (int pp = 0; pp < 2; ++pp) { const u32x2 lo = *(const u32x2*)(Vt + vrow * H_STRIDE64 + (2 * pp) * 16 + fq * 4), hi = *(const u32x2*)(Vt + vrow * H_STRIDE64 + (2 * pp + 1) * 16 + fq * 4);
                o[vt] = __builtin_amdgcn_mfma_f32_16x16x32_bf16(mk8(lo.x, lo.y, hi.x, hi.y), pf[pp], o[vt], 0, 0, 0); }
#pragma unroll
            for (int ks = 0; ks < 4; ++ks) { const bf16x8 a = *(const bf16x8*)(St + vrow * H_STRIDE128 + ks * 32 + fq * 8);
                o[vt] = __builtin_amdgcn_mfma_f32_16x16x32_bf16(a, bq[ks], o[vt], 0, 0, 0); }
            ss += o[vt][0] * o[vt][0] + o[vt][1] * o[vt][1] + o[vt][2] * o[vt][2] + o[vt][3] * o[vt][3]; }
        ss += __shfl_xor(ss, 16); ss += __shfl_xor(ss, 32);
        if (fq == 0) part[vh * 64 + 16 * tt + fr] = ss;
        if (cc < SCN - 1) {
            const f32x4 dv = *(const f32x4*)(dsh + 16 * wid + fq * 4);
#pragma unroll
            for (int vt = 0; vt < 8; ++vt) acc[vt] *= dv;
#pragma unroll
            for (int ks = 0; ks < 2; ++ks) { const bf16x8 a = *(const bf16x8*)(KdT + (16 * wid + fr) * H_STRIDE64 + ks * 32 + fq * 8);
#pragma unroll
                for (int vt = 0; vt < 8; ++vt) { const bf16x8 bv = *(const bf16x8*)(Vt + (16 * vt + fr) * H_STRIDE64 + ks * 32 + fq * 8);
                    acc[vt] = __builtin_amdgcn_mfma_f32_16x16x32_bf16(a, bv, acc[vt], 0, 0, 0); } }
        }
        __syncthreads();
        const float tot = part[16 * tt + fr] + part[64 + 16 * tt + fr];
        const float rstd = rsqrtf(tot * (1.0f / 128.0f) + 1e-6f);
#pragma unroll
        for (int vt = 0; vt < 4; ++vt) { const int col = h * 128 + 16 * (vh * 4 + vt) + fq * 4;
            u32x2 w; w.x = cvt_pk_bf16(o[vt][0] * rstd * gn[vt][0] * bflo(gt[vt].x), o[vt][1] * rstd * gn[vt][1] * bfhi(gt[vt].x)); w.y = cvt_pk_bf16(o[vt][2] * rstd * gn[vt][2] * bflo(gt[vt].y), o[vt][3] * rstd * gn[vt][3] * bfhi(gt[vt].y));
            *(u32x2*)(Ahg + r * 1024 + col) = w; }
    }
}

__device__ __forceinline__ void phase_final(const Params& p) {
    const int tid = threadIdx.x, wid = tid >> 6, lane = tid & 63;
    const bf16_t* yb = (const bf16_t*)(p.ws + WS_AATT);
    for (int r = blockIdx.x * 8 + wid; r < NTOK; r += gridDim.x * 8) {
        const float* xr = p.x + (size_t)r * DM;
        f32x4 v[8]; float ss = 0.f;
#pragma unroll
        for (int i = 0; i < 4; ++i) { const int c0 = (lane + 64 * i) * 8;
            const u32x4 yv = __builtin_nontemporal_load((const u32x4*)(yb + (size_t)r * DM + c0));
            const f32x4 x0 = __builtin_nontemporal_load((const f32x4*)(xr + c0)), x1 = __builtin_nontemporal_load((const f32x4*)(xr + c0 + 4));
            f32x4 a, b; a[0] = x0[0] + bflo(yv.x); a[1] = x0[1] + bfhi(yv.x); a[2] = x0[2] + bflo(yv.y); a[3] = x0[3] + bfhi(yv.y);
            b[0] = x1[0] + bflo(yv.z); b[1] = x1[1] + bfhi(yv.z); b[2] = x1[2] + bflo(yv.w); b[3] = x1[3] + bfhi(yv.w);
            ss += a[0] * a[0] + a[1] * a[1] + a[2] * a[2] + a[3] * a[3] + b[0] * b[0] + b[1] * b[1] + b[2] * b[2] + b[3] * b[3];
            v[2 * i] = a; v[2 * i + 1] = b; }
        ss = wave_sum(ss);
        const float rstd = rsqrtf(ss * (1.0f / DM) + 1e-6f);
        float* orow = p.out + (size_t)r * DM;
#pragma unroll
        for (int i = 0; i < 4; ++i) { const int c0 = (lane + 64 * i) * 8;
            const f32x4 g0 = *(const f32x4*)(p.fgain + c0), g1 = *(const f32x4*)(p.fgain + c0 + 4);
            f32x4 a = v[2 * i], b = v[2 * i + 1];
            a[0] = a[0] * rstd * g0[0]; a[1] = a[1] * rstd * g0[1]; a[2] = a[2] * rstd * g0[2]; a[3] = a[3] * rstd * g0[3];
            b[0] = b[0] * rstd * g1[0]; b[1] = b[1] * rstd * g1[1]; b[2] = b[2] * rstd * g1[2]; b[3] = b[3] * rstd * g1[3];
            __builtin_nontemporal_store(a, (f32x4*)(orow + c0)); __builtin_nontemporal_store(b, (f32x4*)(orow + c0 + 4)); }
    }
}

#define XB_TMO      128
#define XB_XCNT(j)  (256  + 64 * (j))
#define XB_XSUB(j)  (1280 + 64 * (j))
#define XB_XGEN(j)  (2304 + 64 * (j))
#define XB_TOP      3328
#define XB_TOPGEN   3392
#define XCD_BAR_WORDS 3456
#define XB_SPIN_CAP (1u << 18)
__device__ __forceinline__ unsigned xb_ld(unsigned* p)              { return __hip_atomic_load(p, __ATOMIC_RELAXED, __HIP_MEMORY_SCOPE_AGENT); }
__device__ __forceinline__ unsigned xb_add(unsigned* p, unsigned v) { return __hip_atomic_fetch_add(p, v, __ATOMIC_RELAXED, __HIP_MEMORY_SCOPE_AGENT); }
__device__ __forceinline__ unsigned xb_xcc_id() { return (unsigned)__builtin_amdgcn_s_getreg((3 << 11) | 20) & 0xFu; }
#define XB_SPIN(cond, bar) do { unsigned _sp = 0; while (cond) { __builtin_amdgcn_s_sleep(1); \
    if ((++_sp & 255u) == 0u) { if (xb_ld(&(bar)[XB_TMO])) break; if (_sp > XB_SPIN_CAP) { atomicAdd(&(bar)[XB_TMO], 1u); break; } } } } while (0)
struct XcdBarrier { unsigned* bar; unsigned x; volatile LAS unsigned* st; };
__device__ __forceinline__ XcdBarrier xcd_barrier_post(unsigned* bar, volatile LAS unsigned* st) {
    XcdBarrier b; b.bar = bar; b.x = xb_xcc_id(); b.st = st;
    if (threadIdx.x == 0) (void)xb_add(&bar[XB_XCNT(b.x)], 1u);
    return b;
}
__device__ __forceinline__ void xcd_barrier_complete(unsigned* bar, unsigned x, unsigned& nloc, unsigned& nx) {
    const unsigned G = gridDim.x * gridDim.y * gridDim.z;
    unsigned sum, cnt, mine, sp = 0u;
    for (;;) {
        sum = 0u; cnt = 0u; mine = 0u;
#pragma unroll
        for (unsigned j = 0; j < 16; ++j) { const unsigned c = xb_ld(&bar[XB_XCNT(j)]); sum += c; cnt += (c > 0u) ? 1u : 0u; mine = (j == x) ? c : mine; }
        if (sum == G) break;
        __builtin_amdgcn_s_sleep(1);
        if ((++sp & 255u) == 0u) { if (xb_ld(&bar[XB_TMO])) break; if (sp > XB_SPIN_CAP) { atomicAdd(&bar[XB_TMO], 1u); break; } }
    }
    nloc = mine > 0u ? mine : 1u; nx = cnt > 0u ? cnt : 1u;
}
__device__ __forceinline__ void xcd_barrier(const XcdBarrier& b) {
    asm volatile("s_waitcnt vmcnt(0)" ::: "memory");
    __syncthreads();
    if (threadIdx.x == 0) {
        unsigned* bar = b.bar;
        __builtin_amdgcn_s_waitcnt(0);
        unsigned nloc = b.st[0], nx = b.st[1];
        if (nloc == 0u) { xcd_barrier_complete(bar, b.x, nloc, nx); b.st[0] = nloc; b.st[1] = nx; }
        const unsigned old = xb_add(&bar[XB_XSUB(b.x)], 1u);
        const unsigned gen = old / nloc;
        if (old + 1u == (gen + 1u) * nloc) {
            __builtin_amdgcn_fence(__ATOMIC_RELEASE, "agent");
            asm volatile("s_waitcnt vmcnt(0)" ::: "memory");
            const unsigned og = xb_add(&bar[XB_TOP], 1u);
            const unsigned tg = og / nx;
            if (og + 1u == (tg + 1u) * nx) xb_add(&bar[XB_TOPGEN], 1u);
            else XB_SPIN(xb_ld(&bar[XB_TOPGEN]) == tg, bar);
            __builtin_amdgcn_fence(__ATOMIC_ACQUIRE, "agent");
            xb_add(&bar[XB_XGEN(b.x)], 1u);
            asm volatile("s_waitcnt vmcnt(0)" ::: "memory");
        } else {
            XB_SPIN(xb_ld(&bar[XB_XGEN(b.x)]) == gen, bar);
            __builtin_amdgcn_fence(__ATOMIC_ACQUIRE, "agent");
            asm volatile("s_waitcnt vmcnt(0)" ::: "memory");
        }
    }
    __syncthreads();
}

__device__ __forceinline__ void stagger_us(int us) {
    if (us <= 0) return;
    const unsigned long long t0 = __builtin_amdgcn_s_memrealtime();
    while (__builtin_amdgcn_s_memrealtime() - t0 < (unsigned long long)us * 100ull) __builtin_amdgcn_s_sleep(8);
}
#define STAG1 0
#define STAG5 0
#define STAG6 0
#define REP0 1
#define REPS 0
#define REP1 1
#define REP2 1
#define REPA 1
#define REP4 1
#define REP5 1
#define REP6 1
__global__ void __launch_bounds__(512, 2) fwd_megakernel(Params p) {
    extern __shared__ __attribute__((aligned(16))) unsigned char shm[];
    cg::grid_group grid = cg::this_grid();
    const int G = (int)gridDim.x, c = (int)blockIdx.x;
    volatile LAS unsigned* xst = (volatile LAS unsigned*)((LAS unsigned char*)shm + pg8::STAGE_BYTES);
    if (threadIdx.x == 0) { xst[0] = 0u; xst[1] = 0u; xst[2] = 0u; xst[3] = 0u; }
    __syncthreads();
    const XcdBarrier xb = xcd_barrier_post((unsigned*)(p.ws + WS_BAR), xst);
    for (int rep = 0; rep < REP0; ++rep) phase_prep(p, shm);
    if (p.ws == nullptr) grid.sync();
    xcd_barrier(xb);
    for (int rep = 0; rep < REPS; ++rep) xcd_barrier(xb);
    { pg8::Gemm g; g.A0 = (const bf16_t*)(p.ws + WS_HA); g.B0 = (const bf16_t*)(p.ws + WS_WIN); g.A1 = g.A0; g.B1 = g.B0; g.M = NTOK; g.N = INW; g.K = DM;
      stagger_us(((c >> 3) & 3) * STAG1);
      pg8::StaticOrder S; S.init(NTOK, INW, G, c, 0, REP1); EpiProj E; E.O = (bf16_t*)(p.ws + WS_PROJ);
      pg8::gemm_phase<EpiProj>((LAS unsigned char*)shm, g, S, E); }
    xcd_barrier(xb);
    const bool attn_first = ((c >> 3) & 1) == 0;
    if (attn_first) attn_phase(p, shm, c, G);
    for (int u = c; u < NSU; u += G) hgrn_local_unit(p, shm, u);
    if (!attn_first) attn_phase(p, shm, c, G);
    xcd_barrier(xb);
    hgrn_scan(p);
    xcd_barrier(xb);
    for (int rep = 0; rep < REP4; ++rep) for (int u = c; u < NSU; u += G) hgrn_out_unit(p, shm, u);
    xcd_barrier(xb);
    { pg8::Gemm g; g.A0 = (const bf16_t*)(p.ws + WS_AATT); g.B0 = (const bf16_t*)(p.ws + WS_WAO); g.A1 = (const bf16_t*)(p.ws + WS_AHGR); g.B1 = (const bf16_t*)(p.ws + WS_WHO); g.M = NTOK; g.N = DM; g.K = 1024;
      stagger_us(((c >> 3) & 3) * STAG5);
      pg8::StaticOrder S; S.init(NTOK, DM, G, c, 1, REP5); EpiMerge E; E.proj = (const bf16_t*)(p.ws + WS_PROJ); E.O = (bf16_t*)(p.ws + WS_HA);
      pg8::gemm_phase<EpiMerge>((LAS unsigned char*)shm, g, S, E); }
    xcd_barrier(xb);
    { pg8::Gemm g; g.A0 = (const bf16_t*)(p.ws + WS_HA); g.B0 = (const bf16_t*)(p.ws + WS_WO); g.A1 = g.A0; g.B1 = g.B0; g.M = NTOK; g.N = DM; g.K = DM;
      stagger_us(((c >> 3) & 3) * STAG6);
      pg8::StaticOrder S; S.init(NTOK, DM, G, c, 0, REP6); EpiY E; E.O = (bf16_t*)(p.ws + WS_AATT);
      pg8::gemm_phase<EpiY>((LAS unsigned char*)shm, g, S, E); }
    xcd_barrier(xb);
    phase_final(p);
}

extern "C" void kernel_launch(void* const* d_in, const int* in_sizes, int n_in, void* d_out, int out_size, void* d_ws, size_t ws_size, hipStream_t stream) {
    constexpr size_t kDynLds = pg8::STAGE_BYTES + 16;
    static int grid_blocks = 0;
    if (grid_blocks == 0) {
        if (ws_size < WS_END) { fprintf(stderr, "kernel_launch: workspace too small: %zu < %zu\n", ws_size, (size_t)WS_END); grid_blocks = -1; return; }
        int dev = 0, cus = 0, per_cu = 0;
        (void)hipGetDevice(&dev);
        (void)hipDeviceGetAttribute(&cus, hipDeviceAttributeMultiprocessorCount, dev);
        if (hipFuncSetAttribute((const void*)fwd_megakernel, hipFuncAttributeMaxDynamicSharedMemorySize, (int)kDynLds) != hipSuccess) { fprintf(stderr, "kernel_launch: hipFuncSetAttribute failed\n"); grid_blocks = -1; return; }
        if (hipOccupancyMaxActiveBlocksPerMultiprocessor(&per_cu, (const void*)fwd_megakernel, 512, kDynLds) != hipSuccess || per_cu < 1) { fprintf(stderr, "kernel_launch: occupancy query failed (%d)\n", per_cu); (void)hipGetLastError(); grid_blocks = -1; return; }
        if (per_cu > 1) per_cu = 1;
        grid_blocks = cus * per_cu;
    }
    if (grid_blocks < 0) return;
    Params p{};
    p.x = (const float*)d_in[0]; p.pos = (const int*)d_in[1]; p.norm_gain = (const float*)d_in[2]; p.w_in = (const float*)d_in[3]; p.sinks = (const float*)d_in[4];
    p.lbt = (const float*)d_in[5]; p.hgain = (const float*)d_in[6]; p.w_ao = (const float*)d_in[7]; p.w_ho = (const float*)d_in[8]; p.w_o = (const float*)d_in[9];
    p.fgain = (const float*)d_in[10]; p.out = (float*)d_out; p.ws = (unsigned char*)d_ws;
    if (hipMemsetAsync((unsigned char*)d_ws + WS_BAR, 0, XCD_BAR_WORDS * 4, stream) != hipSuccess) { fprintf(stderr, "kernel_launch: memset of the barrier words failed\n"); return; }
    void* args[] = {&p};
    hipError_t e = hipLaunchCooperativeKernel((const void*)fwd_megakernel, dim3(grid_blocks), dim3(512), args, kDynLds, stream);
    if (e != hipSuccess) fprintf(stderr, "cooperative launch failed: %s (grid %d)\n", hipGetErrorString(e), grid_blocks);
}
```

```cpp
#include <hip/hip_runtime.h>
#include <hip/hip_cooperative_groups.h>
#include <cstdio>
namespace cg = cooperative_groups;

#define LAS __attribute__((address_space(3)))
typedef unsigned short bf16_t;
typedef short bf16x8 __attribute__((ext_vector_type(8)));
typedef float f32x4 __attribute__((ext_vector_type(4)));
typedef float f32x2 __attribute__((ext_vector_type(2)));
typedef unsigned u32x4 __attribute__((ext_vector_type(4)));
typedef unsigned u32x2 __attribute__((ext_vector_type(2)));

constexpr int NB = 2, NT = 16384, NTOK = NB * NT, DM = 2048, INW = 10752;
constexpr int OQ = 0, OKK = 1024, OV = 1280, OAG = 1536, OHQ = 2560, OHF = 3584, OHI = 4608, OHG = 5632, OMA = 6656, OMH = 8704;
constexpr int NCHUNK = NT / 64;
constexpr int NHU = NB * 8 * NCHUNK;
constexpr int NAU = NB * (NT / 128) * 4;

constexpr size_t WS_HA = 0;
constexpr size_t WS_WIN = WS_HA + (size_t)NTOK * DM * 2;
constexpr size_t WS_WAO = WS_WIN + (size_t)INW * DM * 2;
constexpr size_t WS_WHO = WS_WAO + (size_t)DM * 1024 * 2;
constexpr size_t WS_WO = WS_WHO + (size_t)DM * 1024 * 2;
constexpr size_t WS_PROJ = WS_WO + (size_t)DM * DM * 2;
constexpr size_t WS_ROPE = WS_PROJ + (size_t)NTOK * INW * 2;
constexpr size_t WS_AATT = WS_ROPE + (size_t)NTOK * 32 * 8;
constexpr size_t WS_AHGR = WS_AATT + (size_t)NTOK * 1024 * 2;
constexpr size_t WS_DTOT = WS_AHGR + (size_t)NTOK * 1024 * 2;
constexpr size_t WS_RSS = WS_DTOT + (size_t)NHU * 128 * 4;
constexpr size_t WS_END = WS_RSS + (size_t)NTOK * 32 * 4;
constexpr size_t WS_BAR = WS_RSS;

struct Params {
    const float* x; const int* pos; const float* norm_gain; const float* w_in; const float* sinks; const float* lbt;
    const float* hgain; const float* w_ao; const float* w_ho; const float* w_o; const float* fgain;
    float* out; unsigned char* ws;
};

__constant__ float c_inv_freq[32] = {
    1.0f, 0.749894261f, 0.562341332f, 0.421696514f, 0.316227764f, 0.237137377f, 0.177827939f, 0.133352131f, 0.100000001f, 0.0749894157f,
    0.0562341325f, 0.0421696529f, 0.0316227749f, 0.0237137377f, 0.0177827943f, 0.0133352149f, 0.00999999978f, 0.00749894185f,
    0.00562341325f, 0.00421696482f, 0.00316227763f, 0.00237137359f, 0.00177827943f, 0.00133352145f, 0.00100000005f, 0.000749894243f,
    0.000562341302f, 0.000421696517f, 0.000316227757f, 0.00023713737f, 0.00017782794f, 0.00013335215f};

__device__ __forceinline__ float bf2f(bf16_t b) { return __uint_as_float(((unsigned)b) << 16); }
__device__ __forceinline__ float bflo(unsigned w) { return __uint_as_float(w << 16); }
__device__ __forceinline__ float bfhi(unsigned w) { return __uint_as_float(w & 0xffff0000u); }
__device__ __forceinline__ unsigned cvt_pk_bf16(float lo, float hi) { unsigned r; asm volatile("v_cvt_pk_bf16_f32 %0, %1, %2" : "=v"(r) : "v"(lo), "v"(hi)); return r; }
__device__ __forceinline__ float fast_rcp(float x) { return __builtin_amdgcn_rcpf(x); }
__device__ __forceinline__ float sigmoidf_(float v) { return fast_rcp(1.0f + __expf(-v)); }
__device__ __forceinline__ float wave_sum(float v) {
#pragma unroll
    for (int o = 32; o > 0; o >>= 1) v += __shfl_xor(v, o);
    return v;
}
__device__ __forceinline__ bf16x8 mk8(unsigned a, unsigned b, unsigned c, unsigned d) { u32x4 w; w.x = a; w.y = b; w.z = c; w.w = d; return __builtin_bit_cast(bf16x8, w); }

namespace pg8 {
constexpr int BM = 256, BK = 64, HALF = 128, HTB = HALF * BK * 2, STAGE_BYTES = 8 * HTB, NXCD = 8, WGM = 8;
__host__ __device__ __forceinline__ int lds_byte(int r, int c) { const int st = (r >> 4) * 2 + (c >> 5), rr = r & 15, cc = c & 31, ob = rr * 64 + cc * 2; return st * 1024 + (ob ^ (((ob >> 9) & 1) << 5)); }
__host__ __device__ __forceinline__ void stage_rc(int b, int& R, int& C) { const int st = b / 1024, sb = b % 1024, swz = sb ^ (((sb >> 9) & 1) << 5); R = (st >> 1) * 16 + swz / 64; C = (st & 1) * 32 + (swz % 64) / 2; }
__host__ __device__ __forceinline__ int perm32(int rho) { const int n = rho >> 4, i = rho & 15; return 8 * (i >> 2) + 4 * n + (i & 3); }

struct Unit { int pm, pn, kind, rep; };
struct Gemm { const bf16_t* A0; const bf16_t* B0; const bf16_t* A1; const bf16_t* B1; int M, N, K; };

struct StaticOrder {
    int nM, nN, nwg, G, c, dual, R, reps;
    __device__ void init(int M, int N, int G_, int c_, int dual_, int reps_ = 1) { nM = M / BM; nN = N / BM; nwg = nM * nN; G = G_; c = c_; dual = dual_; R = (nwg + G - 1) / G; reps = reps_; }
    __device__ bool next(int i, Unit& u) const {
        if (i >= reps * (R << dual)) return false;
        const int it = (i >> dual) % R;
        const long L = (long)it * G + c; if (L >= nwg) return false;
        int wgid = (int)L; { const int q = nwg / NXCD, r = nwg % NXCD, xcd = wgid % NXCD, off = wgid / NXCD; wgid = (xcd < r ? xcd * (q + 1) : r * (q + 1) + (xcd - r) * q) + off; }
        const int nig = WGM * nN, gid = wgid / nig, fm = gid * WGM, gsz = (nM - fm) < WGM ? (nM - fm) : WGM;
        u.pm = fm + ((wgid % nig) % gsz); u.pn = (wgid % nig) / gsz; u.kind = i & dual; u.rep = (i >> dual) / R; return true;
    }
};

template <class Epi>
__device__ __forceinline__ void gemm_phase(LAS unsigned char* lds, const Gemm g, const StaticOrder& S, const Epi& E) {
    const int tid = threadIdx.x, wid = __builtin_amdgcn_readfirstlane(tid >> 6), lane = tid & 63, wr = wid >> 2, wc = wid & 3, fr = lane & 15, fq = lane >> 4;
    const int K = g.K, nt = K / BK;
    unsigned voffA[2], voffB[2];
#pragma unroll
    for (int i = 0; i < 2; ++i) { int R, C; stage_rc(tid * 16 + i * 8192, R, C); const int Rb = Epi::PERM ? ((R & ~31) + perm32(R & 31)) : R;
        voffA[i] = (unsigned)(R * K + C) * 2u; voffB[i] = (unsigned)(Rb * K + C) * 2u; }
    const size_t kstep = (size_t)(BK * 2);
    const size_t hstep = (size_t)HALF * K * 2;
    const size_t tstep = 2 * hstep;
    const unsigned ldsw = (unsigned)wid * 1024u;
    const int aoff = lds_byte(wr * 64 + fr, fq * 8), boff = lds_byte(wc * 32 + fr, fq * 8);
#define PG8_SA(b, h) (((b) * 2 + (h)) * HTB)
#define PG8_SB(b, h) ((4 + (b) * 2 + (h)) * HTB)
#define PG8_STAGE(bufoff, gbase, voff) do { _Pragma("unroll") for (int _i = 0; _i < 2; ++_i) \
        __builtin_amdgcn_global_load_lds((const unsigned*)((const char*)(gbase) + (voff)[_i]), (LAS unsigned*)(lds + (bufoff) + ldsw + _i * 8192), 16, 0, 0); } while (0)
#define PG8_LDA(dst, b, h) do { _Pragma("unroll") for (int m = 0; m < 4; ++m) _Pragma("unroll") for (int k = 0; k < 2; ++k) dst[m][k] = *(const LAS bf16x8*)(lds + PG8_SA(b, h) + aoff + m * 2048 + k * 1024); } while (0)
#define PG8_LDB(dst, b, h) do { _Pragma("unroll") for (int n = 0; n < 2; ++n) _Pragma("unroll") for (int k = 0; k < 2; ++k) dst[n][k] = *(const LAS bf16x8*)(lds + PG8_SB(b, h) + boff + n * 2048 + k * 1024); } while (0)
#define PG8_MMA(ai, bj, At, Bt) do { __builtin_amdgcn_s_setprio(1); _Pragma("unroll") for (int m = 0; m < 4; ++m) _Pragma("unroll") for (int n = 0; n < 2; ++n) _Pragma("unroll") for (int k = 0; k < 2; ++k) \
        acc[ai][bj][m][n] = __builtin_amdgcn_mfma_f32_16x16x32_bf16(Bt[n][k], At[m][k], acc[ai][bj][m][n], 0, 0, 0); __builtin_amdgcn_s_setprio(0); } while (0)
#define PG8_WAIT_V(n) asm volatile("s_waitcnt vmcnt(" #n ")" ::: "memory")
#define PG8_WAIT_L(n) asm volatile("s_waitcnt lgkmcnt(" #n ")" ::: "memory")
#define PG8_BAR __builtin_amdgcn_s_barrier()
#define PG8_SCHED __builtin_amdgcn_sched_barrier(0)
    Unit cur, nxt; int ui = 0;
    if (!S.next(0, cur)) return;
    f32x4 acc[2][2][4][2];
#pragma unroll
    for (int a = 0; a < 2; ++a)
#pragma unroll
        for (int b = 0; b < 2; ++b)
#pragma unroll
            for (int m = 0; m < 4; ++m)
#pragma unroll
                for (int n = 0; n < 2; ++n) acc[a][b][m][n] = (f32x4){0.f, 0.f, 0.f, 0.f};
    bf16x8 At[4][2], B0[2][2], B1[2][2];
    const char* cA = (const char*)(cur.kind ? g.A1 : g.A0) + (size_t)cur.pm * tstep; const char* cB = (const char*)(cur.kind ? g.B1 : g.B0) + (size_t)cur.pn * tstep;
    PG8_STAGE(PG8_SB(0, 0), cB, voffB); PG8_STAGE(PG8_SA(0, 0), cA, voffA); PG8_STAGE(PG8_SB(0, 1), cB + hstep, voffB); PG8_STAGE(PG8_SA(0, 1), cA + hstep, voffA);
    if (wr == 1) PG8_BAR;
    PG8_WAIT_V(4); PG8_BAR;
    PG8_STAGE(PG8_SB(1, 0), cB + kstep, voffB); PG8_STAGE(PG8_SA(1, 0), cA + kstep, voffA); PG8_STAGE(PG8_SB(1, 1), cB + hstep + kstep, voffB);
    PG8_WAIT_V(6); PG8_BAR;
    for (;;) {
        const bool has_next = S.next(ui + 1, nxt);
        const char* nA = has_next ? (const char*)(nxt.kind ? g.A1 : g.A0) + (size_t)nxt.pm * tstep : cA; const char* nB = has_next ? (const char*)(nxt.kind ? g.B1 : g.B0) + (size_t)nxt.pn * tstep : cB;
        for (int t = 0; t < nt; t += 2) {
            const bool last = (t == nt - 2);
            const char* a1 = cA + (size_t)(t + 1) * kstep;
            const char* a2 = last ? nA : cA + (size_t)(t + 2) * kstep; const char* b2 = last ? nB : cB + (size_t)(t + 2) * kstep;
            const char* a3 = a2 + kstep; const char* b3 = b2 + kstep;
            PG8_LDB(B0, 0, 0); PG8_SCHED; PG8_LDA(At, 0, 0); PG8_STAGE(PG8_SA(1, 1), a1 + hstep, voffA);
            PG8_WAIT_L(8); PG8_BAR; PG8_WAIT_L(0); PG8_MMA(0, 0, At, B0); PG8_BAR; PG8_SCHED;
            PG8_LDB(B1, 0, 1); PG8_STAGE(PG8_SB(0, 0), b2, voffB);
            PG8_BAR; PG8_WAIT_L(0); PG8_MMA(0, 1, At, B1); PG8_BAR;
            PG8_LDA(At, 0, 1); PG8_STAGE(PG8_SA(0, 0), a2, voffA);
            PG8_BAR; PG8_WAIT_L(0); PG8_MMA(1, 0, At, B0); PG8_BAR; PG8_SCHED;
            PG8_STAGE(PG8_SB(0, 1), b2 + hstep, voffB);
            PG8_WAIT_V(6); PG8_BAR; PG8_MMA(1, 1, At, B1); PG8_BAR;
            PG8_LDB(B0, 1, 0); PG8_SCHED; PG8_LDA(At, 1, 0); PG8_STAGE(PG8_SA(0, 1), a2 + hstep, voffA);
            PG8_WAIT_L(8); PG8_BAR; PG8_WAIT_L(0); PG8_MMA(0, 0, At, B0); PG8_BAR; PG8_SCHED;
            PG8_LDB(B1, 1, 1); PG8_STAGE(PG8_SB(1, 0), b3, voffB);
            PG8_BAR; PG8_WAIT_L(0); PG8_MMA(0, 1, At, B1); PG8_BAR;
            PG8_LDA(At, 1, 1); PG8_STAGE(PG8_SA(1, 0), a3, voffA);
            PG8_BAR; PG8_WAIT_L(0); PG8_MMA(1, 0, At, B0); PG8_BAR; PG8_SCHED;
            PG8_STAGE(PG8_SB(1, 1), b3 + hstep, voffB);
            PG8_WAIT_V(6); PG8_BAR; PG8_MMA(1, 1, At, B1); PG8_BAR;
        }
        const bool keep = E(acc, cur, wr, wc, fr, fq);
        if (!has_next) break;
        if (!keep) {
#pragma unroll
            for (int a = 0; a < 2; ++a)
#pragma unroll
                for (int b = 0; b < 2; ++b)
#pragma unroll
                    for (int m = 0; m < 4; ++m)
#pragma unroll
                        for (int n = 0; n < 2; ++n) acc[a][b][m][n] = (f32x4){0.f, 0.f, 0.f, 0.f};
        }
        cur = nxt; cA = nA; cB = nB; ++ui;
    }
    PG8_WAIT_V(0);
    if (wr == 0) PG8_BAR;
    PG8_BAR;
#undef PG8_SA
#undef PG8_SB
#undef PG8_STAGE
#undef PG8_LDA
#undef PG8_LDB
#undef PG8_MMA
#undef PG8_WAIT_V
#undef PG8_WAIT_L
#undef PG8_BAR
#undef PG8_SCHED
}
}

#define PROBE_SKIP_EPI 0
struct EpiProj {
    static constexpr bool PERM = true;
    bf16_t* O;
    __device__ __forceinline__ bool operator()(f32x4 (&acc)[2][2][4][2], const pg8::Unit& u, int wr, int wc, int fr, int fq) const {
        if (PROBE_SKIP_EPI && u.rep) return false;
        const int pn = u.pn;
        int mode = 0; float scale = 1.0f;
        if ((pn >= 6 && pn < 10) || (pn >= 22 && pn < 26)) mode = 1;
        else if (pn >= 10 && pn < 14) { mode = 1; scale = 0.08838834764831845f; }
        const int row0 = u.pm * 256 + wr * 64 + fr, col0 = pn * 256 + wc * 32 + 8 * fq;
        if (pn >= 26) {
#pragma unroll
            for (int ai = 0; ai < 2; ++ai)
#pragma unroll
                for (int m = 0; m < 4; ++m) { bf16_t* rowp = O + (size_t)(row0 + ai * 128 + m * 16) * INW + col0;
                    float rr[8], s2[8];
#pragma unroll
                    for (int n = 0; n < 2; ++n)
#pragma unroll
                        for (int j = 0; j < 4; ++j) { const float p1 = 1.0f + fminf(__expf(-acc[ai][0][m][n][j]), 1e15f), p2 = 1.0f + fminf(__expf(-acc[ai][1][m][n][j]), 1e15f);
                            const float inv = fast_rcp(p1 * p2);
                            s2[4 * n + j] = p1 * inv; rr[4 * n + j] = p2 * p2 * inv; }
                    u32x4 w; w.x = cvt_pk_bf16(rr[0], rr[1]); w.y = cvt_pk_bf16(rr[2], rr[3]); w.z = cvt_pk_bf16(rr[4], rr[5]); w.w = cvt_pk_bf16(rr[6], rr[7]);
                    __builtin_nontemporal_store(w, (u32x4*)rowp);
                    w.x = cvt_pk_bf16(s2[0], s2[1]); w.y = cvt_pk_bf16(s2[2], s2[3]); w.z = cvt_pk_bf16(s2[4], s2[5]); w.w = cvt_pk_bf16(s2[6], s2[7]);
                    __builtin_nontemporal_store(w, (u32x4*)(rowp + 128)); }
            return false;
        }
#pragma unroll
        for (int ai = 0; ai < 2; ++ai)
#pragma unroll
            for (int m = 0; m < 4; ++m) { bf16_t* rowp = O + (size_t)(row0 + ai * 128 + m * 16) * INW + col0;
#pragma unroll
                for (int bj = 0; bj < 2; ++bj) { f32x4 v0 = acc[ai][bj][m][0], v1 = acc[ai][bj][m][1];
                    if (mode != 0) {
#pragma unroll
                        for (int j = 0; j < 4; ++j) { v0[j] = v0[j] * sigmoidf_(v0[j]) * scale; v1[j] = v1[j] * sigmoidf_(v1[j]) * scale; }
                    }
                    u32x4 w; w.x = cvt_pk_bf16(v0[0], v0[1]); w.y = cvt_pk_bf16(v0[2], v0[3]); w.z = cvt_pk_bf16(v1[0], v1[1]); w.w = cvt_pk_bf16(v1[2], v1[3]);
                    __builtin_nontemporal_store(w, (u32x4*)(rowp + bj * 128)); } }
        return false;
    }
};
struct EpiMerge {
    static constexpr bool PERM = true;
    const bf16_t* proj; bf16_t* O;
    __device__ __forceinline__ bool operator()(f32x4 (&acc)[2][2][4][2], const pg8::Unit& u, int wr, int wc, int fr, int fq) const {
        const int row0 = u.pm * 256 + wr * 64 + fr, lc = wc * 32 + 8 * fq;
        const int goff = OMA + u.pn * 512 + (u.kind ? 128 : 0) + lc;
        u32x4 Gv[2][4][2];
#pragma unroll
        for (int ai = 0; ai < 2; ++ai)
#pragma unroll
            for (int m = 0; m < 4; ++m)
#pragma unroll
                for (int bj = 0; bj < 2; ++bj) Gv[ai][m][bj] = __builtin_nontemporal_load((const u32x4*)(proj + (size_t)(row0 + ai * 128 + m * 16) * INW + goff + bj * 256));
#pragma unroll
        for (int ai = 0; ai < 2; ++ai)
#pragma unroll
            for (int m = 0; m < 4; ++m)
#pragma unroll
                for (int bj = 0; bj < 2; ++bj) { const u32x4 g = Gv[ai][m][bj];
                    const float gs[8] = {bflo(g.x), bfhi(g.x), bflo(g.y), bfhi(g.y), bflo(g.z), bfhi(g.z), bflo(g.w), bfhi(g.w)};
                    f32x4 v0 = acc[ai][bj][m][0], v1 = acc[ai][bj][m][1];
#pragma unroll
                    for (int j = 0; j < 4; ++j) { v0[j] *= gs[j]; v1[j] *= gs[4 + j]; }
                    if (u.kind == 0) { acc[ai][bj][m][0] = v0; acc[ai][bj][m][1] = v1; }
                    else { u32x4 w; w.x = cvt_pk_bf16(v0[0], v0[1]); w.y = cvt_pk_bf16(v0[2], v0[3]); w.z = cvt_pk_bf16(v1[0], v1[1]); w.w = cvt_pk_bf16(v1[2], v1[3]);
                        *(u32x4*)(O + (size_t)(row0 + ai * 128 + m * 16) * DM + u.pn * 256 + bj * 128 + lc) = w; } }
        return u.kind == 0;
    }
};
struct EpiY {
    static constexpr bool PERM = true;
    bf16_t* O;
    __device__ __forceinline__ bool operator()(f32x4 (&acc)[2][2][4][2], const pg8::Unit& u, int wr, int wc, int fr, int fq) const {
        const int row0 = u.pm * 256 + wr * 64 + fr, col0 = u.pn * 256 + wc * 32 + 8 * fq;
#pragma unroll
        for (int ai = 0; ai < 2; ++ai)
#pragma unroll
            for (int m = 0; m < 4; ++m) { bf16_t* rowp = O + (size_t)(row0 + ai * 128 + m * 16) * DM + col0;
#pragma unroll
                for (int bj = 0; bj < 2; ++bj) { const f32x4 v0 = acc[ai][bj][m][0], v1 = acc[ai][bj][m][1];
                    u32x4 w; w.x = cvt_pk_bf16(v0[0], v0[1]); w.y = cvt_pk_bf16(v0[2], v0[3]); w.z = cvt_pk_bf16(v1[0], v1[1]); w.w = cvt_pk_bf16(v1[2], v1[3]);
                    __builtin_nontemporal_store(w, (u32x4*)(rowp + bj * 128)); } }
        return false;
    }
};

template <bool GATE_MAP>
__device__ __forceinline__ void transpose_tile_wave(const float* __restrict__ W, int K, int N, bf16_t* __restrict__ WT, int tile, int lane) {
    const int ntn = N >> 6; const int k0 = (tile / ntn) * 64, n0 = (tile % ntn) * 64;
    const float* src = W + (size_t)k0 * N + n0 + lane;
    float v[64];
#pragma unroll
    for (int i = 0; i < 64; ++i) v[i] = src[(size_t)i * N];
    int nrow = n0;
    if (GATE_MAP && n0 >= OMA) { const int hg = (n0 >= OMH) ? 1 : 0, ch = n0 - (hg ? OMH : OMA); nrow = OMA + (ch >> 7) * 256 + hg * 128 + (ch & 127); }
    bf16_t* dst = WT + (size_t)(nrow + lane) * K + k0;
#pragma unroll
    for (int i = 0; i < 8; ++i) { u32x4 w; w.x = cvt_pk_bf16(v[8 * i], v[8 * i + 1]); w.y = cvt_pk_bf16(v[8 * i + 2], v[8 * i + 3]); w.z = cvt_pk_bf16(v[8 * i + 4], v[8 * i + 5]); w.w = cvt_pk_bf16(v[8 * i + 6], v[8 * i + 7]);
        *(u32x4*)(dst + 8 * i) = w; }
}

__device__ __forceinline__ void phase_prep(const Params& p, unsigned char* shm) {
    const int tid = threadIdx.x, wid = tid >> 6, lane = tid & 63;
    bf16_t* hA = (bf16_t*)(p.ws + WS_HA);
    for (int r = blockIdx.x * 8 + wid; r < NTOK; r += gridDim.x * 8) {
        const f32x4* xr = (const f32x4*)(p.x + (size_t)r * DM);
        f32x4 v[8]; float ss = 0.f;
#pragma unroll
        for (int i = 0; i < 8; ++i) { v[i] = xr[lane + 64 * i]; ss += v[i][0] * v[i][0] + v[i][1] * v[i][1] + v[i][2] * v[i][2] + v[i][3] * v[i][3]; }
        ss = wave_sum(ss);
        const float rstd = rsqrtf(ss * (1.0f / DM) + 1e-6f);
#pragma unroll
        for (int i = 0; i < 8; ++i) { const f32x4 g = ((const f32x4*)p.norm_gain)[lane + 64 * i];
            u32x2 w; w.x = cvt_pk_bf16(v[i][0] * rstd * g[0], v[i][1] * rstd * g[1]); w.y = cvt_pk_bf16(v[i][2] * rstd * g[2], v[i][3] * rstd * g[3]);
            *(u32x2*)(hA + (size_t)r * DM + (lane + 64 * i) * 4) = w; }
    }
    constexpr int T_IN = (DM / 64) * (INW / 64), T_AO = (1024 / 64) * (DM / 64), T_WO = (DM / 64) * (DM / 64);
    for (int t = blockIdx.x * 8 + wid; t < T_IN + 2 * T_AO + T_WO; t += gridDim.x * 8) {
        if (t < T_IN) transpose_tile_wave<true>(p.w_in, DM, INW, (bf16_t*)(p.ws + WS_WIN), t, lane);
        else if (t < T_IN + T_AO) transpose_tile_wave<false>(p.w_ao, 1024, DM, (bf16_t*)(p.ws + WS_WAO), t - T_IN, lane);
        else if (t < T_IN + 2 * T_AO) transpose_tile_wave<false>(p.w_ho, 1024, DM, (bf16_t*)(p.ws + WS_WHO), t - T_IN - T_AO, lane);
        else transpose_tile_wave<false>(p.w_o, DM, DM, (bf16_t*)(p.ws + WS_WO), t - T_IN - 2 * T_AO, lane);
    }
    f32x2* rope = (f32x2*)(p.ws + WS_ROPE);
    for (int idx = blockIdx.x * 512 + tid; idx < NTOK * 32; idx += gridDim.x * 512) {
        const int tok = idx >> 5, i = idx & 31;
        const float ang = (float)p.pos[tok] * c_inv_freq[i];
        const double a = (double)ang; const double kq = rint(a * 0.63661977236758134308);
        const double r = fma(-kq, 1.5707963267948966192, a) - kq * 6.123233995736766e-17;
        const double r2 = r * r;
        double sn = r2 * (-1.0 / 39916800.0) + (1.0 / 362880.0); sn = sn * r2 - (1.0 / 5040.0); sn = sn * r2 + (1.0 / 120.0); sn = sn * r2 - (1.0 / 6.0); sn = sn * r2 * r + r;
        double cs = r2 * (1.0 / 479001600.0) - (1.0 / 3628800.0); cs = cs * r2 + (1.0 / 40320.0); cs = cs * r2 - (1.0 / 720.0); cs = cs * r2 + (1.0 / 24.0); cs = cs * r2 - 0.5; cs = cs * r2 + 1.0;
        const int q = ((int)(long long)kq) & 3;
        const double c_ = (q == 0) ? cs : (q == 1) ? -sn : (q == 2) ? -cs : sn;
        const double s_ = (q == 0) ? sn : (q == 1) ? cs : (q == 2) ? -sn : -cs;
        f32x2 o; o.x = (float)c_; o.y = (float)s_; rope[idx] = o;
    }
}

constexpr int KS_STRIDE = 72;
constexpr int VT_STRIDE = 264;
struct AttnStage { u32x4 k1a, k1b, k2a, k2b; u32x4 va0, va1, vb0, vb1; };
struct AttnQ { u32x4 x1, x2; f32x4 rp[4]; };
__device__ __forceinline__ void attn_unit_coords(int unit, int& kvh, int& n, int& tq0) { kvh = unit & 3; const int blk = unit >> 2; n = blk & 127; tq0 = (blk >> 7) * NT + n * 128; }
__device__ __forceinline__ void attn_load_stage(const bf16_t* proj, const f32x2* rope, int unit, int tid, AttnStage& S) {
    int kvh, n, tq0; attn_unit_coords(unit, kvh, n, tq0); const int tk0 = tq0 - 128;
    { const int key = tid & 255, hc = tid >> 8;
      if ((n > 0) || (key >= 128)) { const size_t tok = (size_t)(tk0 + key);
          const bf16_t* kp = proj + tok * INW + OKK + kvh * 64 + hc * 16;
          S.k1a = *(const u32x4*)kp; S.k1b = *(const u32x4*)(kp + 8); S.k2a = *(const u32x4*)(kp + 32); S.k2b = *(const u32x4*)(kp + 40);
      } else { S.k1a = S.k1b = S.k2a = S.k2b = (u32x4){0, 0, 0, 0}; } }
    { const int kp = tid & 127, dc = tid >> 7;
      if ((n > 0) || (kp >= 64)) { const bf16_t* vp = proj + (size_t)(tk0 + 2 * kp) * INW + OV + kvh * 64 + dc * 16;
          S.va0 = *(const u32x4*)vp; S.va1 = *(const u32x4*)(vp + 8); S.vb0 = *(const u32x4*)(vp + INW); S.vb1 = *(const u32x4*)(vp + INW + 8);
      } else { S.va0 = S.va1 = S.vb0 = S.vb1 = (u32x4){0, 0, 0, 0}; } }
}
__device__ __forceinline__ void attn_write_stage(const AttnStage& S, const f32x2* rope, int tk0, bf16_t* Ks, bf16_t* Vt, int tid) {
    { const int key = tid & 255, hc = tid >> 8;
      const int tokc = (tk0 + key) < 0 ? 0 : (tk0 + key);
      const f32x4* rp = (const f32x4*)(rope + (size_t)tokc * 32 + hc * 16);
      const unsigned x1[8] = {S.k1a.x, S.k1a.y, S.k1a.z, S.k1a.w, S.k1b.x, S.k1b.y, S.k1b.z, S.k1b.w};
      const unsigned x2[8] = {S.k2a.x, S.k2a.y, S.k2a.z, S.k2a.w, S.k2b.x, S.k2b.y, S.k2b.z, S.k2b.w};
      unsigned r1[8], r2[8];
#pragma unroll
      for (int i = 0; i < 8; ++i) { const f32x4 cs = rp[i];
          const float a0 = bflo(x1[i]), a1 = bfhi(x1[i]), b0 = bflo(x2[i]), b1 = bfhi(x2[i]);
          r1[i] = cvt_pk_bf16(a0 * cs[0] - b0 * cs[1], a1 * cs[2] - b1 * cs[3]);
          r2[i] = cvt_pk_bf16(b0 * cs[0] + a0 * cs[1], b1 * cs[2] + a1 * cs[3]); }
      bf16_t* kd = Ks + key * KS_STRIDE + hc * 16;
      *(u32x4*)kd = (u32x4){r1[0], r1[1], r1[2], r1[3]}; *(u32x4*)(kd + 8) = (u32x4){r1[4], r1[5], r1[6], r1[7]};
      *(u32x4*)(kd + 32) = (u32x4){r2[0], r2[1], r2[2], r2[3]}; *(u32x4*)(kd + 40) = (u32x4){r2[4], r2[5], r2[6], r2[7]}; }
    { const int kp = tid & 127, dc = tid >> 7;
      const unsigned a[8] = {S.va0.x, S.va0.y, S.va0.z, S.va0.w, S.va1.x, S.va1.y, S.va1.z, S.va1.w};
      const unsigned c[8] = {S.vb0.x, S.vb0.y, S.vb0.z, S.vb0.w, S.vb1.x, S.vb1.y, S.vb1.z, S.vb1.w};
      unsigned* vd = (unsigned*)(Vt + (dc * 16) * VT_STRIDE + 2 * kp);
#pragma unroll
      for (int i = 0; i < 8; ++i) {
          vd[(2 * i) * (VT_STRIDE / 2)] = (a[i] & 0xffffu) | (c[i] << 16);
          vd[(2 * i + 1) * (VT_STRIDE / 2)] = (a[i] >> 16) | (c[i] & 0xffff0000u); } }
}
__device__ __forceinline__ void attn_load_q(const bf16_t* proj, const f32x2* rope, size_t tq, int hq, int fq, AttnQ& Q) {
    const bf16_t* qp = proj + tq * INW + OQ + hq * 64 + fq * 8;
    Q.x1 = *(const u32x4*)qp; Q.x2 = *(const u32x4*)(qp + 32);
    const f32x4* rp = (const f32x4*)(rope + tq * 32 + fq * 8);
#pragma unroll
    for (int i = 0; i < 4; ++i) Q.rp[i] = rp[i];
}
__device__ __forceinline__ void attn_qtile(const AttnQ& Q, const bf16_t* proj, const bf16_t* Ks, const bf16_t* Vt, bf16_t* Aatt, size_t tq, int hq, int qt, int n, float sink, int fr, int fq) {
    u32x2 gtv[4];
#pragma unroll
    for (int nt = 0; nt < 4; ++nt) gtv[nt] = *(const u32x2*)(proj + tq * INW + OAG + hq * 64 + nt * 16 + fq * 4);
    bf16x8 qf0, qf1;
    { const unsigned a[4] = {Q.x1.x, Q.x1.y, Q.x1.z, Q.x1.w}, c[4] = {Q.x2.x, Q.x2.y, Q.x2.z, Q.x2.w}; unsigned r1[4], r2[4];
#pragma unroll
      for (int i = 0; i < 4; ++i) { const f32x4 cs = Q.rp[i];
          const float a0 = bflo(a[i]) * 0.125f, a1 = bfhi(a[i]) * 0.125f, b0 = bflo(c[i]) * 0.125f, b1 = bfhi(c[i]) * 0.125f;
          r1[i] = cvt_pk_bf16(a0 * cs[0] - b0 * cs[1], a1 * cs[2] - b1 * cs[3]);
          r2[i] = cvt_pk_bf16(b0 * cs[0] + a0 * cs[1], b1 * cs[2] + a1 * cs[3]); }
      qf0 = mk8(r1[0], r1[1], r1[2], r1[3]); qf1 = mk8(r2[0], r2[1], r2[2], r2[3]); }
    f32x4 s[9];
#pragma unroll
    for (int k9 = 0; k9 < 9; ++k9) {
        const bf16_t* kr = Ks + ((qt + k9) * 16 + fr) * KS_STRIDE + fq * 8;
        const bf16x8 a0 = *(const bf16x8*)kr, a1 = *(const bf16x8*)(kr + 32);
        f32x4 z = {0.f, 0.f, 0.f, 0.f};
        z = __builtin_amdgcn_mfma_f32_16x16x32_bf16(a0, qf0, z, 0, 0, 0);
        s[k9] = __builtin_amdgcn_mfma_f32_16x16x32_bf16(a1, qf1, z, 0, 0, 0);
    }
    const int d0 = fq * 4 - fr;
    float mx = sink;
#pragma unroll
    for (int k9 = 0; k9 < 9; ++k9) { const bool tile_ok = (n > 0) || (qt + k9 >= 8);
#pragma unroll
        for (int j = 0; j < 4; ++j) { bool vis = tile_ok;
            if (k9 == 0) vis = vis && (d0 + j > 0);
            if (k9 == 8) vis = vis && (d0 + j <= 0);
            s[k9][j] = vis ? s[k9][j] : -INFINITY; mx = fmaxf(mx, s[k9][j]); } }
    mx = fmaxf(mx, __shfl_xor(mx, 16)); mx = fmaxf(mx, __shfl_xor(mx, 32));
    float l = 0.f;
#pragma unroll
    for (int k9 = 0; k9 < 9; ++k9)
#pragma unroll
        for (int j = 0; j < 4; ++j) { const float e = __expf(s[k9][j] - mx); s[k9][j] = e; l += e; }
    l += __shfl_xor(l, 16); l += __shfl_xor(l, 32);
    l += __expf(sink - mx);
    const float inv_l = fast_rcp(l);
    bf16x8 pf[5];
#pragma unroll
    for (int pp = 0; pp < 4; ++pp) pf[pp] = mk8(cvt_pk_bf16(s[2 * pp][0], s[2 * pp][1]), cvt_pk_bf16(s[2 * pp][2], s[2 * pp][3]), cvt_pk_bf16(s[2 * pp + 1][0], s[2 * pp + 1][1]), cvt_pk_bf16(s[2 * pp + 1][2], s[2 * pp + 1][3]));
    pf[4] = mk8(cvt_pk_bf16(s[8][0], s[8][1]), cvt_pk_bf16(s[8][2], s[8][3]), 0u, 0u);
#pragma unroll
    for (int nt = 0; nt < 4; ++nt) { f32x4 o = {0.f, 0.f, 0.f, 0.f};
        const bf16_t* vr = Vt + (nt * 16 + fr) * VT_STRIDE + fq * 4;
#pragma unroll
        for (int pp = 0; pp < 5; ++pp) { const int kta = qt + 2 * pp, ktb = (kta + 1 > 15) ? 15 : kta + 1;
            const u32x2 lo = *(const u32x2*)(vr + kta * 16), hi = *(const u32x2*)(vr + ktb * 16);
            o = __builtin_amdgcn_mfma_f32_16x16x32_bf16(mk8(lo.x, lo.y, hi.x, hi.y), pf[pp], o, 0, 0, 0); }
        const u32x2 gt = gtv[nt];
        u32x2 w; w.x = cvt_pk_bf16(o[0] * inv_l * bflo(gt.x), o[1] * inv_l * bfhi(gt.x)); w.y = cvt_pk_bf16(o[2] * inv_l * bflo(gt.y), o[3] * inv_l * bfhi(gt.y));
        *(u32x2*)(Aatt + tq * 1024 + hq * 64 + nt * 16 + fq * 4) = w; }
}
__device__ __forceinline__ void attn_phase(const Params& p, unsigned char* shm, int c, int G) {
    const bf16_t* proj = (const bf16_t*)(p.ws + WS_PROJ);
    const f32x2* rope = (const f32x2*)(p.ws + WS_ROPE);
    bf16_t* Aatt = (bf16_t*)(p.ws + WS_AATT);
    bf16_t* Ks = (bf16_t*)shm;
    bf16_t* Vt = (bf16_t*)(shm + 256 * KS_STRIDE * 2);
    const int tid = threadIdx.x, wid = tid >> 6, lane = tid & 63, fr = lane & 15, fq = lane >> 4;
    const int g = wid >> 1, qb = (wid & 1) * 4;
    if (c >= NAU) return;
    AttnStage S; attn_load_stage(proj, rope, c, tid, S);
#pragma unroll 1
    for (int unit = c; unit < NAU; unit += G) {
        int kvh, n, tq0; attn_unit_coords(unit, kvh, n, tq0);
        const int hq = kvh * 4 + g; const float sink = p.sinks[hq];
        AttnQ Q0, Q1;
        attn_load_q(proj, rope, (size_t)(tq0 + (qb + 0) * 16 + fr), hq, fq, Q0);
        attn_write_stage(S, rope, tq0 - 128, Ks, Vt, tid);
        __syncthreads();
        attn_load_q(proj, rope, (size_t)(tq0 + (qb + 1) * 16 + fr), hq, fq, Q1);
        attn_qtile(Q0, proj, Ks, Vt, Aatt, (size_t)(tq0 + (qb + 0) * 16 + fr), hq, qb + 0, n, sink, fr, fq);
        attn_load_q(proj, rope, (size_t)(tq0 + (qb + 2) * 16 + fr), hq, fq, Q0);
        attn_qtile(Q1, proj, Ks, Vt, Aatt, (size_t)(tq0 + (qb + 1) * 16 + fr), hq, qb + 1, n, sink, fr, fq);
        attn_load_q(proj, rope, (size_t)(tq0 + (qb + 3) * 16 + fr), hq, fq, Q1);
        attn_qtile(Q0, proj, Ks, Vt, Aatt, (size_t)(tq0 + (qb + 2) * 16 + fr), hq, qb + 2, n, sink, fr, fq);
        if (unit + G < NAU) attn_load_stage(proj, rope, unit + G, tid, S);
        attn_qtile(Q1, proj, Ks, Vt, Aatt, (size_t)(tq0 + (qb + 3) * 16 + fr), hq, qb + 3, n, sink, fr, fq);
        __syncthreads();
    }
}

constexpr int H_STRIDE64 = 72;
constexpr int H_STRIDE128 = 136;
constexpr int SCN = 16;
constexpr int NSC = NT / (64 * SCN);
constexpr int NSU = NB * 8 * NSC;
struct HgrnRaw { unsigned hf[16]; unsigned hi[16]; };
__device__ __forceinline__ void hgrn_load_raw(const bf16_t* proj, size_t rc, int h, int d, int seg, HgrnRaw& R) {
    const bf16_t* bp = proj + (rc + seg * 16) * INW + h * 128 + d;
#pragma unroll
    for (int i = 0; i < 16; ++i) { R.hf[i] = bp[(size_t)i * INW + OHF]; R.hi[i] = bp[(size_t)i * INW + OHI]; }
}
__device__ __forceinline__ void hgrn_gates(const HgrnRaw& R, float lb, float (&bp)[16], float (&kk)[16]) {
    float run = 1.0f;
#pragma unroll
    for (int i = 0; i < 16; ++i) {
        const float hf = __uint_as_float(R.hf[i] << 16);
        const float e = __expf(-hf), inv = fast_rcp(1.0f + e);
        const float f = lb + (1.0f - lb) * inv;
        kk[i] = (1.0f - lb) * e * inv;
        run *= f; bp[i] = run;
    }
}
__device__ __forceinline__ void hgrn_store_vt(const HgrnRaw& R, bf16_t* Vt, int d, int seg) {
    unsigned w[8];
#pragma unroll
    for (int i = 0; i < 8; ++i) w[i] = R.hi[2 * i] | (R.hi[2 * i + 1] << 16);
    bf16_t* vd = Vt + d * H_STRIDE64 + seg * 16; *(u32x4*)vd = (u32x4){w[0], w[1], w[2], w[3]}; *(u32x4*)(vd + 8) = (u32x4){w[4], w[5], w[6], w[7]};
}

__device__ __forceinline__ void hgrn_local_unit(const Params& p, unsigned char* shm, int u) {
    const bf16_t* proj = (const bf16_t*)(p.ws + WS_PROJ);
    float* UT = p.out + (size_t)u * 16384; float* dtot = (float*)(p.ws + WS_DTOT) + (size_t)u * 128;
    bf16_t* KdT = (bf16_t*)shm;
    bf16_t* Vt = (bf16_t*)(shm + 128 * H_STRIDE64 * 2);
    float* segsum = (float*)(shm + 2 * 128 * H_STRIDE64 * 2);
    float* dsh = segsum + 512;
    const int tid = threadIdx.x, wid = tid >> 6, lane = tid & 63, fr = lane & 15, fq = lane >> 4;
    const int sc = u % NSC, sq = u / NSC, h = sq & 7, b = sq >> 3; const size_t r0 = (size_t)b * NT + (size_t)sc * (64 * SCN);
    const int d = tid & 127, seg = tid >> 7;
    const float lb = fast_rcp(1.0f + __expf(p.lbt[1024 + h * 128 + d] - p.lbt[h * 128 + d]));
    f32x4 acc[8];
#pragma unroll
    for (int vt = 0; vt < 8; ++vt) acc[vt] = (f32x4){0.f, 0.f, 0.f, 0.f};
    float bsum = 1.0f;
    HgrnRaw R; hgrn_load_raw(proj, r0, h, d, seg, R);
#pragma unroll 1
    for (int cc = 0; cc < SCN; ++cc) {
        float bp[16], kk[16];
        hgrn_gates(R, lb, bp, kk);
        segsum[seg * 128 + d] = bp[15];
        hgrn_store_vt(R, Vt, d, seg);
        if (cc < SCN - 1) hgrn_load_raw(proj, r0 + (size_t)(cc + 1) * 64, h, d, seg, R);
        __syncthreads();
        float off = 1.0f, btot = 1.0f;
#pragma unroll
        for (int s2 = 0; s2 < 4; ++s2) { const float v = segsum[s2 * 128 + d]; btot *= v; if (s2 < seg) off *= v; }
        { unsigned w[8];
#pragma unroll
          for (int i = 0; i < 8; ++i) { const float k0 = kk[2 * i] * btot * fast_rcp(off * bp[2 * i]), k1 = kk[2 * i + 1] * btot * fast_rcp(off * bp[2 * i + 1]); w[i] = cvt_pk_bf16(k0, k1); }
          bf16_t* kd = KdT + d * H_STRIDE64 + seg * 16; *(u32x4*)kd = (u32x4){w[0], w[1], w[2], w[3]}; *(u32x4*)(kd + 8) = (u32x4){w[4], w[5], w[6], w[7]}; }
        if (seg == 0) dsh[d] = btot;
        bsum *= btot;
        __syncthreads();
        const f32x4 dv = *(const f32x4*)(dsh + 16 * wid + fq * 4);
#pragma unroll
        for (int vt = 0; vt < 8; ++vt) acc[vt] *= dv;
#pragma unroll
        for (int ks = 0; ks < 2; ++ks) { const bf16x8 a = *(const bf16x8*)(KdT + (16 * wid + fr) * H_STRIDE64 + ks * 32 + fq * 8);
#pragma unroll
            for (int vt = 0; vt < 8; ++vt) { const bf16x8 bv = *(const bf16x8*)(Vt + (16 * vt + fr) * H_STRIDE64 + ks * 32 + fq * 8);
                acc[vt] = __builtin_amdgcn_mfma_f32_16x16x32_bf16(a, bv, acc[vt], 0, 0, 0); } }
        __syncthreads();
    }
#pragma unroll
    for (int vt = 0; vt < 8; ++vt) *(f32x4*)(UT + (size_t)(16 * vt + fr) * 128 + 16 * wid + fq * 4) = acc[vt];
    if (seg == 0) dtot[d] = bsum;
}

__device__ __forceinline__ void hgrn_scan(const Params& p) {
    const float* dtot = (const float*)(p.ws + WS_DTOT);
    for (int gidx = blockIdx.x * 512 + threadIdx.x; gidx < 16 * 8192; gidx += gridDim.x * 512) {
        const int sq = gidx >> 13, e = (gidx & 8191) * 2, d = e & 127;
        float* base = p.out + (size_t)sq * NSC * 16384 + e; const float* db = dtot + (size_t)sq * NSC * 128 + d;
        f32x2 S = {0.f, 0.f};
        for (int c0 = 0; c0 < NSC; c0 += 8) {
            f32x2 U[8], D[8];
#pragma unroll
            for (int i = 0; i < 8; ++i) { U[i] = *(const f32x2*)(base + (size_t)(c0 + i) * 16384); D[i] = *(const f32x2*)(db + (size_t)(c0 + i) * 128); }
#pragma unroll
            for (int i = 0; i < 8; ++i) { *(f32x2*)(base + (size_t)(c0 + i) * 16384) = S; S = D[i] * S + U[i]; }
        }
    }
}

__device__ __forceinline__ void hgrn_out_unit(const Params& p, unsigned char* shm, int u) {
    const bf16_t* proj = (const bf16_t*)(p.ws + WS_PROJ);
    const float* ST = p.out + (size_t)u * 16384;
    bf16_t* Ahg = (bf16_t*)(p.ws + WS_AHGR);
    bf16_t* Qs = (bf16_t*)shm;
    bf16_t* Ks2 = (bf16_t*)(shm + 17408);
    bf16_t* Vt = (bf16_t*)(shm + 34816);
    bf16_t* KdT = (bf16_t*)(shm + 53248);
    bf16_t* St = (bf16_t*)(shm + 71680);
    float* segsum = (float*)(shm + 106496);
    float* eref = segsum + 512;
    float* dsh = eref + 128;
    float* part = dsh + 128;
    const int tid = threadIdx.x, wid = tid >> 6, lane = tid & 63, fr = lane & 15, fq = lane >> 4;
    const int sc = u % NSC, sq = u / NSC, h = sq & 7, b = sq >> 3; const size_t r0 = (size_t)b * NT + (size_t)sc * (64 * SCN);
    const int d = tid & 127, seg = tid >> 7;
    const int tt = wid & 3, vh = wid >> 2;
    const float lb = fast_rcp(1.0f + __expf(p.lbt[1024 + h * 128 + d] - p.lbt[h * 128 + d]));
    f32x4 acc[8];
#pragma unroll
    for (int vt = 0; vt < 8; ++vt) acc[vt] = *(const f32x4*)(ST + (size_t)(16 * vt + fr) * 128 + 16 * wid + fq * 4);
    f32x4 gn[4];
#pragma unroll
    for (int vt = 0; vt < 4; ++vt) gn[vt] = *(const f32x4*)(p.hgain + h * 128 + 16 * (vh * 4 + vt) + fq * 4);
    HgrnRaw R; hgrn_load_raw(proj, r0, h, d, seg, R);
    unsigned hq[16];
#pragma unroll
    for (int i = 0; i < 16; ++i) hq[i] = proj[(r0 + seg * 16 + i) * INW + OHQ + h * 128 + d];
#pragma unroll 1
    for (int cc = 0; cc < SCN; ++cc) {
        const size_t rc = r0 + (size_t)cc * 64;
        float bp[16], kk[16];
        hgrn_gates(R, lb, bp, kk);
        segsum[seg * 128 + d] = bp[15];
        hgrn_store_vt(R, Vt, d, seg);
        __syncthreads();
        float off = 1.0f, btot = 1.0f;
#pragma unroll
        for (int s2 = 0; s2 < 4; ++s2) { const float v = segsum[s2 * 128 + d]; btot *= v; if (s2 < seg) off *= v; }
        const float bref = segsum[d] * segsum[128 + d];
        if (seg == 0) { eref[d] = bref; dsh[d] = btot; }
        const float rref = fast_rcp(bref), etail = btot * rref;
        { float kdv[16];
#pragma unroll
          for (int i = 0; i < 16; ++i) { const float cp = off * bp[i]; const int t = seg * 16 + i;
              const float qv = __uint_as_float(hq[i] << 16);
              const float kt = kk[i] * bref * fast_rcp(cp); kdv[i] = kt * etail;
              const unsigned qk = cvt_pk_bf16(qv * cp * rref, kt);
              Qs[t * H_STRIDE128 + d] = (bf16_t)(qk & 0xffffu); Ks2[t * H_STRIDE128 + d] = (bf16_t)(qk >> 16); }
          unsigned w[8];
#pragma unroll
          for (int i = 0; i < 8; ++i) w[i] = cvt_pk_bf16(kdv[2 * i], kdv[2 * i + 1]);
          bf16_t* kd = KdT + d * H_STRIDE64 + seg * 16; *(u32x4*)kd = (u32x4){w[0], w[1], w[2], w[3]}; *(u32x4*)(kd + 8) = (u32x4){w[4], w[5], w[6], w[7]}; }
        if (cc < SCN - 1) { hgrn_load_raw(proj, rc + 64, h, d, seg, R);
#pragma unroll
            for (int i = 0; i < 16; ++i) hq[i] = proj[(rc + 64 + seg * 16 + i) * INW + OHQ + h * 128 + d]; }
        const size_t r = rc + 16 * tt + fr;
        u32x2 gt[4];
#pragma unroll
        for (int vt = 0; vt < 4; ++vt) gt[vt] = *(const u32x2*)(proj + r * INW + OHG + h * 128 + 16 * (vh * 4 + vt) + fq * 4);
        __syncthreads();
        { const f32x4 er = *(const f32x4*)(eref + 16 * wid + fq * 4);
#pragma unroll
          for (int vt = 0; vt < 8; ++vt) { const f32x4 sv = acc[vt] * er; u32x2 w; w.x = cvt_pk_bf16(sv[0], sv[1]); w.y = cvt_pk_bf16(sv[2], sv[3]);
              *(u32x2*)(St + (16 * vt + fr) * H_STRIDE128 + 16 * wid + fq * 4) = w; } }
        __syncthreads();
        bf16x8 bq[4];
#pragma unroll
        for (int ks = 0; ks < 4; ++ks) bq[ks] = *(const bf16x8*)(Qs + (16 * tt + fr) * H_STRIDE128 + ks * 32 + fq * 8);
        f32x4 pa[4];
#pragma unroll
        for (int st = 0; st < 4; ++st) { pa[st] = (f32x4){0.f, 0.f, 0.f, 0.f};
            if (st <= tt) {
#pragma unroll
                for (int ks = 0; ks < 4; ++ks) { const bf16x8 a = *(const bf16x8*)(Ks2 + (16 * st + fr) * H_STRIDE128 + ks * 32 + fq * 8);
                    pa[st] = __builtin_amdgcn_mfma_f32_16x16x32_bf16(a, bq[ks], pa[st], 0, 0, 0); }
#pragma unroll
                for (int j = 0; j < 4; ++j) { const int s_ = 16 * st + fq * 4 + j, t_ = 16 * tt + fr; pa[st][j] = (s_ <= t_) ? pa[st][j] : 0.f; }
            } }
        bf16x8 pf[2];
#pragma unroll
        for (int pp = 0; pp < 2; ++pp) pf[pp] = mk8(cvt_pk_bf16(pa[2 * pp][0], pa[2 * pp][1]), cvt_pk_bf16(pa[2 * pp][2], pa[2 * pp][3]), cvt_pk_bf16(pa[2 * pp + 1][0], pa[2 * pp + 1][1]), cvt_pk_bf16(pa[2 * pp + 1][2], pa[2 * pp + 1][3]));
        f32x4 o[4]; float ss = 0.f;
#pragma unroll
        for (int vt = 0; vt < 4; ++vt) { const int vrow = 16 * (vh * 4 + vt) + fr; o[vt] = (f32x4){0.f, 0.f, 0.f, 0.f};
#pragma unroll
            for (int pp = 0; pp < 2; ++pp) { const u32x2 lo = *(const u32x2*)(Vt + vrow * H_STRIDE64 + (2 * pp) * 16 + fq * 4), hi = *(const u32x2*)(Vt + vrow * H_STRIDE64 + (2 * pp + 1) * 16 + fq * 4);
                o[vt] = __builtin_amdgcn_mfma_f32_16x16x32_bf16(mk8(lo.x, lo.y, hi.x, hi.y), pf[pp], o[vt], 0, 0, 0); }
#pragma unroll
            for (int ks = 0; ks < 4; ++ks) { const bf16x8 a = *(const bf16x8*)(St + vrow * H_STRIDE128 + ks * 32 + fq * 8);
                o[vt] = __builtin_amdgcn_mfma_f32_16x16x32_bf16(a, bq[ks], o[vt], 0, 0, 0); }
            ss += o[vt][0] * o[vt][0] + o[vt][1] * o[vt][1] + o[vt][2] * o[vt][2] + o[vt][3] * o[vt][3]; }
        ss += __shfl_xor(ss, 16); ss += __shfl_xor(ss, 32);
        if (fq == 0) part[vh * 64 + 16 * tt + fr] = ss;
        if (cc < SCN - 1) {
            const f32x4 dv = *(const f32x4*)(dsh + 16 * wid + fq * 4);
#pragma unroll
            for (int vt = 0; vt < 8; ++vt) acc[vt] *= dv;
#pragma unroll
            for (int ks = 0; ks < 2; ++ks) { const bf16x8 a = *(const bf16x8*)(KdT + (16 * wid + fr) * H_STRIDE64 + ks * 32 + fq * 8);
#pragma unroll
                for (int vt = 0; vt < 8; ++vt) { const bf16x8 bv = *(const bf16x8*)(Vt + (16 * vt + fr) * H_STRIDE64 + ks * 32 + fq * 8);
                    acc[vt] = __builtin_amdgcn_mfma_f32_16x16x32_bf16(a, bv, acc[vt], 0, 0, 0); } }
        }
        __syncthreads();
        const float tot = part[16 * tt + fr] + part[64 + 16 * tt + fr];
        const float rstd = rsqrtf(tot * (1.0f / 128.0f) + 1e-6f);
#pragma unroll
        for (int vt = 0; vt < 4; ++vt) { const int col = h * 128 + 16 * (vh * 4 + vt) + fq * 4;
            u32x2 w; w.x = cvt_pk_bf16(o[vt][0] * rstd * gn[vt][0] * bflo(gt[vt].x), o[vt][1] * rstd * gn[vt][1] * bfhi(gt[vt].x)); w.y = cvt_pk_bf16(o[vt][2] * rstd * gn[vt][2] * bflo(gt[vt].y), o[vt][3] * rstd * gn[vt][3] * bfhi(gt[vt].y));
            *(u32x2*)(Ahg + r * 1024 + col) = w; }
    }
}

__device__ __forceinline__ void phase_final(const Params& p) {
    const int tid = threadIdx.x, wid = tid >> 6, lane = tid & 63;
    const bf16_t* yb = (const bf16_t*)(p.ws + WS_AATT);
    for (int r = blockIdx.x * 8 + wid; r < NTOK; r += gridDim.x * 8) {
        const float* xr = p.x + (size_t)r * DM;
        f32x4 v[8]; float ss = 0.f;
#pragma unroll
        for (int i = 0; i < 4; ++i) { const int c0 = (lane + 64 * i) * 8;
            const u32x4 yv = __builtin_nontemporal_load((const u32x4*)(yb + (size_t)r * DM + c0));
            const f32x4 x0 = __builtin_nontemporal_load((const f32x4*)(xr + c0)), x1 = __builtin_nontemporal_load((const f32x4*)(xr + c0 + 4));
            f32x4 a, b; a[0] = x0[0] + bflo(yv.x); a[1] = x0[1] + bfhi(yv.x); a[2] = x0[2] + bflo(yv.y); a[3] = x0[3] + bfhi(yv.y);
            b[0] = x1[0] + bflo(yv.z); b[1] = x1[1] + bfhi(yv.z); b[2] = x1[2] + bflo(yv.w); b[3] = x1[3] + bfhi(yv.w);
            ss += a[0] * a[0] + a[1] * a[1] + a[2] * a[2] + a[3] * a[3] + b[0] * b[0] + b[1] * b[1] + b[2] * b[2] + b[3] * b[3];
            v[2 * i] = a; v[2 * i + 1] = b; }
        ss = wave_sum(ss);
        const float rstd = rsqrtf(ss * (1.0f / DM) + 1e-6f);
        float* orow = p.out + (size_t)r * DM;
#pragma unroll
        for (int i = 0; i < 4; ++i) { const int c0 = (lane + 64 * i) * 8;
            const f32x4 g0 = *(const f32x4*)(p.fgain + c0), g1 = *(const f32x4*)(p.fgain + c0 + 4);
            f32x4 a = v[2 * i], b = v[2 * i + 1];
            a[0] = a[0] * rstd * g0[0]; a[1] = a[1] * rstd * g0[1]; a[2] = a[2] * rstd * g0[2]; a[3] = a[3] * rstd * g0[3];
            b[0] = b[0] * rstd * g1[0]; b[1] = b[1] * rstd * g1[1]; b[2] = b[2] * rstd * g1[2]; b[3] = b[3] * rstd * g1[3];
            __builtin_nontemporal_store(a, (f32x4*)(orow + c0)); __builtin_nontemporal_store(b, (f32x4*)(orow + c0 + 4)); }
    }
}

#define XB_TMO      128
#define XB_XCNT(j)  (256  + 64 * (j))
#define XB_XSUB(j)  (1280 + 64 * (j))
#define XB_XGEN(j)  (2304 + 64 * (j))
#define XB_TOP      3328
#define XB_TOPGEN   3392
#define XCD_BAR_WORDS 3456
#define XB_SPIN_CAP (1u << 18)
__device__ __forceinline__ unsigned xb_ld(unsigned* p)              { return __hip_atomic_load(p, __ATOMIC_RELAXED, __HIP_MEMORY_SCOPE_AGENT); }
__device__ __forceinline__ unsigned xb_add(unsigned* p, unsigned v) { return __hip_atomic_fetch_add(p, v, __ATOMIC_RELAXED, __HIP_MEMORY_SCOPE_AGENT); }
__device__ __forceinline__ unsigned xb_xcc_id() { return (unsigned)__builtin_amdgcn_s_getreg((3 << 11) | 20) & 0xFu; }
#define XB_SPIN(cond, bar) do { unsigned _sp = 0; while (cond) { __builtin_amdgcn_s_sleep(1); \
    if ((++_sp & 255u) == 0u) { if (xb_ld(&(bar)[XB_TMO])) break; if (_sp > XB_SPIN_CAP) { atomicAdd(&(bar)[XB_TMO], 1u); break; } } } } while (0)
struct XcdBarrier { unsigned* bar; unsigned x; volatile LAS unsigned* st; };
__device__ __forceinline__ XcdBarrier xcd_barrier_post(unsigned* bar, volatile LAS unsigned* st) {
    XcdBarrier b; b.bar = bar; b.x = xb_xcc_id(); b.st = st;
    if (threadIdx.x == 0) (void)xb_add(&bar[XB_XCNT(b.x)], 1u);
    return b;
}
__device__ __forceinline__ void xcd_barrier_complete(unsigned* bar, unsigned x, unsigned& nloc, unsigned& nx) {
    const unsigned G = gridDim.x * gridDim.y * gridDim.z;
    unsigned sum, cnt, mine, sp = 0u;
    for (;;) {
        sum = 0u; cnt = 0u; mine = 0u;
#pragma unroll
        for (unsigned j = 0; j < 16; ++j) { const unsigned c = xb_ld(&bar[XB_XCNT(j)]); sum += c; cnt += (c > 0u) ? 1u : 0u; mine = (j == x) ? c : mine; }
        if (sum == G) break;
        __builtin_amdgcn_s_sleep(1);
        if ((++sp & 255u) == 0u) { if (xb_ld(&bar[XB_TMO])) break; if (sp > XB_SPIN_CAP) { atomicAdd(&bar[XB_TMO], 1u); break; } }
    }
    nloc = mine > 0u ? mine : 1u; nx = cnt > 0u ? cnt : 1u;
}
__device__ __forceinline__ void xcd_barrier(const XcdBarrier& b) {
    asm volatile("s_waitcnt vmcnt(0)" ::: "memory");
    __syncthreads();
    if (threadIdx.x == 0) {
        unsigned* bar = b.bar;
        __builtin_amdgcn_s_waitcnt(0);
        unsigned nloc = b.st[0], nx = b.st[1];
        if (nloc == 0u) { xcd_barrier_complete(bar, b.x, nloc, nx); b.st[0] = nloc; b.st[1] = nx; }
        const unsigned old = xb_add(&bar[XB_XSUB(b.x)], 1u);
        const unsigned gen = old / nloc;
        if (old + 1u == (gen + 1u) * nloc) {
            __builtin_amdgcn_fence(__ATOMIC_RELEASE, "agent");
            asm volatile("s_waitcnt vmcnt(0)" ::: "memory");
            const unsigned og = xb_add(&bar[XB_TOP], 1u);
            const unsigned tg = og / nx;
            if (og + 1u == (tg + 1u) * nx) xb_add(&bar[XB_TOPGEN], 1u);
            else XB_SPIN(xb_ld(&bar[XB_TOPGEN]) == tg, bar);
            __builtin_amdgcn_fence(__ATOMIC_ACQUIRE, "agent");
            xb_add(&bar[XB_XGEN(b.x)], 1u);
            asm volatile("s_waitcnt vmcnt(0)" ::: "memory");
        } else {
            XB_SPIN(xb_ld(&bar[XB_XGEN(b.x)]) == gen, bar);
            __builtin_amdgcn_fence(__ATOMIC_ACQUIRE, "agent");
            asm volatile("s_waitcnt vmcnt(0)" ::: "memory");
        }
    }
    __syncthreads();
}

__device__ __forceinline__ void stagger_us(int us) {
    if (us <= 0) return;
    const unsigned long long t0 = __builtin_amdgcn_s_memrealtime();
    while (__builtin_amdgcn_s_memrealtime() - t0 < (unsigned long long)us * 100ull) __builtin_amdgcn_s_sleep(8);
}
#define STAG1 0
#define STAG5 0
#define STAG6 0
#define REP0 1
#define REPS 0
#define REP1 1
#define REP2 1
#define REPA 1
#define REP4 1
#define REP5 1
#define REP6 1
__global__ void __launch_bounds__(512, 2) fwd_megakernel(Params p) {
    extern __shared__ __attribute__((aligned(16))) unsigned char shm[];
    cg::grid_group grid = cg::this_grid();
    const int G = (int)gridDim.x, c = (int)blockIdx.x;
    volatile LAS unsigned* xst = (volatile LAS unsigned*)((LAS unsigned char*)shm + pg8::STAGE_BYTES);
    if (threadIdx.x == 0) { xst[0] = 0u; xst[1] = 0u; xst[2] = 0u; xst[3] = 0u; }
    __syncthreads();
    const XcdBarrier xb = xcd_barrier_post((unsigned*)(p.ws + WS_BAR), xst);
    for (int rep = 0; rep < REP0; ++rep) phase_prep(p, shm);
    if (p.ws == nullptr) grid.sync();
    xcd_barrier(xb);
    for (int rep = 0; rep < REPS; ++rep) xcd_barrier(xb);
    { pg8::Gemm g; g.A0 = (const bf16_t*)(p.ws + WS_HA); g.B0 = (const bf16_t*)(p.ws + WS_WIN); g.A1 = g.A0; g.B1 = g.B0; g.M = NTOK; g.N = INW; g.K = DM;
      stagger_us(((c >> 3) & 3) * STAG1);
      pg8::StaticOrder S; S.init(NTOK, INW, G, c, 0, REP1); EpiProj E; E.O = (bf16_t*)(p.ws + WS_PROJ);
      pg8::gemm_phase<EpiProj>((LAS unsigned char*)shm, g, S, E); }
    xcd_barrier(xb);
    for (int rep = 0; rep < REPA; ++rep) attn_phase(p, shm, c, G);
    for (int rep = 0; rep < REP2; ++rep) for (int u = c; u < NSU; u += G) hgrn_local_unit(p, shm, u);
    xcd_barrier(xb);
    hgrn_scan(p);
    xcd_barrier(xb);
    for (int rep = 0; rep < REP4; ++rep) for (int u = c; u < NSU; u += G) hgrn_out_unit(p, shm, u);
    xcd_barrier(xb);
    { pg8::Gemm g; g.A0 = (const bf16_t*)(p.ws + WS_AATT); g.B0 = (const bf16_t*)(p.ws + WS_WAO); g.A1 = (const bf16_t*)(p.ws + WS_AHGR); g.B1 = (const bf16_t*)(p.ws + WS_WHO); g.M = NTOK; g.N = DM; g.K = 1024;
      stagger_us(((c >> 3) & 3) * STAG5);
      pg8::StaticOrder S; S.init(NTOK, DM, G, c, 1, REP5); EpiMerge E; E.proj = (const bf16_t*)(p.ws + WS_PROJ); E.O = (bf16_t*)(p.ws + WS_HA);
      pg8::gemm_phase<EpiMerge>((LAS unsigned char*)shm, g, S, E); }
    xcd_barrier(xb);
    { pg8::Gemm g; g.A0 = (const bf16_t*)(p.ws + WS_HA); g.B0 = (const bf16_t*)(p.ws + WS_WO); g.A1 = g.A0; g.B1 = g.B0; g.M = NTOK; g.N = DM; g.K = DM;
      stagger_us(((c >> 3) & 3) * STAG6);
      pg8::StaticOrder S; S.init(NTOK, DM, G, c, 0, REP6); EpiY E; E.O = (bf16_t*)(p.ws + WS_AATT);
      pg8::gemm_phase<EpiY>((LAS unsigned char*)shm, g, S, E); }
    xcd_barrier(xb);
    phase_final(p);
}

extern "C" void kernel_launch(void* const* d_in, const int* in_sizes, int n_in, void* d_out, int out_size, void* d_ws, size_t ws_size, hipStream_t stream) {
    constexpr size_t kDynLds = pg8::STAGE_BYTES + 16;
    static int grid_blocks = 0;
    if (grid_blocks == 0) {
        if (ws_size < WS_END) { fprintf(stderr, "kernel_launch: workspace too small: %zu < %zu\n", ws_size, (size_t)WS_END); grid_blocks = -1; return; }
        int dev = 0, cus = 0, per_cu = 0;
        (void)hipGetDevice(&dev);
        (void)hipDeviceGetAttribute(&cus, hipDeviceAttributeMultiprocessorCount, dev);
        if (hipFuncSetAttribute((const void*)fwd_megakernel, hipFuncAttributeMaxDynamicSharedMemorySize, (int)kDynLds) != hipSuccess) { fprintf(stderr, "kernel_launch: hipFuncSetAttribute failed\n"); grid_blocks = -1; return; }
        if (hipOccupancyMaxActiveBlocksPerMultiprocessor(&per_cu, (const void*)fwd_megakernel, 512, kDynLds) != hipSuccess || per_cu < 1) { fprintf(stderr, "kernel_launch: occupancy query failed (%d)\n", per_cu); (void)hipGetLastError(); grid_blocks = -1; return; }
        if (per_cu > 1) per_cu = 1;
        grid_blocks = cus * per_cu;
    }
    if (grid_blocks < 0) return;
    Params p{};
    p.x = (const float*)d_in[0]; p.pos = (const int*)d_in[1]; p.norm_gain = (const float*)d_in[2]; p.w_in = (const float*)d_in[3]; p.sinks = (const float*)d_in[4];
    p.lbt = (const float*)d_in[5]; p.hgain = (const float*)d_in[6]; p.w_ao = (const float*)d_in[7]; p.w_ho = (const float*)d_in[8]; p.w_o = (const float*)d_in[9];
    p.fgain = (const float*)d_in[10]; p.out = (float*)d_out; p.ws = (unsigned char*)d_ws;
    if (hipMemsetAsync((unsigned char*)d_ws + WS_BAR, 0, XCD_BAR_WORDS * 4, stream) != hipSuccess) { fprintf(stderr, "kernel_launch: memset of the barrier words failed\n"); return; }
    void* args[] = {&p};
    hipError_t e = hipLaunchCooperativeKernel((const void*)fwd_megakernel, dim3(grid_blocks), dim3(512), args, kDynLds, stream);
    if (e != hipSuccess) fprintf(stderr, "cooperative launch failed: %s (grid %d)\n", hipGetErrorString(e), grid_blocks);
}
```

```cpp
#include <hip/hip_runtime.h>
#include <hip/hip_cooperative_groups.h>
#include <cstdio>
namespace cg = cooperative_groups;

#define LAS __attribute__((address_space(3)))
typedef unsigned short bf16_t;
typedef short bf16x8 __attribute__((ext_vector_type(8)));
typedef float f32x4 __attribute__((ext_vector_type(4)));
typedef float f32x2 __attribute__((ext_vector_type(2)));
typedef unsigned u32x4 __attribute__((ext_vector_type(4)));
typedef unsigned u32x2 __attribute__((ext_vector_type(2)));

constexpr int NB = 2, NT = 16384, NTOK = NB * NT, DM = 2048, INW = 10752;
constexpr int OQ = 0, OKK = 1024, OV = 1280, OAG = 1536, OHQ = 2560, OHF = 3584, OHI = 4608, OHG = 5632, OMA = 6656, OMH = 8704;
constexpr int NCHUNK = NT / 64;
constexpr int NHU = NB * 8 * NCHUNK;
constexpr int NAU = NB * (NT / 128) * 4;

constexpr size_t WS_HA = 0;
constexpr size_t WS_WIN = WS_HA + (size_t)NTOK * DM * 2;
constexpr size_t WS_WAO = WS_WIN + (size_t)INW * DM * 2;
constexpr size_t WS_WHO = WS_WAO + (size_t)DM * 1024 * 2;
constexpr size_t WS_WO = WS_WHO + (size_t)DM * 1024 * 2;
constexpr size_t WS_PROJ = WS_WO + (size_t)DM * DM * 2;
constexpr size_t WS_ROPE = WS_PROJ + (size_t)NTOK * INW * 2;
constexpr size_t WS_AATT = WS_ROPE + (size_t)NTOK * 32 * 8;
constexpr size_t WS_AHGR = WS_AATT + (size_t)NTOK * 1024 * 2;
constexpr size_t WS_DTOT = WS_AHGR + (size_t)NTOK * 1024 * 2;
constexpr size_t WS_RSS = WS_DTOT + (size_t)NHU * 128 * 4;
constexpr size_t WS_END = WS_RSS + (size_t)NTOK * 32 * 4;
constexpr size_t WS_BAR = WS_RSS;

struct Params {
    const float* x; const int* pos; const float* norm_gain; const float* w_in; const float* sinks; const float* lbt;
    const float* hgain; const float* w_ao; const float* w_ho; const float* w_o; const float* fgain;
    float* out; unsigned char* ws;
};

__constant__ float c_inv_freq[32] = {
    1.0f, 0.749894261f, 0.562341332f, 0.421696514f, 0.316227764f, 0.237137377f, 0.177827939f, 0.133352131f, 0.100000001f, 0.0749894157f,
    0.0562341325f, 0.0421696529f, 0.0316227749f, 0.0237137377f, 0.0177827943f, 0.0133352149f, 0.00999999978f, 0.00749894185f,
    0.00562341325f, 0.00421696482f, 0.00316227763f, 0.00237137359f, 0.00177827943f, 0.00133352145f, 0.00100000005f, 0.000749894243f,
    0.000562341302f, 0.000421696517f, 0.000316227757f, 0.00023713737f, 0.00017782794f, 0.00013335215f};

__device__ __forceinline__ float bf2f(bf16_t b) { return __uint_as_float(((unsigned)b) << 16); }
__device__ __forceinline__ float bflo(unsigned w) { return __uint_as_float(w << 16); }
__device__ __forceinline__ float bfhi(unsigned w) { return __uint_as_float(w & 0xffff0000u); }
__device__ __forceinline__ unsigned cvt_pk_bf16(float lo, float hi) { unsigned r; asm volatile("v_cvt_pk_bf16_f32 %0, %1, %2" : "=v"(r) : "v"(lo), "v"(hi)); return r; }
__device__ __forceinline__ float fast_rcp(float x) { return __builtin_amdgcn_rcpf(x); }
__device__ __forceinline__ float sigmoidf_(float v) { return fast_rcp(1.0f + __expf(-v)); }
__device__ __forceinline__ float wave_sum(float v) {
#pragma unroll
    for (int o = 32; o > 0; o >>= 1) v += __shfl_xor(v, o);
    return v;
}
__device__ __forceinline__ bf16x8 mk8(unsigned a, unsigned b, unsigned c, unsigned d) { u32x4 w; w.x = a; w.y = b; w.z = c; w.w = d; return __builtin_bit_cast(bf16x8, w); }

namespace pg8 {
constexpr int BM = 256, BK = 64, HALF = 128, HTB = HALF * BK * 2, STAGE_BYTES = 8 * HTB, NXCD = 8, WGM = 8;
__host__ __device__ __forceinline__ int lds_byte(int r, int c) { const int st = (r >> 4) * 2 + (c >> 5), rr = r & 15, cc = c & 31, ob = rr * 64 + cc * 2; return st * 1024 + (ob ^ (((ob >> 9) & 1) << 5)); }
__host__ __device__ __forceinline__ void stage_rc(int b, int& R, int& C) { const int st = b / 1024, sb = b % 1024, swz = sb ^ (((sb >> 9) & 1) << 5); R = (st >> 1) * 16 + swz / 64; C = (st & 1) * 32 + (swz % 64) / 2; }
__host__ __device__ __forceinline__ int perm32(int rho) { const int n = rho >> 4, i = rho & 15; return 8 * (i >> 2) + 4 * n + (i & 3); }

struct Unit { int pm, pn, kind, rep; };
struct Gemm { const bf16_t* A0; const bf16_t* B0; const bf16_t* A1; const bf16_t* B1; int M, N, K; };

struct StaticOrder {
    int nM, nN, nwg, G, c, dual, R, reps;
    __device__ void init(int M, int N, int G_, int c_, int dual_, int reps_ = 1) { nM = M / BM; nN = N / BM; nwg = nM * nN; G = G_; c = c_; dual = dual_; R = (nwg + G - 1) / G; reps = reps_; }
    __device__ bool next(int i, Unit& u) const {
        if (i >= reps * (R << dual)) return false;
        const int it = (i >> dual) % R;
        const long L = (long)it * G + c; if (L >= nwg) return false;
        int wgid = (int)L; { const int q = nwg / NXCD, r = nwg % NXCD, xcd = wgid % NXCD, off = wgid / NXCD; wgid = (xcd < r ? xcd * (q + 1) : r * (q + 1) + (xcd - r) * q) + off; }
        const int nig = WGM * nN, gid = wgid / nig, fm = gid * WGM, gsz = (nM - fm) < WGM ? (nM - fm) : WGM;
        u.pm = fm + ((wgid % nig) % gsz); u.pn = (wgid % nig) / gsz; u.kind = i & dual; u.rep = (i >> dual) / R; return true;
    }
};

template <class Epi>
__device__ __forceinline__ void gemm_phase(LAS unsigned char* lds, const Gemm g, const StaticOrder& S, const Epi& E) {
    const int tid = threadIdx.x, wid = __builtin_amdgcn_readfirstlane(tid >> 6), lane = tid & 63, wr = wid >> 2, wc = wid & 3, fr = lane & 15, fq = lane >> 4;
    const int K = g.K, nt = K / BK;
    unsigned voffA[2], voffB[2];
#pragma unroll
    for (int i = 0; i < 2; ++i) { int R, C; stage_rc(tid * 16 + i * 8192, R, C); const int Rb = Epi::PERM ? ((R & ~31) + perm32(R & 31)) : R;
        voffA[i] = (unsigned)(R * K + C) * 2u; voffB[i] = (unsigned)(Rb * K + C) * 2u; }
    const size_t kstep = (size_t)(BK * 2);
    const size_t hstep = (size_t)HALF * K * 2;
    const size_t tstep = 2 * hstep;
    const unsigned ldsw = (unsigned)wid * 1024u;
    const int aoff = lds_byte(wr * 64 + fr, fq * 8), boff = lds_byte(wc * 32 + fr, fq * 8);
#define PG8_SA(b, h) (((b) * 2 + (h)) * HTB)
#define PG8_SB(b, h) ((4 + (b) * 2 + (h)) * HTB)
#define PG8_STAGE(bufoff, gbase, voff) do { _Pragma("unroll") for (int _i = 0; _i < 2; ++_i) \
        __builtin_amdgcn_global_load_lds((const unsigned*)((const char*)(gbase) + (voff)[_i]), (LAS unsigned*)(lds + (bufoff) + ldsw + _i * 8192), 16, 0, 0); } while (0)
#define PG8_LDA(dst, b, h) do { _Pragma("unroll") for (int m = 0; m < 4; ++m) _Pragma("unroll") for (int k = 0; k < 2; ++k) dst[m][k] = *(const LAS bf16x8*)(lds + PG8_SA(b, h) + aoff + m * 2048 + k * 1024); } while (0)
#define PG8_LDB(dst, b, h) do { _Pragma("unroll") for (int n = 0; n < 2; ++n) _Pragma("unroll") for (int k = 0; k < 2; ++k) dst[n][k] = *(const LAS bf16x8*)(lds + PG8_SB(b, h) + boff + n * 2048 + k * 1024); } while (0)
#define PG8_MMA(ai, bj, At, Bt) do { __builtin_amdgcn_s_setprio(1); _Pragma("unroll") for (int m = 0; m < 4; ++m) _Pragma("unroll") for (int n = 0; n < 2; ++n) _Pragma("unroll") for (int k = 0; k < 2; ++k) \
        acc[ai][bj][m][n] = __builtin_amdgcn_mfma_f32_16x16x32_bf16(Bt[n][k], At[m][k], acc[ai][bj][m][n], 0, 0, 0); __builtin_amdgcn_s_setprio(0); } while (0)
#define PG8_WAIT_V(n) asm volatile("s_waitcnt vmcnt(" #n ")" ::: "memory")
#define PG8_WAIT_L(n) asm volatile("s_waitcnt lgkmcnt(" #n ")" ::: "memory")
#define PG8_BAR __builtin_amdgcn_s_barrier()
#define PG8_SCHED __builtin_amdgcn_sched_barrier(0)
    Unit cur, nxt; int ui = 0;
    if (!S.next(0, cur)) return;
    f32x4 acc[2][2][4][2];
#pragma unroll
    for (int a = 0; a < 2; ++a)
#pragma unroll
        for (int b = 0; b < 2; ++b)
#pragma unroll
            for (int m = 0; m < 4; ++m)
#pragma unroll
                for (int n = 0; n < 2; ++n) acc[a][b][m][n] = (f32x4){0.f, 0.f, 0.f, 0.f};
    bf16x8 At[4][2], B0[2][2], B1[2][2];
    const char* cA = (const char*)(cur.kind ? g.A1 : g.A0) + (size_t)cur.pm * tstep; const char* cB = (const char*)(cur.kind ? g.B1 : g.B0) + (size_t)cur.pn * tstep;
    PG8_STAGE(PG8_SB(0, 0), cB, voffB); PG8_STAGE(PG8_SA(0, 0), cA, voffA); PG8_STAGE(PG8_SB(0, 1), cB + hstep, voffB); PG8_STAGE(PG8_SA(0, 1), cA + hstep, voffA);
    if (wr == 1) PG8_BAR;
    PG8_WAIT_V(4); PG8_BAR;
    PG8_STAGE(PG8_SB(1, 0), cB + kstep, voffB); PG8_STAGE(PG8_SA(1, 0), cA + kstep, voffA); PG8_STAGE(PG8_SB(1, 1), cB + hstep + kstep, voffB);
    PG8_WAIT_V(6); PG8_BAR;
    for (;;) {
        const bool has_next = S.next(ui + 1, nxt);
        const char* nA = has_next ? (const char*)(nxt.kind ? g.A1 : g.A0) + (size_t)nxt.pm * tstep : cA; const char* nB = has_next ? (const char*)(nxt.kind ? g.B1 : g.B0) + (size_t)nxt.pn * tstep : cB;
        for (int t = 0; t < nt; t += 2) {
            const bool last = (t == nt - 2);
            const char* a1 = cA + (size_t)(t + 1) * kstep;
            const char* a2 = last ? nA : cA + (size_t)(t + 2) * kstep; const char* b2 = last ? nB : cB + (size_t)(t + 2) * kstep;
            const char* a3 = a2 + kstep; const char* b3 = b2 + kstep;
            PG8_LDB(B0, 0, 0); PG8_SCHED; PG8_LDA(At, 0, 0); PG8_STAGE(PG8_SA(1, 1), a1 + hstep, voffA);
            PG8_WAIT_L(8); PG8_BAR; PG8_WAIT_L(0); PG8_MMA(0, 0, At, B0); PG8_BAR; PG8_SCHED;
            PG8_LDB(B1, 0, 1); PG8_STAGE(PG8_SB(0, 0), b2, voffB);
            PG8_BAR; PG8_WAIT_L(0); PG8_MMA(0, 1, At, B1); PG8_BAR;
            PG8_LDA(At, 0, 1); PG8_STAGE(PG8_SA(0, 0), a2, voffA);
            PG8_BAR; PG8_WAIT_L(0); PG8_MMA(1, 0, At, B0); PG8_BAR; PG8_SCHED;
            PG8_STAGE(PG8_SB(0, 1), b2 + hstep, voffB);
            PG8_WAIT_V(6); PG8_BAR; PG8_MMA(1, 1, At, B1); PG8_BAR;
            PG8_LDB(B0, 1, 0); PG8_SCHED; PG8_LDA(At, 1, 0); PG8_STAGE(PG8_SA(0, 1), a2 + hstep, voffA);
            PG8_WAIT_L(8); PG8_BAR; PG8_WAIT_L(0); PG8_MMA(0, 0, At, B0); PG8_BAR; PG8_SCHED;
            PG8_LDB(B1, 1, 1); PG8_STAGE(PG8_SB(1, 0), b3, voffB);
            PG8_BAR; PG8_WAIT_L(0); PG8_MMA(0, 1, At, B1); PG8_BAR;
            PG8_LDA(At, 1, 1); PG8_STAGE(PG8_SA(1, 0), a3, voffA);
            PG8_BAR; PG8_WAIT_L(0); PG8_MMA(1, 0, At, B0); PG8_BAR; PG8_SCHED;
            PG8_STAGE(PG8_SB(1, 1), b3 + hstep, voffB);
            PG8_WAIT_V(6); PG8_BAR; PG8_MMA(1, 1, At, B1); PG8_BAR;
        }
        const bool keep = E(acc, cur, wr, wc, fr, fq);
        if (!has_next) break;
        if (!keep) {
#pragma unroll
            for (int a = 0; a < 2; ++a)
#pragma unroll
                for (int b = 0; b < 2; ++b)
#pragma unroll
                    for (int m = 0; m < 4; ++m)
#pragma unroll
                        for (int n = 0; n < 2; ++n) acc[a][b][m][n] = (f32x4){0.f, 0.f, 0.f, 0.f};
        }
        cur = nxt; cA = nA; cB = nB; ++ui;
    }
    PG8_WAIT_V(0);
    if (wr == 0) PG8_BAR;
    PG8_BAR;
#undef PG8_SA
#undef PG8_SB
#undef PG8_STAGE
#undef PG8_LDA
#undef PG8_LDB
#undef PG8_MMA
#undef PG8_WAIT_V
#undef PG8_WAIT_L
#undef PG8_BAR
#undef PG8_SCHED
}
}

#define PROBE_SKIP_EPI 0
struct EpiProj {
    static constexpr bool PERM = true;
    bf16_t* O;
    __device__ __forceinline__ bool operator()(f32x4 (&acc)[2][2][4][2], const pg8::Unit& u, int wr, int wc, int fr, int fq) const {
        if (PROBE_SKIP_EPI && u.rep) return false;
        const int pn = u.pn;
        int mode = 0; float scale = 1.0f;
        if ((pn >= 6 && pn < 10) || (pn >= 22 && pn < 26)) mode = 1;
        else if (pn >= 10 && pn < 14) { mode = 1; scale = 0.08838834764831845f; }
        const int row0 = u.pm * 256 + wr * 64 + fr, col0 = pn * 256 + wc * 32 + 8 * fq;
        if (pn >= 26) {
#pragma unroll
            for (int ai = 0; ai < 2; ++ai)
#pragma unroll
                for (int m = 0; m < 4; ++m) { bf16_t* rowp = O + (size_t)(row0 + ai * 128 + m * 16) * INW + col0;
                    float rr[8], s2[8];
#pragma unroll
                    for (int n = 0; n < 2; ++n)
#pragma unroll
                        for (int j = 0; j < 4; ++j) { const float p1 = 1.0f + fminf(__expf(-acc[ai][0][m][n][j]), 1e15f), p2 = 1.0f + fminf(__expf(-acc[ai][1][m][n][j]), 1e15f);
                            const float inv = fast_rcp(p1 * p2);
                            s2[4 * n + j] = p1 * inv; rr[4 * n + j] = p2 * p2 * inv; }
                    u32x4 w; w.x = cvt_pk_bf16(rr[0], rr[1]); w.y = cvt_pk_bf16(rr[2], rr[3]); w.z = cvt_pk_bf16(rr[4], rr[5]); w.w = cvt_pk_bf16(rr[6], rr[7]);
                    __builtin_nontemporal_store(w, (u32x4*)rowp);
                    w.x = cvt_pk_bf16(s2[0], s2[1]); w.y = cvt_pk_bf16(s2[2], s2[3]); w.z = cvt_pk_bf16(s2[4], s2[5]); w.w = cvt_pk_bf16(s2[6], s2[7]);
                    __builtin_nontemporal_store(w, (u32x4*)(rowp + 128)); }
            return false;
        }
#pragma unroll
        for (int ai = 0; ai < 2; ++ai)
#pragma unroll
            for (int m = 0; m < 4; ++m) { bf16_t* rowp = O + (size_t)(row0 + ai * 128 + m * 16) * INW + col0;
#pragma unroll
                for (int bj = 0; bj < 2; ++bj) { f32x4 v0 = acc[ai][bj][m][0], v1 = acc[ai][bj][m][1];
                    if (mode != 0) {
#pragma unroll
                        for (int j = 0; j < 4; ++j) { v0[j] = v0[j] * sigmoidf_(v0[j]) * scale; v1[j] = v1[j] * sigmoidf_(v1[j]) * scale; }
                    }
                    u32x4 w; w.x = cvt_pk_bf16(v0[0], v0[1]); w.y = cvt_pk_bf16(v0[2], v0[3]); w.z = cvt_pk_bf16(v1[0], v1[1]); w.w = cvt_pk_bf16(v1[2], v1[3]);
                    __builtin_nontemporal_store(w, (u32x4*)(rowp + bj * 128)); } }
        return false;
    }
};
struct EpiMerge {
    static constexpr bool PERM = true;
    const bf16_t* proj; bf16_t* O;
    __device__ __forceinline__ bool operator()(f32x4 (&acc)[2][2][4][2], const pg8::Unit& u, int wr, int wc, int fr, int fq) const {
        const int row0 = u.pm * 256 + wr * 64 + fr, lc = wc * 32 + 8 * fq;
        const int goff = OMA + u.pn * 512 + (u.kind ? 128 : 0) + lc;
        u32x4 Gv[2][4][2];
#pragma unroll
        for (int ai = 0; ai < 2; ++ai)
#pragma unroll
            for (int m = 0; m < 4; ++m)
#pragma unroll
                for (int bj = 0; bj < 2; ++bj) Gv[ai][m][bj] = __builtin_nontemporal_load((const u32x4*)(proj + (size_t)(row0 + ai * 128 + m * 16) * INW + goff + bj * 256));
#pragma unroll
        for (int ai = 0; ai < 2; ++ai)
#pragma unroll
            for (int m = 0; m < 4; ++m)
#pragma unroll
                for (int bj = 0; bj < 2; ++bj) { const u32x4 g = Gv[ai][m][bj];
                    const float gs[8] = {bflo(g.x), bfhi(g.x), bflo(g.y), bfhi(g.y), bflo(g.z), bfhi(g.z), bflo(g.w), bfhi(g.w)};
                    f32x4 v0 = acc[ai][bj][m][0], v1 = acc[ai][bj][m][1];
#pragma unroll
                    for (int j = 0; j < 4; ++j) { v0[j] *= gs[j]; v1[j] *= gs[4 + j]; }
                    if (u.kind == 0) { acc[ai][bj][m][0] = v0; acc[ai][bj][m][1] = v1; }
                    else { u32x4 w; w.x = cvt_pk_bf16(v0[0], v0[1]); w.y = cvt_pk_bf16(v0[2], v0[3]); w.z = cvt_pk_bf16(v1[0], v1[1]); w.w = cvt_pk_bf16(v1[2], v1[3]);
                        *(u32x4*)(O + (size_t)(row0 + ai * 128 + m * 16) * DM + u.pn * 256 + bj * 128 + lc) = w; } }
        return u.kind == 0;
    }
};
struct EpiY {
    static constexpr bool PERM = true;
    bf16_t* O;
    __device__ __forceinline__ bool operator()(f32x4 (&acc)[2][2][4][2], const pg8::Unit& u, int wr, int wc, int fr, int fq) const {
        const int row0 = u.pm * 256 + wr * 64 + fr, col0 = u.pn * 256 + wc * 32 + 8 * fq;
#pragma unroll
        for (int ai = 0; ai < 2; ++ai)
#pragma unroll
            for (int m = 0; m < 4; ++m) { bf16_t* rowp = O + (size_t)(row0 + ai * 128 + m * 16) * DM + col0;
#pragma unroll
                for (int bj = 0; bj < 2; ++bj) { const f32x4 v0 = acc[ai][bj][m][0], v1 = acc[ai][bj][m][1];
                    u32x4 w; w.x = cvt_pk_bf16(v0[0], v0[1]); w.y = cvt_pk_bf16(v0[2], v0[3]); w.z = cvt_pk_bf16(v1[0], v1[1]); w.w = cvt_pk_bf16(v1[2], v1[3]);
                    __builtin_nontemporal_store(w, (u32x4*)(rowp + bj * 128)); } }
        return false;
    }
};

template <bool GATE_MAP>
__device__ __forceinline__ void transpose_tile_wave(const float* __restrict__ W, int K, int N, bf16_t* __restrict__ WT, int tile, int lane) {
    const int ntn = N >> 6; const int k0 = (tile / ntn) * 64, n0 = (tile % ntn) * 64;
    const float* src = W + (size_t)k0 * N + n0 + lane;
    float v[64];
#pragma unroll
    for (int i = 0; i < 64; ++i) v[i] = src[(size_t)i * N];
    int nrow = n0;
    if (GATE_MAP && n0 >= OMA) { const int hg = (n0 >= OMH) ? 1 : 0, ch = n0 - (hg ? OMH : OMA); nrow = OMA + (ch >> 7) * 256 + hg * 128 + (ch & 127); }
    bf16_t* dst = WT + (size_t)(nrow + lane) * K + k0;
#pragma unroll
    for (int i = 0; i < 8; ++i) { u32x4 w; w.x = cvt_pk_bf16(v[8 * i], v[8 * i + 1]); w.y = cvt_pk_bf16(v[8 * i + 2], v[8 * i + 3]); w.z = cvt_pk_bf16(v[8 * i + 4], v[8 * i + 5]); w.w = cvt_pk_bf16(v[8 * i + 6], v[8 * i + 7]);
        *(u32x4*)(dst + 8 * i) = w; }
}

__device__ __forceinline__ void phase_prep(const Params& p, unsigned char* shm) {
    const int tid = threadIdx.x, wid = tid >> 6, lane = tid & 63;
    bf16_t* hA = (bf16_t*)(p.ws + WS_HA);
    for (int r = blockIdx.x * 8 + wid; r < NTOK; r += gridDim.x * 8) {
        const f32x4* xr = (const f32x4*)(p.x + (size_t)r * DM);
        f32x4 v[8]; float ss = 0.f;
#pragma unroll
        for (int i = 0; i < 8; ++i) { v[i] = xr[lane + 64 * i]; ss += v[i][0] * v[i][0] + v[i][1] * v[i][1] + v[i][2] * v[i][2] + v[i][3] * v[i][3]; }
        ss = wave_sum(ss);
        const float rstd = rsqrtf(ss * (1.0f / DM) + 1e-6f);
#pragma unroll
        for (int i = 0; i < 8; ++i) { const f32x4 g = ((const f32x4*)p.norm_gain)[lane + 64 * i];
            u32x2 w; w.x = cvt_pk_bf16(v[i][0] * rstd * g[0], v[i][1] * rstd * g[1]); w.y = cvt_pk_bf16(v[i][2] * rstd * g[2], v[i][3] * rstd * g[3]);
            *(u32x2*)(hA + (size_t)r * DM + (lane + 64 * i) * 4) = w; }
    }
    constexpr int T_IN = (DM / 64) * (INW / 64), T_AO = (1024 / 64) * (DM / 64), T_WO = (DM / 64) * (DM / 64);
    for (int t = blockIdx.x * 8 + wid; t < T_IN + 2 * T_AO + T_WO; t += gridDim.x * 8) {
        if (t < T_IN) transpose_tile_wave<true>(p.w_in, DM, INW, (bf16_t*)(p.ws + WS_WIN), t, lane);
        else if (t < T_IN + T_AO) transpose_tile_wave<false>(p.w_ao, 1024, DM, (bf16_t*)(p.ws + WS_WAO), t - T_IN, lane);
        else if (t < T_IN + 2 * T_AO) transpose_tile_wave<false>(p.w_ho, 1024, DM, (bf16_t*)(p.ws + WS_WHO), t - T_IN - T_AO, lane);
        else transpose_tile_wave<false>(p.w_o, DM, DM, (bf16_t*)(p.ws + WS_WO), t - T_IN - 2 * T_AO, lane);
    }
    f32x2* rope = (f32x2*)(p.ws + WS_ROPE);
    for (int idx = blockIdx.x * 512 + tid; idx < NTOK * 32; idx += gridDim.x * 512) {
        const int tok = idx >> 5, i = idx & 31;
        const float ang = (float)p.pos[tok] * c_inv_freq[i];
        const double a = (double)ang; const double kq = rint(a * 0.63661977236758134308);
        const double r = fma(-kq, 1.5707963267948966192, a) - kq * 6.123233995736766e-17;
        const double r2 = r * r;
        double sn = r2 * (-1.0 / 39916800.0) + (1.0 / 362880.0); sn = sn * r2 - (1.0 / 5040.0); sn = sn * r2 + (1.0 / 120.0); sn = sn * r2 - (1.0 / 6.0); sn = sn * r2 * r + r;
        double cs = r2 * (1.0 / 479001600.0) - (1.0 / 3628800.0); cs = cs * r2 + (1.0 / 40320.0); cs = cs * r2 - (1.0 / 720.0); cs = cs * r2 + (1.0 / 24.0); cs = cs * r2 - 0.5; cs = cs * r2 + 1.0;
        const int q = ((int)(long long)kq) & 3;
        const double c_ = (q == 0) ? cs : (q == 1) ? -sn : (q == 2) ? -cs : sn;
        const double s_ = (q == 0) ? sn : (q == 1) ? cs : (q == 2) ? -sn : -cs;
        f32x2 o; o.x = (float)c_; o.y = (float)s_; rope[idx] = o;
    }
}

constexpr int KS_STRIDE = 72;
constexpr int VT_STRIDE = 264;
struct AttnStage { u32x4 k1a, k1b, k2a, k2b; u32x4 va0, va1, vb0, vb1; };
struct AttnQ { u32x4 x1, x2; f32x4 rp[4]; };
__device__ __forceinline__ void attn_unit_coords(int unit, int& kvh, int& n, int& tq0) { kvh = unit & 3; const int blk = unit >> 2; n = blk & 127; tq0 = (blk >> 7) * NT + n * 128; }
__device__ __forceinline__ void attn_load_stage(const bf16_t* proj, const f32x2* rope, int unit, int tid, AttnStage& S) {
    int kvh, n, tq0; attn_unit_coords(unit, kvh, n, tq0); const int tk0 = tq0 - 128;
    { const int key = tid & 255, hc = tid >> 8;
      if ((n > 0) || (key >= 128)) { const size_t tok = (size_t)(tk0 + key);
          const bf16_t* kp = proj + tok * INW + OKK + kvh * 64 + hc * 16;
          S.k1a = *(const u32x4*)kp; S.k1b = *(const u32x4*)(kp + 8); S.k2a = *(const u32x4*)(kp + 32); S.k2b = *(const u32x4*)(kp + 40);
      } else { S.k1a = S.k1b = S.k2a = S.k2b = (u32x4){0, 0, 0, 0}; } }
    { const int kp = tid & 127, dc = tid >> 7;
      if ((n > 0) || (kp >= 64)) { const bf16_t* vp = proj + (size_t)(tk0 + 2 * kp) * INW + OV + kvh * 64 + dc * 16;
          S.va0 = *(const u32x4*)vp; S.va1 = *(const u32x4*)(vp + 8); S.vb0 = *(const u32x4*)(vp + INW); S.vb1 = *(const u32x4*)(vp + INW + 8);
      } else { S.va0 = S.va1 = S.vb0 = S.vb1 = (u32x4){0, 0, 0, 0}; } }
}
__device__ __forceinline__ void attn_write_stage(const AttnStage& S, const f32x2* rope, int tk0, bf16_t* Ks, bf16_t* Vt, int tid) {
    { const int key = tid & 255, hc = tid >> 8;
      const int tokc = (tk0 + key) < 0 ? 0 : (tk0 + key);
      const f32x4* rp = (const f32x4*)(rope + (size_t)tokc * 32 + hc * 16);
      const unsigned x1[8] = {S.k1a.x, S.k1a.y, S.k1a.z, S.k1a.w, S.k1b.x, S.k1b.y, S.k1b.z, S.k1b.w};
      const unsigned x2[8] = {S.k2a.x, S.k2a.y, S.k2a.z, S.k2a.w, S.k2b.x, S.k2b.y, S.k2b.z, S.k2b.w};
      unsigned r1[8], r2[8];
#pragma unroll
      for (int i = 0; i < 8; ++i) { const f32x4 cs = rp[i];
          const float a0 = bflo(x1[i]), a1 = bfhi(x1[i]), b0 = bflo(x2[i]), b1 = bfhi(x2[i]);
          r1[i] = cvt_pk_bf16(a0 * cs[0] - b0 * cs[1], a1 * cs[2] - b1 * cs[3]);
          r2[i] = cvt_pk_bf16(b0 * cs[0] + a0 * cs[1], b1 * cs[2] + a1 * cs[3]); }
      bf16_t* kd = Ks + key * KS_STRIDE + hc * 16;
      *(u32x4*)kd = (u32x4){r1[0], r1[1], r1[2], r1[3]}; *(u32x4*)(kd + 8) = (u32x4){r1[4], r1[5], r1[6], r1[7]};
      *(u32x4*)(kd + 32) = (u32x4){r2[0], r2[1], r2[2], r2[3]}; *(u32x4*)(kd + 40) = (u32x4){r2[4], r2[5], r2[6], r2[7]}; }
    { const int kp = tid & 127, dc = tid >> 7;
      const unsigned a[8] = {S.va0.x, S.va0.y, S.va0.z, S.va0.w, S.va1.x, S.va1.y, S.va1.z, S.va1.w};
      const unsigned c[8] = {S.vb0.x, S.vb0.y, S.vb0.z, S.vb0.w, S.vb1.x, S.vb1.y, S.vb1.z, S.vb1.w};
      unsigned* vd = (unsigned*)(Vt + (dc * 16) * VT_STRIDE + 2 * kp);
#pragma unroll
      for (int i = 0; i < 8; ++i) {
          vd[(2 * i) * (VT_STRIDE / 2)] = (a[i] & 0xffffu) | (c[i] << 16);
          vd[(2 * i + 1) * (VT_STRIDE / 2)] = (a[i] >> 16) | (c[i] & 0xffff0000u); } }
}
__device__ __forceinline__ void attn_load_q(const bf16_t* proj, const f32x2* rope, size_t tq, int hq, int fq, AttnQ& Q) {
    const bf16_t* qp = proj + tq * INW + OQ + hq * 64 + fq * 8;
    Q.x1 = *(const u32x4*)qp; Q.x2 = *(const u32x4*)(qp + 32);
    const f32x4* rp = (const f32x4*)(rope + tq * 32 + fq * 8);
#pragma unroll
    for (int i = 0; i < 4; ++i) Q.rp[i] = rp[i];
}
__device__ __forceinline__ void attn_qtile(const AttnQ& Q, const bf16_t* proj, const bf16_t* Ks, const bf16_t* Vt, bf16_t* Aatt, size_t tq, int hq, int qt, int n, float sink, int fr, int fq) {
    u32x2 gtv[4];
#pragma unroll
    for (int nt = 0; nt < 4; ++nt) gtv[nt] = *(const u32x2*)(proj + tq * INW + OAG + hq * 64 + nt * 16 + fq * 4);
    bf16x8 qf0, qf1;
    { const unsigned a[4] = {Q.x1.x, Q.x1.y, Q.x1.z, Q.x1.w}, c[4] = {Q.x2.x, Q.x2.y, Q.x2.z, Q.x2.w}; unsigned r1[4], r2[4];
#pragma unroll
      for (int i = 0; i < 4; ++i) { const f32x4 cs = Q.rp[i];
          const float a0 = bflo(a[i]) * 0.125f, a1 = bfhi(a[i]) * 0.125f, b0 = bflo(c[i]) * 0.125f, b1 = bfhi(c[i]) * 0.125f;
          r1[i] = cvt_pk_bf16(a0 * cs[0] - b0 * cs[1], a1 * cs[2] - b1 * cs[3]);
          r2[i] = cvt_pk_bf16(b0 * cs[0] + a0 * cs[1], b1 * cs[2] + a1 * cs[3]); }
      qf0 = mk8(r1[0], r1[1], r1[2], r1[3]); qf1 = mk8(r2[0], r2[1], r2[2], r2[3]); }
    f32x4 s[9];
#pragma unroll
    for (int k9 = 0; k9 < 9; ++k9) {
        const bf16_t* kr = Ks + ((qt + k9) * 16 + fr) * KS_STRIDE + fq * 8;
        const bf16x8 a0 = *(const bf16x8*)kr, a1 = *(const bf16x8*)(kr + 32);
        f32x4 z = {0.f, 0.f, 0.f, 0.f};
        z = __builtin_amdgcn_mfma_f32_16x16x32_bf16(a0, qf0, z, 0, 0, 0);
        s[k9] = __builtin_amdgcn_mfma_f32_16x16x32_bf16(a1, qf1, z, 0, 0, 0);
    }
    const int d0 = fq * 4 - fr;
    float mx = sink;
#pragma unroll
    for (int k9 = 0; k9 < 9; ++k9) { const bool tile_ok = (n > 0) || (qt + k9 >= 8);
#pragma unroll
        for (int j = 0; j < 4; ++j) { bool vis = tile_ok;
            if (k9 == 0) vis = vis && (d0 + j > 0);
            if (k9 == 8) vis = vis && (d0 + j <= 0);
            s[k9][j] = vis ? s[k9][j] : -INFINITY; mx = fmaxf(mx, s[k9][j]); } }
    mx = fmaxf(mx, __shfl_xor(mx, 16)); mx = fmaxf(mx, __shfl_xor(mx, 32));
    float l = 0.f;
#pragma unroll
    for (int k9 = 0; k9 < 9; ++k9)
#pragma unroll
        for (int j = 0; j < 4; ++j) { const float e = __expf(s[k9][j] - mx); s[k9][j] = e; l += e; }
    l += __shfl_xor(l, 16); l += __shfl_xor(l, 32);
    l += __expf(sink - mx);
    const float inv_l = fast_rcp(l);
    bf16x8 pf[5];
#pragma unroll
    for (int pp = 0; pp < 4; ++pp) pf[pp] = mk8(cvt_pk_bf16(s[2 * pp][0], s[2 * pp][1]), cvt_pk_bf16(s[2 * pp][2], s[2 * pp][3]), cvt_pk_bf16(s[2 * pp + 1][0], s[2 * pp + 1][1]), cvt_pk_bf16(s[2 * pp + 1][2], s[2 * pp + 1][3]));
    pf[4] = mk8(cvt_pk_bf16(s[8][0], s[8][1]), cvt_pk_bf16(s[8][2], s[8][3]), 0u, 0u);
#pragma unroll
    for (int nt = 0; nt < 4; ++nt) { f32x4 o = {0.f, 0.f, 0.f, 0.f};
        const bf16_t* vr = Vt + (nt * 16 + fr) * VT_STRIDE + fq * 4;
#pragma unroll
        for (int pp = 0; pp < 5; ++pp) { const int kta = qt + 2 * pp, ktb = (kta + 1 > 15) ? 15 : kta + 1;
            const u32x2 lo = *(const u32x2*)(vr + kta * 16), hi = *(const u32x2*)(vr + ktb * 16);
            o = __builtin_amdgcn_mfma_f32_16x16x32_bf16(mk8(lo.x, lo.y, hi.x, hi.y), pf[pp], o, 0, 0, 0); }
        const u32x2 gt = gtv[nt];
        u32x2 w; w.x = cvt_pk_bf16(o[0] * inv_l * bflo(gt.x), o[1] * inv_l * bfhi(gt.x)); w.y = cvt_pk_bf16(o[2] * inv_l * bflo(gt.y), o[3] * inv_l * bfhi(gt.y));
        *(u32x2*)(Aatt + tq * 1024 + hq * 64 + nt * 16 + fq * 4) = w; }
}
__device__ __forceinline__ void attn_phase(const Params& p, unsigned char* shm, int c, int G) {
    const bf16_t* proj = (const bf16_t*)(p.ws + WS_PROJ);
    const f32x2* rope = (const f32x2*)(p.ws + WS_ROPE);
    bf16_t* Aatt = (bf16_t*)(p.ws + WS_AATT);
    bf16_t* Ks = (bf16_t*)shm;
    bf16_t* Vt = (bf16_t*)(shm + 256 * KS_STRIDE * 2);
    const int tid = threadIdx.x, wid = tid >> 6, lane = tid & 63, fr = lane & 15, fq = lane >> 4;
    const int g = wid >> 1, qb = (wid & 1) * 4;
    const int cx = (G == 256) ? ((c & 7) * 32 + (c >> 3)) : c;
    if (cx >= NAU) return;
    AttnStage S; attn_load_stage(proj, rope, cx, tid, S);
#pragma unroll 1
    for (int unit = cx; unit < NAU; unit += G) {
        int kvh, n, tq0; attn_unit_coords(unit, kvh, n, tq0);
        const int hq = kvh * 4 + g; const float sink = p.sinks[hq];
        AttnQ Q0, Q1;
        attn_load_q(proj, rope, (size_t)(tq0 + (qb + 0) * 16 + fr), hq, fq, Q0);
        attn_write_stage(S, rope, tq0 - 128, Ks, Vt, tid);
        __syncthreads();
        attn_load_q(proj, rope, (size_t)(tq0 + (qb + 1) * 16 + fr), hq, fq, Q1);
        attn_qtile(Q0, proj, Ks, Vt, Aatt, (size_t)(tq0 + (qb + 0) * 16 + fr), hq, qb + 0, n, sink, fr, fq);
        attn_load_q(proj, rope, (size_t)(tq0 + (qb + 2) * 16 + fr), hq, fq, Q0);
        attn_qtile(Q1, proj, Ks, Vt, Aatt, (size_t)(tq0 + (qb + 1) * 16 + fr), hq, qb + 1, n, sink, fr, fq);
        attn_load_q(proj, rope, (size_t)(tq0 + (qb + 3) * 16 + fr), hq, fq, Q1);
        attn_qtile(Q0, proj, Ks, Vt, Aatt, (size_t)(tq0 + (qb + 2) * 16 + fr), hq, qb + 2, n, sink, fr, fq);
        if (unit + G < NAU) attn_load_stage(proj, rope, unit + G, tid, S);
        attn_qtile(Q1, proj, Ks, Vt, Aatt, (size_t)(tq0 + (qb + 3) * 16 + fr), hq, qb + 3, n, sink, fr, fq);
        __syncthreads();
    }
}

constexpr int H_STRIDE64 = 72;
constexpr int H_STRIDE128 = 136;
constexpr int SCN = 16;
constexpr int NSC = NT / (64 * SCN);
constexpr int NSU = NB * 8 * NSC;
struct HgrnRaw { unsigned hf[16]; unsigned hi[16]; };
__device__ __forceinline__ void hgrn_load_raw(const bf16_t* proj, size_t rc, int h, int d, int seg, HgrnRaw& R) {
    const bf16_t* bp = proj + (rc + seg * 16) * INW + h * 128 + d;
#pragma unroll
    for (int i = 0; i < 16; ++i) { R.hf[i] = bp[(size_t)i * INW + OHF]; R.hi[i] = bp[(size_t)i * INW + OHI]; }
}
__device__ __forceinline__ void hgrn_gates(const HgrnRaw& R, float lb, float (&bp)[16], float (&kk)[16]) {
    float run = 1.0f;
#pragma unroll
    for (int i = 0; i < 16; ++i) {
        const float hf = __uint_as_float(R.hf[i] << 16);
        const float e = __expf(-hf), inv = fast_rcp(1.0f + e);
        const float f = lb + (1.0f - lb) * inv;
        kk[i] = (1.0f - lb) * e * inv;
        run *= f; bp[i] = run;
    }
}
__device__ __forceinline__ void hgrn_store_vt(const HgrnRaw& R, bf16_t* Vt, int d, int seg) {
    unsigned w[8];
#pragma unroll
    for (int i = 0; i < 8; ++i) w[i] = R.hi[2 * i] | (R.hi[2 * i + 1] << 16);
    bf16_t* vd = Vt + d * H_STRIDE64 + seg * 16; *(u32x4*)vd = (u32x4){w[0], w[1], w[2], w[3]}; *(u32x4*)(vd + 8) = (u32x4){w[4], w[5], w[6], w[7]};
}

__device__ __forceinline__ void hgrn_local_unit(const Params& p, unsigned char* shm, int u) {
    const bf16_t* proj = (const bf16_t*)(p.ws + WS_PROJ);
    float* UT = p.out + (size_t)u * 16384; float* dtot = (float*)(p.ws + WS_DTOT) + (size_t)u * 128;
    bf16_t* KdT = (bf16_t*)shm;
    bf16_t* Vt = (bf16_t*)(shm + 128 * H_STRIDE64 * 2);
    float* segsum = (float*)(shm + 2 * 128 * H_STRIDE64 * 2);
    float* dsh = segsum + 512;
    const int tid = threadIdx.x, wid = tid >> 6, lane = tid & 63, fr = lane & 15, fq = lane >> 4;
    const int sc = u % NSC, sq = u / NSC, h = sq & 7, b = sq >> 3; const size_t r0 = (size_t)b * NT + (size_t)sc * (64 * SCN);
    const int d = tid & 127, seg = tid >> 7;
    const float lb = fast_rcp(1.0f + __expf(p.lbt[1024 + h * 128 + d] - p.lbt[h * 128 + d]));
    f32x4 acc[8];
#pragma unroll
    for (int vt = 0; vt < 8; ++vt) acc[vt] = (f32x4){0.f, 0.f, 0.f, 0.f};
    float bsum = 1.0f;
    HgrnRaw R; hgrn_load_raw(proj, r0, h, d, seg, R);
#pragma unroll 1
    for (int cc = 0; cc < SCN; ++cc) {
        float bp[16], kk[16];
        hgrn_gates(R, lb, bp, kk);
        segsum[seg * 128 + d] = bp[15];
        hgrn_store_vt(R, Vt, d, seg);
        if (cc < SCN - 1) hgrn_load_raw(proj, r0 + (size_t)(cc + 1) * 64, h, d, seg, R);
        __syncthreads();
        float off = 1.0f, btot = 1.0f;
#pragma unroll
        for (int s2 = 0; s2 < 4; ++s2) { const float v = segsum[s2 * 128 + d]; btot *= v; if (s2 < seg) off *= v; }
        { unsigned w[8];
#pragma unroll
          for (int i = 0; i < 8; ++i) { const float k0 = kk[2 * i] * btot * fast_rcp(off * bp[2 * i]), k1 = kk[2 * i + 1] * btot * fast_rcp(off * bp[2 * i + 1]); w[i] = cvt_pk_bf16(k0, k1); }
          bf16_t* kd = KdT + d * H_STRIDE64 + seg * 16; *(u32x4*)kd = (u32x4){w[0], w[1], w[2], w[3]}; *(u32x4*)(kd + 8) = (u32x4){w[4], w[5], w[6], w[7]}; }
        if (seg == 0) dsh[d] = btot;
        bsum *= btot;
        __syncthreads();
        const f32x4 dv = *(const f32x4*)(dsh + 16 * wid + fq * 4);
#pragma unroll
        for (int vt = 0; vt < 8; ++vt) acc[vt] *= dv;
#pragma unroll
        for (int ks = 0; ks < 2; ++ks) { const bf16x8 a = *(const bf16x8*)(KdT + (16 * wid + fr) * H_STRIDE64 + ks * 32 + fq * 8);
#pragma unroll
            for (int vt = 0; vt < 8; ++vt) { const bf16x8 bv = *(const bf16x8*)(Vt + (16 * vt + fr) * H_STRIDE64 + ks * 32 + fq * 8);
                acc[vt] = __builtin_amdgcn_mfma_f32_16x16x32_bf16(a, bv, acc[vt], 0, 0, 0); } }
        __syncthreads();
    }
#pragma unroll
    for (int vt = 0; vt < 8; ++vt) *(f32x4*)(UT + (size_t)(16 * vt + fr) * 128 + 16 * wid + fq * 4) = acc[vt];
    if (seg == 0) dtot[d] = bsum;
}

__device__ __forceinline__ void hgrn_scan(const Params& p) {
    const float* dtot = (const float*)(p.ws + WS_DTOT);
    for (int gidx = blockIdx.x * 512 + threadIdx.x; gidx < 16 * 8192; gidx += gridDim.x * 512) {
        const int sq = gidx >> 13, e = (gidx & 8191) * 2, d = e & 127;
        float* base = p.out + (size_t)sq * NSC * 16384 + e; const float* db = dtot + (size_t)sq * NSC * 128 + d;
        f32x2 S = {0.f, 0.f};
        for (int c0 = 0; c0 < NSC; c0 += 8) {
            f32x2 U[8], D[8];
#pragma unroll
            for (int i = 0; i < 8; ++i) { U[i] = *(const f32x2*)(base + (size_t)(c0 + i) * 16384); D[i] = *(const f32x2*)(db + (size_t)(c0 + i) * 128); }
#pragma unroll
            for (int i = 0; i < 8; ++i) { *(f32x2*)(base + (size_t)(c0 + i) * 16384) = S; S = D[i] * S + U[i]; }
        }
    }
}

__device__ __forceinline__ void hgrn_out_unit(const Params& p, unsigned char* shm, int u) {
    const bf16_t* proj = (const bf16_t*)(p.ws + WS_PROJ);
    const float* ST = p.out + (size_t)u * 16384;
    bf16_t* Ahg = (bf16_t*)(p.ws + WS_AHGR);
    bf16_t* Qs = (bf16_t*)shm;
    bf16_t* Ks2 = (bf16_t*)(shm + 17408);
    bf16_t* Vt = (bf16_t*)(shm + 34816);
    bf16_t* KdT = (bf16_t*)(shm + 53248);
    bf16_t* St = (bf16_t*)(shm + 71680);
    float* segsum = (float*)(shm + 106496);
    float* eref = segsum + 512;
    float* dsh = eref + 128;
    float* part = dsh + 128;
    const int tid = threadIdx.x, wid = tid >> 6, lane = tid & 63, fr = lane & 15, fq = lane >> 4;
    const int sc = u % NSC, sq = u / NSC, h = sq & 7, b = sq >> 3; const size_t r0 = (size_t)b * NT + (size_t)sc * (64 * SCN);
    const int d = tid & 127, seg = tid >> 7;
    const int tt = wid & 3, vh = wid >> 2;
    const float lb = fast_rcp(1.0f + __expf(p.lbt[1024 + h * 128 + d] - p.lbt[h * 128 + d]));
    f32x4 acc[8];
#pragma unroll
    for (int vt = 0; vt < 8; ++vt) acc[vt] = *(const f32x4*)(ST + (size_t)(16 * vt + fr) * 128 + 16 * wid + fq * 4);
    f32x4 gn[4];
#pragma unroll
    for (int vt = 0; vt < 4; ++vt) gn[vt] = *(const f32x4*)(p.hgain + h * 128 + 16 * (vh * 4 + vt) + fq * 4);
    HgrnRaw R; hgrn_load_raw(proj, r0, h, d, seg, R);
    unsigned hq[16];
#pragma unroll
    for (int i = 0; i < 16; ++i) hq[i] = proj[(r0 + seg * 16 + i) * INW + OHQ + h * 128 + d];
#pragma unroll 1
    for (int cc = 0; cc < SCN; ++cc) {
        const size_t rc = r0 + (size_t)cc * 64;
        float bp[16], kk[16];
        hgrn_gates(R, lb, bp, kk);
        segsum[seg * 128 + d] = bp[15];
        hgrn_store_vt(R, Vt, d, seg);
        __syncthreads();
        float off = 1.0f, btot = 1.0f;
#pragma unroll
        for (int s2 = 0; s2 < 4; ++s2) { const float v = segsum[s2 * 128 + d]; btot *= v; if (s2 < seg) off *= v; }
        const float bref = segsum[d] * segsum[128 + d];
        if (seg == 0) dsh[d] = btot;
        const float rref = fast_rcp(bref), etail = btot * rref;
        { float kdv[16];
#pragma unroll
          for (int i = 0; i < 16; ++i) { const float cp = off * bp[i]; const int t = seg * 16 + i;
              const float qv = __uint_as_float(hq[i] << 16);
              const float kt = kk[i] * bref * fast_rcp(cp); kdv[i] = kt * etail;
              const unsigned qk = cvt_pk_bf16(qv * cp * rref, kt);
              Qs[t * H_STRIDE128 + d] = (bf16_t)(qk & 0xffffu); Ks2[t * H_STRIDE128 + d] = (bf16_t)(qk >> 16); }
          unsigned w[8];
#pragma unroll
          for (int i = 0; i < 8; ++i) w[i] = cvt_pk_bf16(kdv[2 * i], kdv[2 * i + 1]);
          bf16_t* kd = KdT + d * H_STRIDE64 + seg * 16; *(u32x4*)kd = (u32x4){w[0], w[1], w[2], w[3]}; *(u32x4*)(kd + 8) = (u32x4){w[4], w[5], w[6], w[7]}; }
        if (cc < SCN - 1) { hgrn_load_raw(proj, rc + 64, h, d, seg, R);
#pragma unroll
            for (int i = 0; i < 16; ++i) hq[i] = proj[(rc + 64 + seg * 16 + i) * INW + OHQ + h * 128 + d]; }
        const size_t r = rc + 16 * tt + fr;
        u32x2 gt[4];
#pragma unroll
        for (int vt = 0; vt < 4; ++vt) gt[vt] = *(const u32x2*)(proj + r * INW + OHG + h * 128 + 16 * (vh * 4 + vt) + fq * 4);
        { const f32x4 s0 = *(const f32x4*)(segsum + 16 * wid + fq * 4), s1 = *(const f32x4*)(segsum + 128 + 16 * wid + fq * 4); const f32x4 er = s0 * s1;
#pragma unroll
          for (int vt = 0; vt < 8; ++vt) { const f32x4 sv = acc[vt] * er; u32x2 w; w.x = cvt_pk_bf16(sv[0], sv[1]); w.y = cvt_pk_bf16(sv[2], sv[3]);
              *(u32x2*)(St + (16 * vt + fr) * H_STRIDE128 + 16 * wid + fq * 4) = w; } }
        __syncthreads();
        bf16x8 bq[4];
#pragma unroll
        for (int ks = 0; ks < 4; ++ks) bq[ks] = *(const bf16x8*)(Qs + (16 * tt + fr) * H_STRIDE128 + ks * 32 + fq * 8);
        f32x4 pa[4];
#pragma unroll
        for (int st = 0; st < 4; ++st) { pa[st] = (f32x4){0.f, 0.f, 0.f, 0.f};
            if (st <= tt) {
#pragma unroll
                for (int ks = 0; ks < 4; ++ks) { const bf16x8 a = *(const bf16x8*)(Ks2 + (16 * st + fr) * H_STRIDE128 + ks * 32 + fq * 8);
                    pa[st] = __builtin_amdgcn_mfma_f32_16x16x32_bf16(a, bq[ks], pa[st], 0, 0, 0); }
#pragma unroll
                for (int j = 0; j < 4; ++j) { const int s_ = 16 * st + fq * 4 + j, t_ = 16 * tt + fr; pa[st][j] = (s_ <= t_) ? pa[st][j] : 0.f; }
            } }
        bf16x8 pf[2];
#pragma unroll
        for (int pp = 0; pp < 2; ++pp) pf[pp] = mk8(cvt_pk_bf16(pa[2 * pp][0], pa[2 * pp][1]), cvt_pk_bf16(pa[2 * pp][2], pa[2 * pp][3]), cvt_pk_bf16(pa[2 * pp + 1][0], pa[2 * pp + 1][1]), cvt_pk_bf16(pa[2 * pp + 1][2], pa[2 * pp + 1][3]));
        f32x4 o[4]; float ss = 0.f;
#pragma unroll
        for (int vt = 0; vt < 4; ++vt) { const int vrow = 16 * (vh * 4 + vt) + fr; o[vt] = (f32x4){0.f, 0.f, 0.f, 0.f};
#pragma unroll
            for (int pp = 0; pp < 2; ++pp) { const u32x2 lo = *(const u32x2*)(Vt + vrow * H_STRIDE64 + (2 * pp) * 16 + fq * 4), hi = *(const u32x2*)(Vt + vrow * H_STRIDE64 + (2 * pp + 1) * 16 + fq * 4);
                o[vt] = __builtin_amdgcn_mfma_f32_16x16x32_bf16(mk8(lo.x, lo.y, hi.x, hi.y), pf[pp], o[vt], 0, 0, 0); }
#pragma unroll
            for (int ks = 0; ks < 4; ++ks) { const bf16x8 a = *(const bf16x8*)(St + vrow * H_STRIDE128 + ks * 32 + fq * 8);
                o[vt] = __builtin_amdgcn_mfma_f32_16x16x32_bf16(a, bq[ks], o[vt], 0, 0, 0); }
            ss += o[vt][0] * o[vt][0] + o[vt][1] * o[vt][1] + o[vt][2] * o[vt][2] + o[vt][3] * o[vt][3]; }
        ss += __shfl_xor(ss, 16); ss += __shfl_xor(ss, 32);
        if (fq == 0) part[vh * 64 + 16 * tt + fr] = ss;
        if (cc < SCN - 1) {
            const f32x4 dv = *(const f32x4*)(dsh + 16 * wid + fq * 4);
#pragma unroll
            for (int vt = 0; vt < 8; ++vt) acc[vt] *= dv;
#pragma unroll
            for (int ks = 0; ks < 2; ++ks) { const bf16x8 a = *(const bf16x8*)(KdT + (16 * wid + fr) * H_STRIDE64 + ks * 32 + fq * 8);
#pragma unroll
                for (int vt = 0; vt < 8; ++vt) { const bf16x8 bv = *(const bf16x8*)(Vt + (16 * vt + fr) * H_STRIDE64 + ks * 32 + fq * 8);
                    acc[vt] = __builtin_amdgcn_mfma_f32_16x16x32_bf16(a, bv, acc[vt], 0, 0, 0); } }
        }
        __syncthreads();
        const float tot = part[16 * tt + fr] + part[64 + 16 * tt + fr];
        const float rstd = rsqrtf(tot * (1.0f / 128.0f) + 1e-6f);
#pragma unroll
        for (int vt = 0; vt < 4; ++vt) { const int col = h * 128 + 16 * (vh * 4 + vt) + fq * 4;
            u32x2 w; w.x = cvt_pk_bf16(o[vt][0] * rstd * gn[vt][0] * bflo(gt[vt].x), o[vt][1] * rstd * gn[vt][1] * bfhi(gt[vt].x)); w.y = cvt_pk_bf16(o[vt][2] * rstd * gn[vt][2] * bflo(gt[vt].y), o[vt][3] * rstd * gn[vt][3] * bfhi(gt[vt].y));
            *(u32x2*)(Ahg + r * 1024 + col) = w; }
    }
}

__device__ __forceinline__ void phase_final(const Params& p) {
    const int tid = threadIdx.x, wid = tid >> 6, lane = tid & 63;
    const bf16_t* yb = (const bf16_t*)(p.ws + WS_AATT);
    for (int r = blockIdx.x * 8 + wid; r < NTOK; r += gridDim.x * 8) {
        const float* xr = p.x + (size_t)r * DM;
        f32x4 v[8]; float ss = 0.f;
#pragma unroll
        for (int i = 0; i < 4; ++i) { const int c0 = (lane + 64 * i) * 8;
            const u32x4 yv = __builtin_nontemporal_load((const u32x4*)(yb + (size_t)r * DM + c0));
            const f32x4 x0 = __builtin_nontemporal_load((const f32x4*)(xr + c0)), x1 = __builtin_nontemporal_load((const f32x4*)(xr + c0 + 4));
            f32x4 a, b; a[0] = x0[0] + bflo(yv.x); a[1] = x0[1] + bfhi(yv.x); a[2] = x0[2] + bflo(yv.y); a[3] = x0[3] + bfhi(yv.y);
            b[0] = x1[0] + bflo(yv.z); b[1] = x1[1] + bfhi(yv.z); b[2] = x1[2] + bflo(yv.w); b[3] = x1[3] + bfhi(yv.w);
            ss += a[0] * a[0] + a[1] * a[1] + a[2] * a[2] + a[3] * a[3] + b[0] * b[0] + b[1] * b[1] + b[2] * b[2] + b[3] * b[3];
            v[2 * i] = a; v[2 * i + 1] = b; }
        ss = wave_sum(ss);
        const float rstd = rsqrtf(ss * (1.0f / DM) + 1e-6f);
        float* orow = p.out + (size_t)r * DM;
#pragma unroll
        for (int i = 0; i < 4; ++i) { const int c0 = (lane + 64 * i) * 8;
            const f32x4 g0 = *(const f32x4*)(p.fgain + c0), g1 = *(const f32x4*)(p.fgain + c0 + 4);
            f32x4 a = v[2 * i], b = v[2 * i + 1];
            a[0] = a[0] * rstd * g0[0]; a[1] = a[1] * rstd * g0[1]; a[2] = a[2] * rstd * g0[2]; a[3] = a[3] * rstd * g0[3];
            b[0] = b[0] * rstd * g1[0]; b[1] = b[1] * rstd * g1[1]; b[2] = b[2] * rstd * g1[2]; b[3] = b[3] * rstd * g1[3];
            __builtin_nontemporal_store(a, (f32x4*)(orow + c0)); __builtin_nontemporal_store(b, (f32x4*)(orow + c0 + 4)); }
    }
}

#define XB_TMO      128
#define XB_XCNT(j)  (256  + 64 * (j))
#define XB_XSUB(j)  (1280 + 64 * (j))
#define XB_XGEN(j)  (2304 + 64 * (j))
#define XB_TOP      3328
#define XB_TOPGEN   3392
#define XCD_BAR_WORDS 3456
#define XB_SPIN_CAP (1u << 18)
__device__ __forceinline__ unsigned xb_ld(unsigned* p)              { return __hip_atomic_load(p, __ATOMIC_RELAXED, __HIP_MEMORY_SCOPE_AGENT); }
__device__ __forceinline__ unsigned xb_add(unsigned* p, unsigned v) { return __hip_atomic_fetch_add(p, v, __ATOMIC_RELAXED, __HIP_MEMORY_SCOPE_AGENT); }
__device__ __forceinline__ unsigned xb_xcc_id() { return (unsigned)__builtin_amdgcn_s_getreg((3 << 11) | 20) & 0xFu; }
#define XB_SPIN(cond, bar) do { unsigned _sp = 0; while (cond) { __builtin_amdgcn_s_sleep(1); \
    if ((++_sp & 255u) == 0u) { if (xb_ld(&(bar)[XB_TMO])) break; if (_sp > XB_SPIN_CAP) { atomicAdd(&(bar)[XB_TMO], 1u); break; } } } } while (0)
struct XcdBarrier { unsigned* bar; unsigned x; volatile LAS unsigned* st; };
__device__ __forceinline__ XcdBarrier xcd_barrier_post(unsigned* bar, volatile LAS unsigned* st) {
    XcdBarrier b; b.bar = bar; b.x = xb_xcc_id(); b.st = st;
    if (threadIdx.x == 0) (void)xb_add(&bar[XB_XCNT(b.x)], 1u);
    return b;
}
__device__ __forceinline__ void xcd_barrier_complete(unsigned* bar, unsigned x, unsigned& nloc, unsigned& nx) {
    const unsigned G = gridDim.x * gridDim.y * gridDim.z;
    unsigned sum, cnt, mine, sp = 0u;
    for (;;) {
        sum = 0u; cnt = 0u; mine = 0u;
#pragma unroll
        for (unsigned j = 0; j < 16; ++j) { const unsigned c = xb_ld(&bar[XB_XCNT(j)]); sum += c; cnt += (c > 0u) ? 1u : 0u; mine = (j == x) ? c : mine; }
        if (sum == G) break;
        __builtin_amdgcn_s_sleep(1);
        if ((++sp & 255u) == 0u) { if (xb_ld(&bar[XB_TMO])) break; if (sp > XB_SPIN_CAP) { atomicAdd(&bar[XB_TMO], 1u); break; } }
    }
    nloc = mine > 0u ? mine : 1u; nx = cnt > 0u ? cnt : 1u;
}
__device__ __forceinline__ void xcd_barrier(const XcdBarrier& b) {
    asm volatile("s_waitcnt vmcnt(0)" ::: "memory");
    __syncthreads();
    if (threadIdx.x == 0) {
        unsigned* bar = b.bar;
        __builtin_amdgcn_s_waitcnt(0);
        unsigned nloc = b.st[0], nx = b.st[1];
        if (nloc == 0u) { xcd_barrier_complete(bar, b.x, nloc, nx); b.st[0] = nloc; b.st[1] = nx; }
        const unsigned old = xb_add(&bar[XB_XSUB(b.x)], 1u);
        const unsigned gen = old / nloc;
        if (old + 1u == (gen + 1u) * nloc) {
            __builtin_amdgcn_fence(__ATOMIC_RELEASE, "agent");
            asm volatile("s_waitcnt vmcnt(0)" ::: "memory");
            const unsigned og = xb_add(&bar[XB_TOP], 1u);
            const unsigned tg = og / nx;
            if (og + 1u == (tg + 1u) * nx) xb_add(&bar[XB_TOPGEN], 1u);
            else XB_SPIN(xb_ld(&bar[XB_TOPGEN]) == tg, bar);
            __builtin_amdgcn_fence(__ATOMIC_ACQUIRE, "agent");
            xb_add(&bar[XB_XGEN(b.x)], 1u);
            asm volatile("s_waitcnt vmcnt(0)" ::: "memory");
        } else {
            XB_SPIN(xb_ld(&bar[XB_XGEN(b.x)]) == gen, bar);
            __builtin_amdgcn_fence(__ATOMIC_ACQUIRE, "agent");
            asm volatile("s_waitcnt vmcnt(0)" ::: "memory");
        }
    }
    __syncthreads();
}

__device__ __forceinline__ void stagger_us(int us) {
    if (us <= 0) return;
    const unsigned long long t0 = __builtin_amdgcn_s_memrealtime();
    while (__builtin_amdgcn_s_memrealtime() - t0 < (unsigned long long)us * 100ull) __builtin_amdgcn_s_sleep(8);
}
#define STAG1 0
#define STAG5 0
#define STAG6 0
#define REP0 1
#define REPS 0
#define REP1 1
#define REP2 1
#define REPA 1
#define REP4 1
#define REP5 1
#define REP6 1
__global__ void __launch_bounds__(512, 2) fwd_megakernel(Params p) {
    extern __shared__ __attribute__((aligned(16))) unsigned char shm[];
    cg::grid_group grid = cg::this_grid();
    const int G = (int)gridDim.x, c = (int)blockIdx.x;
    volatile LAS unsigned* xst = (volatile LAS unsigned*)((LAS unsigned char*)shm + pg8::STAGE_BYTES);
    if (threadIdx.x == 0) { xst[0] = 0u; xst[1] = 0u; xst[2] = 0u; xst[3] = 0u; }
    __syncthreads();
    const XcdBarrier xb = xcd_barrier_post((unsigned*)(p.ws + WS_BAR), xst);
    for (int rep = 0; rep < REP0; ++rep) phase_prep(p, shm);
    if (p.ws == nullptr) grid.sync();
    xcd_barrier(xb);
    for (int rep = 0; rep < REPS; ++rep) xcd_barrier(xb);
    { pg8::Gemm g; g.A0 = (const bf16_t*)(p.ws + WS_HA); g.B0 = (const bf16_t*)(p.ws + WS_WIN); g.A1 = g.A0; g.B1 = g.B0; g.M = NTOK; g.N = INW; g.K = DM;
      stagger_us(((c >> 3) & 3) * STAG1);
      pg8::StaticOrder S; S.init(NTOK, INW, G, c, 0, REP1); EpiProj E; E.O = (bf16_t*)(p.ws + WS_PROJ);
      pg8::gemm_phase<EpiProj>((LAS unsigned char*)shm, g, S, E); }
    xcd_barrier(xb);
    for (int rep = 0; rep < REPA; ++rep) attn_phase(p, shm, c, G);
    for (int rep = 0; rep < REP2; ++rep) for (int u = c; u < NSU; u += G) hgrn_local_unit(p, shm, u);
    xcd_barrier(xb);
    hgrn_scan(p);
    xcd_barrier(xb);
    for (int rep = 0; rep < REP4; ++rep) for (int u = c; u < NSU; u += G) hgrn_out_unit(p, shm, u);
    xcd_barrier(xb);
    { pg8::Gemm g; g.A0 = (const bf16_t*)(p.ws + WS_AATT); g.B0 = (const bf16_t*)(p.ws + WS_WAO); g.A1 = (const bf16_t*)(p.ws + WS_AHGR); g.B1 = (const bf16_t*)(p.ws + WS_WHO); g.M = NTOK; g.N = DM; g.K = 1024;
      stagger_us(((c >> 3) & 3) * STAG5);
      pg8::StaticOrder S; S.init(NTOK, DM, G, c, 1, REP5); EpiMerge E; E.proj = (const bf16_t*)(p.ws + WS_PROJ); E.O = (bf16_t*)(p.ws + WS_HA);
      pg8::gemm_phase<EpiMerge>((LAS unsigned char*)shm, g, S, E); }
    xcd_barrier(xb);
    { pg8::Gemm g; g.A0 = (const bf16_t*)(p.ws + WS_HA); g.B0 = (const bf16_t*)(p.ws + WS_WO); g.A1 = g.A0; g.B1 = g.B0; g.M = NTOK; g.N = DM; g.K = DM;
      stagger_us(((c >> 3) & 3) * STAG6);
      pg8::StaticOrder S; S.init(NTOK, DM, G, c, 0, REP6); EpiY E; E.O = (bf16_t*)(p.ws + WS_AATT);
      pg8::gemm_phase<EpiY>((LAS unsigned char*)shm, g, S, E); }
    xcd_barrier(xb);
    phase_final(p);
}

extern "C" void kernel_launch(void* const* d_in, const int* in_sizes, int n_in, void* d_out, int out_size, void* d_ws, size_t ws_size, hipStream_t stream) {
    constexpr size_t kDynLds = pg8::STAGE_BYTES + 16;
    static int grid_blocks = 0;
    if (grid_blocks == 0) {
        if (ws_size < WS_END) { fprintf(stderr, "kernel_launch: workspace too small: %zu < %zu\n", ws_size, (size_t)WS_END); grid_blocks = -1; return; }
        int dev = 0, cus = 0, per_cu = 0;
        (void)hipGetDevice(&dev);
        (void)hipDeviceGetAttribute(&cus, hipDeviceAttributeMultiprocessorCount, dev);
        if (hipFuncSetAttribute((const void*)fwd_megakernel, hipFuncAttributeMaxDynamicSharedMemorySize, (int)kDynLds) != hipSuccess) { fprintf(stderr, "kernel_launch: hipFuncSetAttribute failed\n"); grid_blocks = -1; return; }
        if (hipOccupancyMaxActiveBlocksPerMultiprocessor(&per_cu, (const void*)fwd_megakernel, 512, kDynLds) != hipSuccess || per_cu < 1) { fprintf(stderr, "kernel_launch: occupancy query failed (%d)\n", per_cu); (void)hipGetLastError(); grid_blocks = -1; return; }
        if (per_cu > 1) per_cu = 1;
        grid_blocks = cus * per_cu;
    }
    if (grid_blocks < 0) return;
    Params p{};
    p.x = (const float*)d_in[0]; p.pos = (const int*)d_in[1]; p.norm_gain = (const float*)d_in[2]; p.w_in = (const float*)d_in[3]; p.sinks = (const float*)d_in[4];
    p.lbt = (const float*)d_in[5]; p.hgain = (const float*)d_in[6]; p.w_ao = (const float*)d_in[7]; p.w_ho = (const float*)d_in[8]; p.w_o = (const float*)d_in[9];
    p.fgain = (const float*)d_in[10]; p.out = (float*)d_out; p.ws = (unsigned char*)d_ws;
    if (hipMemsetAsync((unsigned char*)d_ws + WS_BAR, 0, XCD_BAR_WORDS * 4, stream) != hipSuccess) { fprintf(stderr, "kernel_launch: memset of the barrier words failed\n"); return; }
    void* args[] = {&p};
    hipError_t e = hipLaunchCooperativeKernel((const void*)fwd_megakernel, dim3(grid_blocks), dim3(512), args, kDynLds, stream);
    if (e != hipSuccess) fprintf(stderr, "cooperative launch failed: %s (grid %d)\n", hipGetErrorString(e), grid_blocks);
}
```

```cpp
#include <hip/hip_runtime.h>
#include <hip/hip_cooperative_groups.h>
#include <cstdio>
namespace cg = cooperative_groups;

#define LAS __attribute__((address_space(3)))
typedef unsigned short bf16_t;
typedef short bf16x8 __attribute__((ext_vector_type(8)));
typedef float f32x4 __attribute__((ext_vector_type(4)));
typedef float f32x2 __attribute__((ext_vector_type(2)));
typedef unsigned u32x4 __attribute__((ext_vector_type(4)));
typedef unsigned u32x2 __attribute__((ext_vector_type(2)));

constexpr int NB = 2, NT = 16384, NTOK = NB * NT, DM = 2048, INW = 10752;
constexpr int OQ = 0, OKK = 1024, OV = 1280, OAG = 1536, OHQ = 2560, OHF = 3584, OHI = 4608, OHG = 5632, OMA = 6656, OMH = 8704;
constexpr int NCHUNK = NT / 64;
constexpr int NHU = NB * 8 * NCHUNK;
constexpr int NAU = NB * (NT / 128) * 4;

constexpr size_t WS_HA = 0;
constexpr size_t WS_WIN = WS_HA + (size_t)NTOK * DM * 2;
constexpr size_t WS_WAO = WS_WIN + (size_t)INW * DM * 2;
constexpr size_t WS_WHO = WS_WAO + (size_t)DM * 1024 * 2;
constexpr size_t WS_WO = WS_WHO + (size_t)DM * 1024 * 2;
constexpr size_t WS_PROJ = WS_WO + (size_t)DM * DM * 2;
constexpr size_t WS_ROPE = WS_PROJ + (size_t)NTOK * INW * 2;
constexpr size_t WS_AATT = WS_ROPE + (size_t)NTOK * 32 * 8;
constexpr size_t WS_AHGR = WS_AATT + (size_t)NTOK * 1024 * 2;
constexpr size_t WS_DTOT = WS_AHGR + (size_t)NTOK * 1024 * 2;
constexpr size_t WS_RSS = WS_DTOT + (size_t)NHU * 128 * 4;
constexpr size_t WS_END = WS_RSS + (size_t)NTOK * 32 * 4;
constexpr size_t WS_BAR = WS_RSS;

struct Params {
    const float* x; const int* pos; const float* norm_gain; const float* w_in; const float* sinks; const float* lbt;
    const float* hgain; const float* w_ao; const float* w_ho; const float* w_o; const float* fgain;
    float* out; unsigned char* ws;
};

__constant__ float c_inv_freq[32] = {
    1.0f, 0.749894261f, 0.562341332f, 0.421696514f, 0.316227764f, 0.237137377f, 0.177827939f, 0.133352131f, 0.100000001f, 0.0749894157f,
    0.0562341325f, 0.0421696529f, 0.0316227749f, 0.0237137377f, 0.0177827943f, 0.0133352149f, 0.00999999978f, 0.00749894185f,
    0.00562341325f, 0.00421696482f, 0.00316227763f, 0.00237137359f, 0.00177827943f, 0.00133352145f, 0.00100000005f, 0.000749894243f,
    0.000562341302f, 0.000421696517f, 0.000316227757f, 0.00023713737f, 0.00017782794f, 0.00013335215f};

__device__ __forceinline__ float bf2f(bf16_t b) { return __uint_as_float(((unsigned)b) << 16); }
__device__ __forceinline__ float bflo(unsigned w) { return __uint_as_float(w << 16); }
__device__ __forceinline__ float bfhi(unsigned w) { return __uint_as_float(w & 0xffff0000u); }
__device__ __forceinline__ unsigned cvt_pk_bf16(float lo, float hi) { unsigned r; asm volatile("v_cvt_pk_bf16_f32 %0, %1, %2" : "=v"(r) : "v"(lo), "v"(hi)); return r; }
__device__ __forceinline__ float fast_rcp(float x) { return __builtin_amdgcn_rcpf(x); }
__device__ __forceinline__ float sigmoidf_(float v) { return fast_rcp(1.0f + __expf(-v)); }
__device__ __forceinline__ float wave_sum(float v) {
#pragma unroll
    for (int o = 32; o > 0; o >>= 1) v += __shfl_xor(v, o);
    return v;
}
__device__ __forceinline__ bf16x8 mk8(unsigned a, unsigned b, unsigned c, unsigned d) { u32x4 w; w.x = a; w.y = b; w.z = c; w.w = d; return __builtin_bit_cast(bf16x8, w); }

namespace pg8 {
constexpr int BM = 256, BK = 64, HALF = 128, HTB = HALF * BK * 2, STAGE_BYTES = 8 * HTB, NXCD = 8, WGM = 8;
__host__ __device__ __forceinline__ int lds_byte(int r, int c) { const int st = (r >> 4) * 2 + (c >> 5), rr = r & 15, cc = c & 31, ob = rr * 64 + cc * 2; return st * 1024 + (ob ^ (((ob >> 9) & 1) << 5)); }
__host__ __device__ __forceinline__ void stage_rc(int b, int& R, int& C) { const int st = b / 1024, sb = b % 1024, swz = sb ^ (((sb >> 9) & 1) << 5); R = (st >> 1) * 16 + swz / 64; C = (st & 1) * 32 + (swz % 64) / 2; }
__host__ __device__ __forceinline__ int perm32(int rho) { const int n = rho >> 4, i = rho & 15; return 8 * (i >> 2) + 4 * n + (i & 3); }

struct Unit { int pm, pn, kind, rep; };
struct Gemm { const bf16_t* A0; const bf16_t* B0; const bf16_t* A1; const bf16_t* B1; int M, N, K; };

struct StaticOrder {
    int nM, nN, nwg, G, c, dual, R, reps;
    __device__ void init(int M, int N, int G_, int c_, int dual_, int reps_ = 1) { nM = M / BM; nN = N / BM; nwg = nM * nN; G = G_; c = c_; dual = dual_; R = (nwg + G - 1) / G; reps = reps_; }
    __device__ bool next(int i, Unit& u) const {
        if (i >= reps * (R << dual)) return false;
        const int it = (i >> dual) % R;
        const long L = (long)it * G + c; if (L >= nwg) return false;
        int wgid = (int)L; { const int q = nwg / NXCD, r = nwg % NXCD, xcd = wgid % NXCD, off = wgid / NXCD; wgid = (xcd < r ? xcd * (q + 1) : r * (q + 1) + (xcd - r) * q) + off; }
        const int nig = WGM * nN, gid = wgid / nig, fm = gid * WGM, gsz = (nM - fm) < WGM ? (nM - fm) : WGM;
        u.pm = fm + ((wgid % nig) % gsz); u.pn = (wgid % nig) / gsz; u.kind = i & dual; u.rep = (i >> dual) / R; return true;
    }
};

template <class Epi>
__device__ __forceinline__ void gemm_phase(LAS unsigned char* lds, const Gemm g, const StaticOrder& S, const Epi& E) {
    const int tid = threadIdx.x, wid = __builtin_amdgcn_readfirstlane(tid >> 6), lane = tid & 63, wr = wid >> 2, wc = wid & 3, fr = lane & 15, fq = lane >> 4;
    const int K = g.K, nt = K / BK;
    unsigned voffA[2], voffB[2];
#pragma unroll
    for (int i = 0; i < 2; ++i) { int R, C; stage_rc(tid * 16 + i * 8192, R, C); const int Rb = Epi::PERM ? ((R & ~31) + perm32(R & 31)) : R;
        voffA[i] = (unsigned)(R * K + C) * 2u; voffB[i] = (unsigned)(Rb * K + C) * 2u; }
    const size_t kstep = (size_t)(BK * 2);
    const size_t hstep = (size_t)HALF * K * 2;
    const size_t tstep = 2 * hstep;
    const unsigned ldsw = (unsigned)wid * 1024u;
    const int aoff = lds_byte(wr * 64 + fr, fq * 8), boff = lds_byte(wc * 32 + fr, fq * 8);
#define PG8_SA(b, h) (((b) * 2 + (h)) * HTB)
#define PG8_SB(b, h) ((4 + (b) * 2 + (h)) * HTB)
#define PG8_STAGE(bufoff, gbase, voff) do { _Pragma("unroll") for (int _i = 0; _i < 2; ++_i) \
        __builtin_amdgcn_global_load_lds((const unsigned*)((const char*)(gbase) + (voff)[_i]), (LAS unsigned*)(lds + (bufoff) + ldsw + _i * 8192), 16, 0, 0); } while (0)
#define PG8_LDA(dst, b, h) do { _Pragma("unroll") for (int m = 0; m < 4; ++m) _Pragma("unroll") for (int k = 0; k < 2; ++k) dst[m][k] = *(const LAS bf16x8*)(lds + PG8_SA(b, h) + aoff + m * 2048 + k * 1024); } while (0)
#define PG8_LDB(dst, b, h) do { _Pragma("unroll") for (int n = 0; n < 2; ++n) _Pragma("unroll") for (int k = 0; k < 2; ++k) dst[n][k] = *(const LAS bf16x8*)(lds + PG8_SB(b, h) + boff + n * 2048 + k * 1024); } while (0)
#define PG8_MMA(ai, bj, At, Bt) do { __builtin_amdgcn_s_setprio(1); _Pragma("unroll") for (int m = 0; m < 4; ++m) _Pragma("unroll") for (int n = 0; n < 2; ++n) _Pragma("unroll") for (int k = 0; k < 2; ++k) \
        acc[ai][bj][m][n] = __builtin_amdgcn_mfma_f32_16x16x32_bf16(Bt[n][k], At[m][k], acc[ai][bj][m][n], 0, 0, 0); __builtin_amdgcn_s_setprio(0); } while (0)
#define PG8_WAIT_V(n) asm volatile("s_waitcnt vmcnt(" #n ")" ::: "memory")
#define PG8_WAIT_L(n) asm volatile("s_waitcnt lgkmcnt(" #n ")" ::: "memory")
#define PG8_BAR __builtin_amdgcn_s_barrier()
#define PG8_SCHED __builtin_amdgcn_sched_barrier(0)
    Unit cur, nxt; int ui = 0;
    if (!S.next(0, cur)) return;
    f32x4 acc[2][2][4][2];
#pragma unroll
    for (int a = 0; a < 2; ++a)
#pragma unroll
        for (int b = 0; b < 2; ++b)
#pragma unroll
            for (int m = 0; m < 4; ++m)
#pragma unroll
                for (int n = 0; n < 2; ++n) acc[a][b][m][n] = (f32x4){0.f, 0.f, 0.f, 0.f};
    bf16x8 At[4][2], B0[2][2], B1[2][2];
    const char* cA = (const char*)(cur.kind ? g.A1 : g.A0) + (size_t)cur.pm * tstep; const char* cB = (const char*)(cur.kind ? g.B1 : g.B0) + (size_t)cur.pn * tstep;
    PG8_STAGE(PG8_SB(0, 0), cB, voffB); PG8_STAGE(PG8_SA(0, 0), cA, voffA); PG8_STAGE(PG8_SB(0, 1), cB + hstep, voffB); PG8_STAGE(PG8_SA(0, 1), cA + hstep, voffA);
    if (wr == 1) PG8_BAR;
    PG8_WAIT_V(4); PG8_BAR;
    PG8_STAGE(PG8_SB(1, 0), cB + kstep, voffB); PG8_STAGE(PG8_SA(1, 0), cA + kstep, voffA); PG8_STAGE(PG8_SB(1, 1), cB + hstep + kstep, voffB);
    PG8_WAIT_V(6); PG8_BAR;
    for (;;) {
        const bool has_next = S.next(ui + 1, nxt);
        const char* nA = has_next ? (const char*)(nxt.kind ? g.A1 : g.A0) + (size_t)nxt.pm * tstep : cA; const char* nB = has_next ? (const char*)(nxt.kind ? g.B1 : g.B0) + (size_t)nxt.pn * tstep : cB;
        for (int t = 0; t < nt; t += 2) {
            const bool last = (t == nt - 2);
            const char* a1 = cA + (size_t)(t + 1) * kstep;
            const char* a2 = last ? nA : cA + (size_t)(t + 2) * kstep; const char* b2 = last ? nB : cB + (size_t)(t + 2) * kstep;
            const char* a3 = a2 + kstep; const char* b3 = b2 + kstep;
            PG8_LDB(B0, 0, 0); PG8_SCHED; PG8_LDA(At, 0, 0); PG8_STAGE(PG8_SA(1, 1), a1 + hstep, voffA);
            PG8_WAIT_L(8); PG8_BAR; PG8_WAIT_L(0); PG8_MMA(0, 0, At, B0); PG8_BAR; PG8_SCHED;
            PG8_LDB(B1, 0, 1); PG8_STAGE(PG8_SB(0, 0), b2, voffB);
            PG8_BAR; PG8_WAIT_L(0); PG8_MMA(0, 1, At, B1); PG8_BAR;
            PG8_LDA(At, 0, 1); PG8_STAGE(PG8_SA(0, 0), a2, voffA);
            PG8_BAR; PG8_WAIT_L(0); PG8_MMA(1, 0, At, B0); PG8_BAR; PG8_SCHED;
            PG8_STAGE(PG8_SB(0, 1), b2 + hstep, voffB);
            PG8_WAIT_V(6); PG8_BAR; PG8_MMA(1, 1, At, B1); PG8_BAR;
            PG8_LDB(B0, 1, 0); PG8_SCHED; PG8_LDA(At, 1, 0); PG8_STAGE(PG8_SA(0, 1), a2 + hstep, voffA);
            PG8_WAIT_L(8); PG8_BAR; PG8_WAIT_L(0); PG8_MMA(0, 0, At, B0); PG8_BAR; PG8_SCHED;
            PG8_LDB(B1, 1, 1); PG8_STAGE(PG8_SB(1, 0), b3, voffB);
            PG8_BAR; PG8_WAIT_L(0); PG8_MMA(0, 1, At, B1); PG8_BAR;
            PG8_LDA(At, 1, 1); PG8_STAGE(PG8_SA(1, 0), a3, voffA);
            PG8_BAR; PG8_WAIT_L(0); PG8_MMA(1, 0, At, B0); PG8_BAR; PG8_SCHED;
            PG8_STAGE(PG8_SB(1, 1), b3 + hstep, voffB);
            PG8_WAIT_V(6); PG8_BAR; PG8_MMA(1, 1, At, B1); PG8_BAR;
        }
        const bool keep = E(acc, cur, wr, wc, fr, fq);
        if (!has_next) break;
        if (!keep) {
#pragma unroll
            for (int a = 0; a < 2; ++a)
#pragma unroll
                for (int b = 0; b < 2; ++b)
#pragma unroll
                    for (int m = 0; m < 4; ++m)
#pragma unroll
                        for (int n = 0; n < 2; ++n) acc[a][b][m][n] = (f32x4){0.f, 0.f, 0.f, 0.f};
        }
        cur = nxt; cA = nA; cB = nB; ++ui;
    }
    PG8_WAIT_V(0);
    if (wr == 0) PG8_BAR;
    PG8_BAR;
#undef PG8_SA
#undef PG8_SB
#undef PG8_STAGE
#undef PG8_LDA
#undef PG8_LDB
#undef PG8_MMA
#undef PG8_WAIT_V
#undef PG8_WAIT_L
#undef PG8_BAR
#undef PG8_SCHED
}
}

#define PROBE_SKIP_EPI 0
struct EpiProj {
    static constexpr bool PERM = true;
    bf16_t* O;
    __device__ __forceinline__ bool operator()(f32x4 (&acc)[2][2][4][2], const pg8::Unit& u, int wr, int wc, int fr, int fq) const {
        if (PROBE_SKIP_EPI && u.rep) return false;
        const int pn = u.pn;
        int mode = 0; float scale = 1.0f;
        if ((pn >= 6 && pn < 10) || (pn >= 22 && pn < 26)) mode = 1;
        else if (pn >= 10 && pn < 14) { mode = 1; scale = 0.08838834764831845f; }
        const int row0 = u.pm * 256 + wr * 64 + fr, col0 = pn * 256 + wc * 32 + 8 * fq;
        if (pn >= 26) {
#pragma unroll
            for (int ai = 0; ai < 2; ++ai)
#pragma unroll
                for (int m = 0; m < 4; ++m) { bf16_t* rowp = O + (size_t)(row0 + ai * 128 + m * 16) * INW + col0;
                    float rr[8], s2[8];
#pragma unroll
                    for (int n = 0; n < 2; ++n)
#pragma unroll
                        for (int j = 0; j < 4; ++j) { const float p1 = 1.0f + fminf(__expf(-acc[ai][0][m][n][j]), 1e15f), p2 = 1.0f + fminf(__expf(-acc[ai][1][m][n][j]), 1e15f);
                            const float inv = fast_rcp(p1 * p2);
                            s2[4 * n + j] = p1 * inv; rr[4 * n + j] = p2 * p2 * inv; }
                    u32x4 w; w.x = cvt_pk_bf16(rr[0], rr[1]); w.y = cvt_pk_bf16(rr[2], rr[3]); w.z = cvt_pk_bf16(rr[4], rr[5]); w.w = cvt_pk_bf16(rr[6], rr[7]);
                    __builtin_nontemporal_store(w, (u32x4*)rowp);
                    w.x = cvt_pk_bf16(s2[0], s2[1]); w.y = cvt_pk_bf16(s2[2], s2[3]); w.z = cvt_pk_bf16(s2[4], s2[5]); w.w = cvt_pk_bf16(s2[6], s2[7]);
                    __builtin_nontemporal_store(w, (u32x4*)(rowp + 128)); }
            return false;
        }
#pragma unroll
        for (int ai = 0; ai < 2; ++ai)
#pragma unroll
            for (int m = 0; m < 4; ++m) { bf16_t* rowp = O + (size_t)(row0 + ai * 128 + m * 16) * INW + col0;
#pragma unroll
                for (int bj = 0; bj < 2; ++bj) { f32x4 v0 = acc[ai][bj][m][0], v1 = acc[ai][bj][m][1];
                    if (mode != 0) {
#pragma unroll
                        for (int j = 0; j < 4; ++j) { v0[j] = v0[j] * sigmoidf_(v0[j]) * scale; v1[j] = v1[j] * sigmoidf_(v1[j]) * scale; }
                    }
                    u32x4 w; w.x = cvt_pk_bf16(v0[0], v0[1]); w.y = cvt_pk_bf16(v0[2], v0[3]); w.z = cvt_pk_bf16(v1[0], v1[1]); w.w = cvt_pk_bf16(v1[2], v1[3]);
                    __builtin_nontemporal_store(w, (u32x4*)(rowp + bj * 128)); } }
        return false;
    }
};
struct EpiMerge {
    static constexpr bool PERM = true;
    const bf16_t* proj; bf16_t* O;
    __device__ __forceinline__ bool operator()(f32x4 (&acc)[2][2][4][2], const pg8::Unit& u, int wr, int wc, int fr, int fq) const {
        const int row0 = u.pm * 256 + wr * 64 + fr, lc = wc * 32 + 8 * fq;
        const int goff = OMA + u.pn * 512 + (u.kind ? 128 : 0) + lc;
        u32x4 Gv[2][4][2];
#pragma unroll
        for (int ai = 0; ai < 2; ++ai)
#pragma unroll
            for (int m = 0; m < 4; ++m)
#pragma unroll
                for (int bj = 0; bj < 2; ++bj) Gv[ai][m][bj] = __builtin_nontemporal_load((const u32x4*)(proj + (size_t)(row0 + ai * 128 + m * 16) * INW + goff + bj * 256));
#pragma unroll
        for (int ai = 0; ai < 2; ++ai)
#pragma unroll
            for (int m = 0; m < 4; ++m)
#pragma unroll
                for (int bj = 0; bj < 2; ++bj) { const u32x4 g = Gv[ai][m][bj];
                    const float gs[8] = {bflo(g.x), bfhi(g.x), bflo(g.y), bfhi(g.y), bflo(g.z), bfhi(g.z), bflo(g.w), bfhi(g.w)};
                    f32x4 v0 = acc[ai][bj][m][0], v1 = acc[ai][bj][m][1];
#pragma unroll
                    for (int j = 0; j < 4; ++j) { v0[j] *= gs[j]; v1[j] *= gs[4 + j]; }
                    if (u.kind == 0) { acc[ai][bj][m][0] = v0; acc[ai][bj][m][1] = v1; }
                    else { u32x4 w; w.x = cvt_pk_bf16(v0[0], v0[1]); w.y = cvt_pk_bf16(v0[2], v0[3]); w.z = cvt_pk_bf16(v1[0], v1[1]); w.w = cvt_pk_bf16(v1[2], v1[3]);
                        *(u32x4*)(O + (size_t)(row0 + ai * 128 + m * 16) * DM + u.pn * 256 + bj * 128 + lc) = w; } }
        return u.kind == 0;
    }
};
struct EpiY {
    static constexpr bool PERM = true;
    bf16_t* O;
    __device__ __forceinline__ bool operator()(f32x4 (&acc)[2][2][4][2], const pg8::Unit& u, int wr, int wc, int fr, int fq) const {
        const int row0 = u.pm * 256 + wr * 64 + fr, col0 = u.pn * 256 + wc * 32 + 8 * fq;
#pragma unroll
        for (int ai = 0; ai < 2; ++ai)
#pragma unroll
            for (int m = 0; m < 4; ++m) { bf16_t* rowp = O + (size_t)(row0 + ai * 128 + m * 16) * DM + col0;
#pragma unroll
                for (int bj = 0; bj < 2; ++bj) { const f32x4 v0 = acc[ai][bj][m][0], v1 = acc[ai][bj][m][1];
                    u32x4 w; w.x = cvt_pk_bf16(v0[0], v0[1]); w.y = cvt_pk_bf16(v0[2], v0[3]); w.z = cvt_pk_bf16(v1[0], v1[1]); w.w = cvt_pk_bf16(v1[2], v1[3]);
                    __builtin_nontemporal_store(w, (u32x4*)(rowp + bj * 128)); } }
        return false;
    }
};

struct TrTile { const float* src; bf16_t* dst; int N; };
__device__ __forceinline__ TrTile tr_tile(const Params& p, int t, int lane) {
    constexpr int T_IN = (DM / 64) * (INW / 64), T_AO = (1024 / 64) * (DM / 64);
    const float* W; bf16_t* WT; int K, N; bool gate = false;
    if (t < T_IN) { W = p.w_in; WT = (bf16_t*)(p.ws + WS_WIN); K = DM; N = INW; gate = true; }
    else if (t < T_IN + T_AO) { t -= T_IN; W = p.w_ao; WT = (bf16_t*)(p.ws + WS_WAO); K = 1024; N = DM; }
    else if (t < T_IN + 2 * T_AO) { t -= T_IN + T_AO; W = p.w_ho; WT = (bf16_t*)(p.ws + WS_WHO); K = 1024; N = DM; }
    else { t -= T_IN + 2 * T_AO; W = p.w_o; WT = (bf16_t*)(p.ws + WS_WO); K = DM; N = DM; }
    const int ntn = N >> 6; const int k0 = (t / ntn) * 64, n0 = (t % ntn) * 64;
    int nrow = n0;
    if (gate && n0 >= OMA) { const int hg = (n0 >= OMH) ? 1 : 0, ch = n0 - (hg ? OMH : OMA); nrow = OMA + (ch >> 7) * 256 + hg * 128 + (ch & 127); }
    TrTile r; r.src = W + (size_t)k0 * N + n0 + lane; r.dst = WT + (size_t)(nrow + lane) * K + k0; r.N = N; return r;
}
__device__ __forceinline__ void tr_load(const TrTile& T, float (&v)[64]) {
#pragma unroll
    for (int i = 0; i < 64; ++i) v[i] = T.src[(size_t)i * T.N];
}
__device__ __forceinline__ void tr_store(const TrTile& T, const float (&v)[64]) {
#pragma unroll
    for (int i = 0; i < 8; ++i) { u32x4 w; w.x = cvt_pk_bf16(v[8 * i], v[8 * i + 1]); w.y = cvt_pk_bf16(v[8 * i + 2], v[8 * i + 3]); w.z = cvt_pk_bf16(v[8 * i + 4], v[8 * i + 5]); w.w = cvt_pk_bf16(v[8 * i + 6], v[8 * i + 7]);
        *(u32x4*)(T.dst + 8 * i) = w; }
}

__device__ __forceinline__ void phase_prep(const Params& p, unsigned char* shm) {
    const int tid = threadIdx.x, wid = tid >> 6, lane = tid & 63;
    bf16_t* hA = (bf16_t*)(p.ws + WS_HA);
    for (int r = blockIdx.x * 8 + wid; r < NTOK; r += gridDim.x * 8) {
        const f32x4* xr = (const f32x4*)(p.x + (size_t)r * DM);
        f32x4 v[8]; float ss = 0.f;
#pragma unroll
        for (int i = 0; i < 8; ++i) { v[i] = xr[lane + 64 * i]; ss += v[i][0] * v[i][0] + v[i][1] * v[i][1] + v[i][2] * v[i][2] + v[i][3] * v[i][3]; }
        ss = wave_sum(ss);
        const float rstd = rsqrtf(ss * (1.0f / DM) + 1e-6f);
#pragma unroll
        for (int i = 0; i < 8; ++i) { const f32x4 g = ((const f32x4*)p.norm_gain)[lane + 64 * i];
            u32x2 w; w.x = cvt_pk_bf16(v[i][0] * rstd * g[0], v[i][1] * rstd * g[1]); w.y = cvt_pk_bf16(v[i][2] * rstd * g[2], v[i][3] * rstd * g[3]);
            *(u32x2*)(hA + (size_t)r * DM + (lane + 64 * i) * 4) = w; }
    }
    {
        constexpr int T_ALL = (DM / 64) * (INW / 64) + 2 * (1024 / 64) * (DM / 64) + (DM / 64) * (DM / 64);
        const int tstep = gridDim.x * 8; int t = blockIdx.x * 8 + wid;
        float v[64]; TrTile cur;
        if (t < T_ALL) { cur = tr_tile(p, t, lane); tr_load(cur, v); }
#pragma unroll 1
        for (; t < T_ALL; t += tstep) {
            float nv[64]; TrTile nxt = cur; const int tn = t + tstep;
            if (tn < T_ALL) { nxt = tr_tile(p, tn, lane); tr_load(nxt, nv); }
            tr_store(cur, v);
            cur = nxt;
#pragma unroll
            for (int i = 0; i < 64; ++i) v[i] = nv[i];
        }
    }
    f32x2* rope = (f32x2*)(p.ws + WS_ROPE);
    for (int idx = blockIdx.x * 512 + tid; idx < NTOK * 32; idx += gridDim.x * 512) {
        const int tok = idx >> 5, i = idx & 31;
        const float ang = (float)p.pos[tok] * c_inv_freq[i];
        const double a = (double)ang; const double kq = rint(a * 0.63661977236758134308);
        const double r = fma(-kq, 1.5707963267948966192, a) - kq * 6.123233995736766e-17;
        const double r2 = r * r;
        double sn = r2 * (-1.0 / 39916800.0) + (1.0 / 362880.0); sn = sn * r2 - (1.0 / 5040.0); sn = sn * r2 + (1.0 / 120.0); sn = sn * r2 - (1.0 / 6.0); sn = sn * r2 * r + r;
        double cs = r2 * (1.0 / 479001600.0) - (1.0 / 3628800.0); cs = cs * r2 + (1.0 / 40320.0); cs = cs * r2 - (1.0 / 720.0); cs = cs * r2 + (1.0 / 24.0); cs = cs * r2 - 0.5; cs = cs * r2 + 1.0;
        const int q = ((int)(long long)kq) & 3;
        const double c_ = (q == 0) ? cs : (q == 1) ? -sn : (q == 2) ? -cs : sn;
        const double s_ = (q == 0) ? sn : (q == 1) ? cs : (q == 2) ? -sn : -cs;
        f32x2 o; o.x = (float)c_; o.y = (float)s_; rope[idx] = o;
    }
}

constexpr int KS_STRIDE = 72;
constexpr int VT_STRIDE = 264;
struct AttnStage { u32x4 k1a, k1b, k2a, k2b; u32x4 va0, va1, vb0, vb1; };
struct AttnQ { u32x4 x1, x2; f32x4 rp[4]; };
__device__ __forceinline__ void attn_unit_coords(int unit, int& kvh, int& n, int& tq0) { kvh = unit & 3; const int blk = unit >> 2; n = blk & 127; tq0 = (blk >> 7) * NT + n * 128; }
__device__ __forceinline__ void attn_load_stage(const bf16_t* proj, const f32x2* rope, int unit, int tid, AttnStage& S) {
    int kvh, n, tq0; attn_unit_coords(unit, kvh, n, tq0); const int tk0 = tq0 - 128;
    { const int key = tid & 255, hc = tid >> 8;
      if ((n > 0) || (key >= 128)) { const size_t tok = (size_t)(tk0 + key);
          const bf16_t* kp = proj + tok * INW + OKK + kvh * 64 + hc * 16;
          S.k1a = *(const u32x4*)kp; S.k1b = *(const u32x4*)(kp + 8); S.k2a = *(const u32x4*)(kp + 32); S.k2b = *(const u32x4*)(kp + 40);
      } else { S.k1a = S.k1b = S.k2a = S.k2b = (u32x4){0, 0, 0, 0}; } }
    { const int kp = tid & 127, dc = tid >> 7;
      if ((n > 0) || (kp >= 64)) { const bf16_t* vp = proj + (size_t)(tk0 + 2 * kp) * INW + OV + kvh * 64 + dc * 16;
          S.va0 = *(const u32x4*)vp; S.va1 = *(const u32x4*)(vp + 8); S.vb0 = *(const u32x4*)(vp + INW); S.vb1 = *(const u32x4*)(vp + INW + 8);
      } else { S.va0 = S.va1 = S.vb0 = S.vb1 = (u32x4){0, 0, 0, 0}; } }
}
__device__ __forceinline__ void attn_write_stage(const AttnStage& S, const f32x2* rope, int tk0, bf16_t* Ks, bf16_t* Vt, int tid) {
    { const int key = tid & 255, hc = tid >> 8;
      const int tokc = (tk0 + key) < 0 ? 0 : (tk0 + key);
      const f32x4* rp = (const f32x4*)(rope + (size_t)tokc * 32 + hc * 16);
      const unsigned x1[8] = {S.k1a.x, S.k1a.y, S.k1a.z, S.k1a.w, S.k1b.x, S.k1b.y, S.k1b.z, S.k1b.w};
      const unsigned x2[8] = {S.k2a.x, S.k2a.y, S.k2a.z, S.k2a.w, S.k2b.x, S.k2b.y, S.k2b.z, S.k2b.w};
      unsigned r1[8], r2[8];
#pragma unroll
      for (int i = 0; i < 8; ++i) { const f32x4 cs = rp[i];
          const float a0 = bflo(x1[i]), a1 = bfhi(x1[i]), b0 = bflo(x2[i]), b1 = bfhi(x2[i]);
          r1[i] = cvt_pk_bf16(a0 * cs[0] - b0 * cs[1], a1 * cs[2] - b1 * cs[3]);
          r2[i] = cvt_pk_bf16(b0 * cs[0] + a0 * cs[1], b1 * cs[2] + a1 * cs[3]); }
      bf16_t* kd = Ks + key * KS_STRIDE + hc * 16;
      *(u32x4*)kd = (u32x4){r1[0], r1[1], r1[2], r1[3]}; *(u32x4*)(kd + 8) = (u32x4){r1[4], r1[5], r1[6], r1[7]};
      *(u32x4*)(kd + 32) = (u32x4){r2[0], r2[1], r2[2], r2[3]}; *(u32x4*)(kd + 40) = (u32x4){r2[4], r2[5], r2[6], r2[7]}; }
    { const int kp = tid & 127, dc = tid >> 7;
      const unsigned a[8] = {S.va0.x, S.va0.y, S.va0.z, S.va0.w, S.va1.x, S.va1.y, S.va1.z, S.va1.w};
      const unsigned c[8] = {S.vb0.x, S.vb0.y, S.vb0.z, S.vb0.w, S.vb1.x, S.vb1.y, S.vb1.z, S.vb1.w};
      unsigned* vd = (unsigned*)(Vt + (dc * 16) * VT_STRIDE + 2 * kp);
#pragma unroll
      for (int i = 0; i < 8; ++i) {
          vd[(2 * i) * (VT_STRIDE / 2)] = (a[i] & 0xffffu) | (c[i] << 16);
          vd[(2 * i + 1) * (VT_STRIDE / 2)] = (a[i] >> 16) | (c[i] & 0xffff0000u); } }
}
__device__ __forceinline__ void attn_load_q(const bf16_t* proj, const f32x2* rope, size_t tq, int hq, int fq, AttnQ& Q) {
    const bf16_t* qp = proj + tq * INW + OQ + hq * 64 + fq * 8;
    Q.x1 = *(const u32x4*)qp; Q.x2 = *(const u32x4*)(qp + 32);
    const f32x4* rp = (const f32x4*)(rope + tq * 32 + fq * 8);
#pragma unroll
    for (int i = 0; i < 4; ++i) Q.rp[i] = rp[i];
}
__device__ __forceinline__ void attn_qtile(const AttnQ& Q, const bf16_t* proj, const bf16_t* Ks, const bf16_t* Vt, bf16_t* Aatt, size_t tq, int hq, int qt, int n, float sink, int fr, int fq) {
    u32x2 gtv[4];
#pragma unroll
    for (int nt = 0; nt < 4; ++nt) gtv[nt] = *(const u32x2*)(proj + tq * INW + OAG + hq * 64 + nt * 16 + fq * 4);
    bf16x8 qf0, qf1;
    { const unsigned a[4] = {Q.x1.x, Q.x1.y, Q.x1.z, Q.x1.w}, c[4] = {Q.x2.x, Q.x2.y, Q.x2.z, Q.x2.w}; unsigned r1[4], r2[4];
#pragma unroll
      for (int i = 0; i < 4; ++i) { const f32x4 cs = Q.rp[i];
          const float a0 = bflo(a[i]) * 0.125f, a1 = bfhi(a[i]) * 0.125f, b0 = bflo(c[i]) * 0.125f, b1 = bfhi(c[i]) * 0.125f;
          r1[i] = cvt_pk_bf16(a0 * cs[0] - b0 * cs[1], a1 * cs[2] - b1 * cs[3]);
          r2[i] = cvt_pk_bf16(b0 * cs[0] + a0 * cs[1], b1 * cs[2] + a1 * cs[3]); }
      qf0 = mk8(r1[0], r1[1], r1[2], r1[3]); qf1 = mk8(r2[0], r2[1], r2[2], r2[3]); }
    f32x4 s[9];
#pragma unroll
    for (int k9 = 0; k9 < 9; ++k9) {
        const bf16_t* kr = Ks + ((qt + k9) * 16 + fr) * KS_STRIDE + fq * 8;
        const bf16x8 a0 = *(const bf16x8*)kr, a1 = *(const bf16x8*)(kr + 32);
        f32x4 z = {0.f, 0.f, 0.f, 0.f};
        z = __builtin_amdgcn_mfma_f32_16x16x32_bf16(a0, qf0, z, 0, 0, 0);
        s[k9] = __builtin_amdgcn_mfma_f32_16x16x32_bf16(a1, qf1, z, 0, 0, 0);
    }
    const int d0 = fq * 4 - fr;
    float mx = sink;
#pragma unroll
    for (int k9 = 0; k9 < 9; ++k9) { const bool tile_ok = (n > 0) || (qt + k9 >= 8);
#pragma unroll
        for (int j = 0; j < 4; ++j) { bool vis = tile_ok;
            if (k9 == 0) vis = vis && (d0 + j > 0);
            if (k9 == 8) vis = vis && (d0 + j <= 0);
            s[k9][j] = vis ? s[k9][j] : -INFINITY; mx = fmaxf(mx, s[k9][j]); } }
    mx = fmaxf(mx, __shfl_xor(mx, 16)); mx = fmaxf(mx, __shfl_xor(mx, 32));
    float l = 0.f;
#pragma unroll
    for (int k9 = 0; k9 < 9; ++k9)
#pragma unroll
        for (int j = 0; j < 4; ++j) { const float e = __expf(s[k9][j] - mx); s[k9][j] = e; l += e; }
    l += __shfl_xor(l, 16); l += __shfl_xor(l, 32);
    l += __expf(sink - mx);
    const float inv_l = fast_rcp(l);
    bf16x8 pf[5];
#pragma unroll
    for (int pp = 0; pp < 4; ++pp) pf[pp] = mk8(cvt_pk_bf16(s[2 * pp][0], s[2 * pp][1]), cvt_pk_bf16(s[2 * pp][2], s[2 * pp][3]), cvt_pk_bf16(s[2 * pp + 1][0], s[2 * pp + 1][1]), cvt_pk_bf16(s[2 * pp + 1][2], s[2 * pp + 1][3]));
    pf[4] = mk8(cvt_pk_bf16(s[8][0], s[8][1]), cvt_pk_bf16(s[8][2], s[8][3]), 0u, 0u);
#pragma unroll
    for (int nt = 0; nt < 4; ++nt) { f32x4 o = {0.f, 0.f, 0.f, 0.f};
        const bf16_t* vr = Vt + (nt * 16 + fr) * VT_STRIDE + fq * 4;
#pragma unroll
        for (int pp = 0; pp < 5; ++pp) { const int kta = qt + 2 * pp, ktb = (kta + 1 > 15) ? 15 : kta + 1;
            const u32x2 lo = *(const u32x2*)(vr + kta * 16), hi = *(const u32x2*)(vr + ktb * 16);
            o = __builtin_amdgcn_mfma_f32_16x16x32_bf16(mk8(lo.x, lo.y, hi.x, hi.y), pf[pp], o, 0, 0, 0); }
        const u32x2 gt = gtv[nt];
        u32x2 w; w.x = cvt_pk_bf16(o[0] * inv_l * bflo(gt.x), o[1] * inv_l * bfhi(gt.x)); w.y = cvt_pk_bf16(o[2] * inv_l * bflo(gt.y), o[3] * inv_l * bfhi(gt.y));
        *(u32x2*)(Aatt + tq * 1024 + hq * 64 + nt * 16 + fq * 4) = w; }
}
__device__ __forceinline__ void attn_phase(const Params& p, unsigned char* shm, int c, int G) {
    const bf16_t* proj = (const bf16_t*)(p.ws + WS_PROJ);
    const f32x2* rope = (const f32x2*)(p.ws + WS_ROPE);
    bf16_t* Aatt = (bf16_t*)(p.ws + WS_AATT);
    bf16_t* Ks = (bf16_t*)shm;
    bf16_t* Vt = (bf16_t*)(shm + 256 * KS_STRIDE * 2);
    const int tid = threadIdx.x, wid = tid >> 6, lane = tid & 63, fr = lane & 15, fq = lane >> 4;
    const int g = wid >> 1, qb = (wid & 1) * 4;
    const int cx = (G == 256) ? ((c & 7) * 32 + (c >> 3)) : c;
    if (cx >= NAU) return;
    AttnStage S; attn_load_stage(proj, rope, cx, tid, S);
#pragma unroll 1
    for (int unit = cx; unit < NAU; unit += G) {
        int kvh, n, tq0; attn_unit_coords(unit, kvh, n, tq0);
        const int hq = kvh * 4 + g; const float sink = p.sinks[hq];
        AttnQ Q0, Q1;
        attn_load_q(proj, rope, (size_t)(tq0 + (qb + 0) * 16 + fr), hq, fq, Q0);
        attn_write_stage(S, rope, tq0 - 128, Ks, Vt, tid);
        __syncthreads();
        attn_load_q(proj, rope, (size_t)(tq0 + (qb + 1) * 16 + fr), hq, fq, Q1);
        attn_qtile(Q0, proj, Ks, Vt, Aatt, (size_t)(tq0 + (qb + 0) * 16 + fr), hq, qb + 0, n, sink, fr, fq);
        attn_load_q(proj, rope, (size_t)(tq0 + (qb + 2) * 16 + fr), hq, fq, Q0);
        attn_qtile(Q1, proj, Ks, Vt, Aatt, (size_t)(tq0 + (qb + 1) * 16 + fr), hq, qb + 1, n, sink, fr, fq);
        attn_load_q(proj, rope, (size_t)(tq0 + (qb + 3) * 16 + fr), hq, fq, Q1);
        attn_qtile(Q0, proj, Ks, Vt, Aatt, (size_t)(tq0 + (qb + 2) * 16 + fr), hq, qb + 2, n, sink, fr, fq);
        if (unit + G < NAU) attn_load_stage(proj, rope, unit + G, tid, S);
        attn_qtile(Q1, proj, Ks, Vt, Aatt, (size_t)(tq0 + (qb + 3) * 16 + fr), hq, qb + 3, n, sink, fr, fq);
        __syncthreads();
    }
}

constexpr int H_STRIDE64 = 72;
constexpr int H_STRIDE128 = 136;
constexpr int SCN = 16;
constexpr int NSC = NT / (64 * SCN);
constexpr int NSU = NB * 8 * NSC;
struct HgrnRaw { unsigned hf[16]; unsigned hi[16]; };
__device__ __forceinline__ void hgrn_load_raw(const bf16_t* proj, size_t rc, int h, int d, int seg, HgrnRaw& R) {
    const bf16_t* bp = proj + (rc + seg * 16) * INW + h * 128 + d;
#pragma unroll
    for (int i = 0; i < 16; ++i) { R.hf[i] = bp[(size_t)i * INW + OHF]; R.hi[i] = bp[(size_t)i * INW + OHI]; }
}
__device__ __forceinline__ void hgrn_gates(const HgrnRaw& R, float lb, float (&bp)[16], float (&kk)[16]) {
    float run = 1.0f;
#pragma unroll
    for (int i = 0; i < 16; ++i) {
        const float hf = __uint_as_float(R.hf[i] << 16);
        const float e = __expf(-hf), inv = fast_rcp(1.0f + e);
        const float f = lb + (1.0f - lb) * inv;
        kk[i] = (1.0f - lb) * e * inv;
        run *= f; bp[i] = run;
    }
}
__device__ __forceinline__ void hgrn_store_vt(const HgrnRaw& R, bf16_t* Vt, int d, int seg) {
    unsigned w[8];
#pragma unroll
    for (int i = 0; i < 8; ++i) w[i] = R.hi[2 * i] | (R.hi[2 * i + 1] << 16);
    bf16_t* vd = Vt + d * H_STRIDE64 + seg * 16; *(u32x4*)vd = (u32x4){w[0], w[1], w[2], w[3]}; *(u32x4*)(vd + 8) = (u32x4){w[4], w[5], w[6], w[7]};
}

__device__ __forceinline__ void hgrn_local_unit(const Params& p, unsigned char* shm, int u) {
    const bf16_t* proj = (const bf16_t*)(p.ws + WS_PROJ);
    float* UT = p.out + (size_t)u * 16384; float* dtot = (float*)(p.ws + WS_DTOT) + (size_t)u * 128;
    bf16_t* KdT = (bf16_t*)shm;
    bf16_t* Vt = (bf16_t*)(shm + 128 * H_STRIDE64 * 2);
    float* segsum = (float*)(shm + 2 * 128 * H_STRIDE64 * 2);
    float* dsh = segsum + 512;
    const int tid = threadIdx.x, wid = tid >> 6, lane = tid & 63, fr = lane & 15, fq = lane >> 4;
    const int sc = u % NSC, sq = u / NSC, h = sq & 7, b = sq >> 3; const size_t r0 = (size_t)b * NT + (size_t)sc * (64 * SCN);
    const int d = tid & 127, seg = tid >> 7;
    const float lb = fast_rcp(1.0f + __expf(p.lbt[1024 + h * 128 + d] - p.lbt[h * 128 + d]));
    f32x4 acc[8];
#pragma unroll
    for (int vt = 0; vt < 8; ++vt) acc[vt] = (f32x4){0.f, 0.f, 0.f, 0.f};
    float bsum = 1.0f;
    HgrnRaw R; hgrn_load_raw(proj, r0, h, d, seg, R);
#pragma unroll 1
    for (int cc = 0; cc < SCN; ++cc) {
        float bp[16], kk[16];
        hgrn_gates(R, lb, bp, kk);
        segsum[seg * 128 + d] = bp[15];
        hgrn_store_vt(R, Vt, d, seg);
        if (cc < SCN - 1) hgrn_load_raw(proj, r0 + (size_t)(cc + 1) * 64, h, d, seg, R);
        __syncthreads();
        float off = 1.0f, btot = 1.0f;
#pragma unroll
        for (int s2 = 0; s2 < 4; ++s2) { const float v = segsum[s2 * 128 + d]; btot *= v; if (s2 < seg) off *= v; }
        { unsigned w[8];
#pragma unroll
          for (int i = 0; i < 8; ++i) { const float k0 = kk[2 * i] * btot * fast_rcp(off * bp[2 * i]), k1 = kk[2 * i + 1] * btot * fast_rcp(off * bp[2 * i + 1]); w[i] = cvt_pk_bf16(k0, k1); }
          bf16_t* kd = KdT + d * H_STRIDE64 + seg * 16; *(u32x4*)kd = (u32x4){w[0], w[1], w[2], w[3]}; *(u32x4*)(kd + 8) = (u32x4){w[4], w[5], w[6], w[7]}; }
        if (seg == 0) dsh[d] = btot;
        bsum *= btot;
        __syncthreads();
        const f32x4 dv = *(const f32x4*)(dsh + 16 * wid + fq * 4);
#pragma unroll
        for (int vt = 0; vt < 8; ++vt) acc[vt] *= dv;
#pragma unroll
        for (int ks = 0; ks < 2; ++ks) { const bf16x8 a = *(const bf16x8*)(KdT + (16 * wid + fr) * H_STRIDE64 + ks * 32 + fq * 8);
#pragma unroll
            for (int vt = 0; vt < 8; ++vt) { const bf16x8 bv = *(const bf16x8*)(Vt + (16 * vt + fr) * H_STRIDE64 + ks * 32 + fq * 8);
                acc[vt] = __builtin_amdgcn_mfma_f32_16x16x32_bf16(a, bv, acc[vt], 0, 0, 0); } }
        __syncthreads();
    }
#pragma unroll
    for (int vt = 0; vt < 8; ++vt) *(f32x4*)(UT + (size_t)(16 * vt + fr) * 128 + 16 * wid + fq * 4) = acc[vt];
    if (seg == 0) dtot[d] = bsum;
}

__device__ __forceinline__ void hgrn_scan(const Params& p) {
    const float* dtot = (const float*)(p.ws + WS_DTOT);
    for (int gidx = blockIdx.x * 512 + threadIdx.x; gidx < 16 * 8192; gidx += gridDim.x * 512) {
        const int sq = gidx >> 13, e = (gidx & 8191) * 2, d = e & 127;
        float* base = p.out + (size_t)sq * NSC * 16384 + e; const float* db = dtot + (size_t)sq * NSC * 128 + d;
        f32x2 S = {0.f, 0.f};
        for (int c0 = 0; c0 < NSC; c0 += 8) {
            f32x2 U[8], D[8];
#pragma unroll
            for (int i = 0; i < 8; ++i) { U[i] = *(const f32x2*)(base + (size_t)(c0 + i) * 16384); D[i] = *(const f32x2*)(db + (size_t)(c0 + i) * 128); }
#pragma unroll
            for (int i = 0; i < 8; ++i) { *(f32x2*)(base + (size_t)(c0 + i) * 16384) = S; S = D[i] * S + U[i]; }
        }
    }
}

__device__ __forceinline__ void hgrn_out_unit(const Params& p, unsigned char* shm, int u) {
    const bf16_t* proj = (const bf16_t*)(p.ws + WS_PROJ);
    const float* ST = p.out + (size_t)u * 16384;
    bf16_t* Ahg = (bf16_t*)(p.ws + WS_AHGR);
    bf16_t* Qs = (bf16_t*)shm;
    bf16_t* Ks2 = (bf16_t*)(shm + 17408);
    bf16_t* Vt = (bf16_t*)(shm + 34816);
    bf16_t* KdT = (bf16_t*)(shm + 53248);
    bf16_t* St = (bf16_t*)(shm + 71680);
    float* segsum = (float*)(shm + 106496);
    float* eref = segsum + 512;
    float* dsh = eref + 128;
    float* part = dsh + 128;
    const int tid = threadIdx.x, wid = tid >> 6, lane = tid & 63, fr = lane & 15, fq = lane >> 4;
    const int sc = u % NSC, sq = u / NSC, h = sq & 7, b = sq >> 3; const size_t r0 = (size_t)b * NT + (size_t)sc * (64 * SCN);
    const int d = tid & 127, seg = tid >> 7;
    const int tt = wid & 3, vh = wid >> 2;
    const float lb = fast_rcp(1.0f + __expf(p.lbt[1024 + h * 128 + d] - p.lbt[h * 128 + d]));
    f32x4 acc[8];
#pragma unroll
    for (int vt = 0; vt < 8; ++vt) acc[vt] = *(const f32x4*)(ST + (size_t)(16 * vt + fr) * 128 + 16 * wid + fq * 4);
    f32x4 gn[4];
#pragma unroll
    for (int vt = 0; vt < 4; ++vt) gn[vt] = *(const f32x4*)(p.hgain + h * 128 + 16 * (vh * 4 + vt) + fq * 4);
    HgrnRaw R; hgrn_load_raw(proj, r0, h, d, seg, R);
    unsigned hq[16];
#pragma unroll
    for (int i = 0; i < 16; ++i) hq[i] = proj[(r0 + seg * 16 + i) * INW + OHQ + h * 128 + d];
#pragma unroll 1
    for (int cc = 0; cc < SCN; ++cc) {
        const size_t rc = r0 + (size_t)cc * 64;
        float bp[16], kk[16];
        hgrn_gates(R, lb, bp, kk);
        segsum[seg * 128 + d] = bp[15];
        hgrn_store_vt(R, Vt, d, seg);
        __syncthreads();
        float off = 1.0f, btot = 1.0f;
#pragma unroll
        for (int s2 = 0; s2 < 4; ++s2) { const float v = segsum[s2 * 128 + d]; btot *= v; if (s2 < seg) off *= v; }
        const float bref = segsum[d] * segsum[128 + d];
        if (seg == 0) dsh[d] = btot;
        const float rref = fast_rcp(bref), etail = btot * rref;
        { float kdv[16];
#pragma unroll
          for (int i = 0; i < 16; ++i) { const float cp = off * bp[i]; const int t = seg * 16 + i;
              const float qv = __uint_as_float(hq[i] << 16);
              const float kt = kk[i] * bref * fast_rcp(cp); kdv[i] = kt * etail;
              const unsigned qk = cvt_pk_bf16(qv * cp * rref, kt);
              Qs[t * H_STRIDE128 + d] = (bf16_t)(qk & 0xffffu); Ks2[t * H_STRIDE128 + d] = (bf16_t)(qk >> 16); }
          unsigned w[8];
#pragma unroll
          for (int i = 0; i < 8; ++i) w[i] = cvt_pk_bf16(kdv[2 * i], kdv[2 * i + 1]);
          bf16_t* kd = KdT + d * H_STRIDE64 + seg * 16; *(u32x4*)kd = (u32x4){w[0], w[1], w[2], w[3]}; *(u32x4*)(kd + 8) = (u32x4){w[4], w[5], w[6], w[7]}; }
        if (cc < SCN - 1) { hgrn_load_raw(proj, rc + 64, h, d, seg, R);
#pragma unroll
            for (int i = 0; i < 16; ++i) hq[i] = proj[(rc + 64 + seg * 16 + i) * INW + OHQ + h * 128 + d]; }
        const size_t r = rc + 16 * tt + fr;
        u32x2 gt[4];
#pragma unroll
        for (int vt = 0; vt < 4; ++vt) gt[vt] = *(const u32x2*)(proj + r * INW + OHG + h * 128 + 16 * (vh * 4 + vt) + fq * 4);
        { const f32x4 s0 = *(const f32x4*)(segsum + 16 * wid + fq * 4), s1 = *(const f32x4*)(segsum + 128 + 16 * wid + fq * 4); const f32x4 er = s0 * s1;
#pragma unroll
          for (int vt = 0; vt < 8; ++vt) { const f32x4 sv = acc[vt] * er; u32x2 w; w.x = cvt_pk_bf16(sv[0], sv[1]); w.y = cvt_pk_bf16(sv[2], sv[3]);
              *(u32x2*)(St + (16 * vt + fr) * H_STRIDE128 + 16 * wid + fq * 4) = w; } }
        __syncthreads();
        bf16x8 bq[4];
#pragma unroll
        for (int ks = 0; ks < 4; ++ks) bq[ks] = *(const bf16x8*)(Qs + (16 * tt + fr) * H_STRIDE128 + ks * 32 + fq * 8);
        f32x4 pa[4];
#pragma unroll
        for (int st = 0; st < 4; ++st) { pa[st] = (f32x4){0.f, 0.f, 0.f, 0.f};
            if (st <= tt) {
#pragma unroll
                for (int ks = 0; ks < 4; ++ks) { const bf16x8 a = *(const bf16x8*)(Ks2 + (16 * st + fr) * H_STRIDE128 + ks * 32 + fq * 8);
                    pa[st] = __builtin_amdgcn_mfma_f32_16x16x32_bf16(a, bq[ks], pa[st], 0, 0, 0); }
#pragma unroll
                for (int j = 0; j < 4; ++j) { const int s_ = 16 * st + fq * 4 + j, t_ = 16 * tt + fr; pa[st][j] = (s_ <= t_) ? pa[st][j] : 0.f; }
            } }
        bf16x8 pf[2];
#pragma unroll
        for (int pp = 0; pp < 2; ++pp) pf[pp] = mk8(cvt_pk_bf16(pa[2 * pp][0], pa[2 * pp][1]), cvt_pk_bf16(pa[2 * pp][2], pa[2 * pp][3]), cvt_pk_bf16(pa[2 * pp + 1][0], pa[2 * pp + 1][1]), cvt_pk_bf16(pa[2 * pp + 1][2], pa[2 * pp + 1][3]));
        f32x4 o[4]; float ss = 0.f;
#pragma unroll
        for (int vt = 0; vt < 4; ++vt) { const int vrow = 16 * (vh * 4 + vt) + fr; o[vt] = (f32x4){0.f, 0.f, 0.f, 0.f};
#pragma unroll
            for (int pp = 0; pp < 2; ++pp) { const u32x2 lo = *(const u32x2*)(Vt + vrow * H_STRIDE64 + (2 * pp) * 16 + fq * 4), hi = *(const u32x2*)(Vt + vrow * H_STRIDE64 + (2 * pp + 1) * 16 + fq * 4);
                o[vt] = __builtin_amdgcn_mfma_f32_16x16x32_bf16(mk8(lo.x, lo.y, hi.x, hi.y), pf[pp], o[vt], 0, 0, 0); }
#pragma unroll
            for (int ks = 0; ks < 4; ++ks) { const bf16x8 a = *(const bf16x8*)(St + vrow * H_STRIDE128 + ks * 32 + fq * 8);
                o[vt] = __builtin_amdgcn_mfma_f32_16x16x32_bf16(a, bq[ks], o[vt], 0, 0, 0); }
            ss += o[vt][0] * o[vt][0] + o[vt][1] * o[vt][1] + o[vt][2] * o[vt][2] + o[vt][3] * o[vt][3]; }
        ss += __shfl_xor(ss, 16); ss += __shfl_xor(ss, 32);
        if (fq == 0) part[vh * 64 + 16 * tt + fr] = ss;
        if (cc < SCN - 1) {
            const f32x4 dv = *(const f32x4*)(dsh + 16 * wid + fq * 4);
#pragma unroll
            for (int vt = 0; vt < 8; ++vt) acc[vt] *= dv;
#pragma unroll
            for (int ks = 0; ks < 2; ++ks) { const bf16x8 a = *(const bf16x8*)(KdT + (16 * wid + fr) * H_STRIDE64 + ks * 32 + fq * 8);
#pragma unroll
                for (int vt = 0; vt < 8; ++vt) { const bf16x8 bv = *(const bf16x8*)(Vt + (16 * vt + fr) * H_STRIDE64 + ks * 32 + fq * 8);
                    acc[vt] = __builtin_amdgcn_mfma_f32_16x16x32_bf16(a, bv, acc[vt], 0, 0, 0); } }
        }
        __syncthreads();
        const float tot = part[16 * tt + fr] + part[64 + 16 * tt + fr];
        const float rstd = rsqrtf(tot * (1.0f / 128.0f) + 1e-6f);
#pragma unroll
        for (int vt = 0; vt < 4; ++vt) { const int col = h * 128 + 16 * (vh * 4 + vt) + fq * 4;
            u32x2 w; w.x = cvt_pk_bf16(o[vt][0] * rstd * gn[vt][0] * bflo(gt[vt].x), o[vt][1] * rstd * gn[vt][1] * bfhi(gt[vt].x)); w.y = cvt_pk_bf16(o[vt][2] * rstd * gn[vt][2] * bflo(gt[vt].y), o[vt][3] * rstd * gn[vt][3] * bfhi(gt[vt].y));
            *(u32x2*)(Ahg + r * 1024 + col) = w; }
    }
}

__device__ __forceinline__ void phase_final(const Params& p) {
    const int tid = threadIdx.x, wid = tid >> 6, lane = tid & 63;
    const bf16_t* yb = (const bf16_t*)(p.ws + WS_AATT);
    for (int r = blockIdx.x * 8 + wid; r < NTOK; r += gridDim.x * 8) {
        const float* xr = p.x + (size_t)r * DM;
        f32x4 v[8]; float ss = 0.f;
#pragma unroll
        for (int i = 0; i < 4; ++i) { const int c0 = (lane + 64 * i) * 8;
            const u32x4 yv = __builtin_nontemporal_load((const u32x4*)(yb + (size_t)r * DM + c0));
            const f32x4 x0 = __builtin_nontemporal_load((const f32x4*)(xr + c0)), x1 = __builtin_nontemporal_load((const f32x4*)(xr + c0 + 4));
            f32x4 a, b; a[0] = x0[0] + bflo(yv.x); a[1] = x0[1] + bfhi(yv.x); a[2] = x0[2] + bflo(yv.y); a[3] = x0[3] + bfhi(yv.y);
            b[0] = x1[0] + bflo(yv.z); b[1] = x1[1] + bfhi(yv.z); b[2] = x1[2] + bflo(yv.w); b[3] = x1[3] + bfhi(yv.w);
            ss += a[0] * a[0] + a[1] * a[1] + a[2] * a[2] + a[3] * a[3] + b[0] * b[0] + b[1] * b[1] + b[2] * b[2] + b[3] * b[3];
            v[2 * i] = a; v[2 * i + 1] = b; }
        ss = wave_sum(ss);
        const float rstd = rsqrtf(ss * (1.0f / DM) + 1e-6f);
        float* orow = p.out + (size_t)r * DM;
#pragma unroll
        for (int i = 0; i < 4; ++i) { const int c0 = (lane + 64 * i) * 8;
            const f32x4 g0 = *(const f32x4*)(p.fgain + c0), g1 = *(const f32x4*)(p.fgain + c0 + 4);
            f32x4 a = v[2 * i], b = v[2 * i + 1];
            a[0] = a[0] * rstd * g0[0]; a[1] = a[1] * rstd * g0[1]; a[2] = a[2] * rstd * g0[2]; a[3] = a[3] * rstd * g0[3];
            b[0] = b[0] * rstd * g1[0]; b[1] = b[1] * rstd * g1[1]; b[2] = b[2] * rstd * g1[2]; b[3] = b[3] * rstd * g1[3];
            __builtin_nontemporal_store(a, (f32x4*)(orow + c0)); __builtin_nontemporal_store(b, (f32x4*)(orow + c0 + 4)); }
    }
}

#define XB_TMO      128
#define XB_XCNT(j)  (256  + 64 * (j))
#define XB_XSUB(j)  (1280 + 64 * (j))
#define XB_XGEN(j)  (2304 + 64 * (j))
#define XB_TOP      3328
#define XB_TOPGEN   3392
#define XCD_BAR_WORDS 3456
#define XB_SPIN_CAP (1u << 18)
__device__ __forceinline__ unsigned xb_ld(unsigned* p)              { return __hip_atomic_load(p, __ATOMIC_RELAXED, __HIP_MEMORY_SCOPE_AGENT); }
__device__ __forceinline__ unsigned xb_add(unsigned* p, unsigned v) { return __hip_atomic_fetch_add(p, v, __ATOMIC_RELAXED, __HIP_MEMORY_SCOPE_AGENT); }
__device__ __forceinline__ unsigned xb_xcc_id() { return (unsigned)__builtin_amdgcn_s_getreg((3 << 11) | 20) & 0xFu; }
#define XB_SPIN(cond, bar) do { unsigned _sp = 0; while (cond) { __builtin_amdgcn_s_sleep(1); \
    if ((++_sp & 255u) == 0u) { if (xb_ld(&(bar)[XB_TMO])) break; if (_sp > XB_SPIN_CAP) { atomicAdd(&(bar)[XB_TMO], 1u); break; } } } } while (0)
struct XcdBarrier { unsigned* bar; unsigned x; volatile LAS unsigned* st; };
__device__ __forceinline__ XcdBarrier xcd_barrier_post(unsigned* bar, volatile LAS unsigned* st) {
    XcdBarrier b; b.bar = bar; b.x = xb_xcc_id(); b.st = st;
    if (threadIdx.x == 0) (void)xb_add(&bar[XB_XCNT(b.x)], 1u);
    return b;
}
__device__ __forceinline__ void xcd_barrier_complete(unsigned* bar, unsigned x, unsigned& nloc, unsigned& nx) {
    const unsigned G = gridDim.x * gridDim.y * gridDim.z;
    unsigned sum, cnt, mine, sp = 0u;
    for (;;) {
        sum = 0u; cnt = 0u; mine = 0u;
#pragma unroll
        for (unsigned j = 0; j < 16; ++j) { const unsigned c = xb_ld(&bar[XB_XCNT(j)]); sum += c; cnt += (c > 0u) ? 1u : 0u; mine = (j == x) ? c : mine; }
        if (sum == G) break;
        __builtin_amdgcn_s_sleep(1);
        if ((++sp & 255u) == 0u) { if (xb_ld(&bar[XB_TMO])) break; if (sp > XB_SPIN_CAP) { atomicAdd(&bar[XB_TMO], 1u); break; } }
    }
    nloc = mine > 0u ? mine : 1u; nx = cnt > 0u ? cnt : 1u;
}
__device__ __forceinline__ void xcd_barrier(const XcdBarrier& b) {
    asm volatile("s_waitcnt vmcnt(0)" ::: "memory");
    __syncthreads();
    if (threadIdx.x == 0) {
        unsigned* bar = b.bar;
        __builtin_amdgcn_s_waitcnt(0);
        unsigned nloc = b.st[0], nx = b.st[1];
        if (nloc == 0u) { xcd_barrier_complete(bar, b.x, nloc, nx); b.st[0] = nloc; b.st[1] = nx; }
        const unsigned old = xb_add(&bar[XB_XSUB(b.x)], 1u);
        const unsigned gen = old / nloc;
        if (old + 1u == (gen + 1u) * nloc) {
            __builtin_amdgcn_fence(__ATOMIC_RELEASE, "agent");
            asm volatile("s_waitcnt vmcnt(0)" ::: "memory");
            const unsigned og = xb_add(&bar[XB_TOP], 1u);
            const unsigned tg = og / nx;
            if (og + 1u == (tg + 1u) * nx) xb_add(&bar[XB_TOPGEN], 1u);
            else XB_SPIN(xb_ld(&bar[XB_TOPGEN]) == tg, bar);
            __builtin_amdgcn_fence(__ATOMIC_ACQUIRE, "agent");
            xb_add(&bar[XB_XGEN(b.x)], 1u);
            asm volatile("s_waitcnt vmcnt(0)" ::: "memory");
        } else {
            XB_SPIN(xb_ld(&bar[XB_XGEN(b.x)]) == gen, bar);
            __builtin_amdgcn_fence(__ATOMIC_ACQUIRE, "agent");
            asm volatile("s_waitcnt vmcnt(0)" ::: "memory");
        }
    }
    __syncthreads();
}

__device__ __forceinline__ void stagger_us(int us) {
    if (us <= 0) return;
    const unsigned long long t0 = __builtin_amdgcn_s_memrealtime();
    while (__builtin_amdgcn_s_memrealtime() - t0 < (unsigned long long)us * 100ull) __builtin_amdgcn_s_sleep(8);
}
#define STAG1 0
#define STAG5 0
#define STAG6 0
#define REP0 1
#define REPS 0
#define REP1 1
#define REP2 1
#define REPA 1
#define REP4 1
#define REP5 1
#define REP6 1
__global__ void __launch_bounds__(512, 2) fwd_megakernel(Params p) {
    extern __shared__ __attribute__((aligned(16))) unsigned char shm[];
    cg::grid_group grid = cg::this_grid();
    const int G = (int)gridDim.x, c = (int)blockIdx.x;
    volatile LAS unsigned* xst = (volatile LAS unsigned*)((LAS unsigned char*)shm + pg8::STAGE_BYTES);
    if (threadIdx.x == 0) { xst[0] = 0u; xst[1] = 0u; xst[2] = 0u; xst[3] = 0u; }
    __syncthreads();
    const XcdBarrier xb = xcd_barrier_post((unsigned*)(p.ws + WS_BAR), xst);
    for (int rep = 0; rep < REP0; ++rep) phase_prep(p, shm);
    if (p.ws == nullptr) grid.sync();
    xcd_barrier(xb);
    for (int rep = 0; rep < REPS; ++rep) xcd_barrier(xb);
    { pg8::Gemm g; g.A0 = (const bf16_t*)(p.ws + WS_HA); g.B0 = (const bf16_t*)(p.ws + WS_WIN); g.A1 = g.A0; g.B1 = g.B0; g.M = NTOK; g.N = INW; g.K = DM;
      stagger_us(((c >> 3) & 3) * STAG1);
      pg8::StaticOrder S; S.init(NTOK, INW, G, c, 0, REP1); EpiProj E; E.O = (bf16_t*)(p.ws + WS_PROJ);
      pg8::gemm_phase<EpiProj>((LAS unsigned char*)shm, g, S, E); }
    xcd_barrier(xb);
    for (int rep = 0; rep < REPA; ++rep) attn_phase(p, shm, c, G);
    for (int rep = 0; rep < REP2; ++rep) for (int u = c; u < NSU; u += G) hgrn_local_unit(p, shm, u);
    xcd_barrier(xb);
    hgrn_scan(p);
    xcd_barrier(xb);
    for (int rep = 0; rep < REP4; ++rep) for (int u = c; u < NSU; u += G) hgrn_out_unit(p, shm, u);
    xcd_barrier(xb);
    { pg8::Gemm g; g.A0 = (const bf16_t*)(p.ws + WS_AATT); g.B0 = (const bf16_t*)(p.ws + WS_WAO); g.A1 = (const bf16_t*)(p.ws + WS_AHGR); g.B1 = (const bf16_t*)(p.ws + WS_WHO); g.M = NTOK; g.N = DM; g.K = 1024;
      stagger_us(((c >> 3) & 3) * STAG5);
      pg8::StaticOrder S; S.init(NTOK, DM, G, c, 1, REP5); EpiMerge E; E.proj = (const bf16_t*)(p.ws + WS_PROJ); E.O = (bf16_t*)(p.ws + WS_HA);
      pg8::gemm_phase<EpiMerge>((LAS unsigned char*)shm, g, S, E); }
    xcd_barrier(xb);
    { pg8::Gemm g; g.A0 = (const bf16_t*)(p.ws + WS_HA); g.B0 = (const bf16_t*)(p.ws + WS_WO); g.A1 = g.A0; g.B1 = g.B0; g.M = NTOK; g.N = DM; g.K = DM;
      stagger_us(((c >> 3) & 3) * STAG6);
      pg8::StaticOrder S; S.init(NTOK, DM, G, c, 0, REP6); EpiY E; E.O = (bf16_t*)(p.ws + WS_AATT);
      pg8::gemm_phase<EpiY>((LAS unsigned char*)shm, g, S, E); }
    xcd_barrier(xb);
    phase_final(p);
}

extern "C" void kernel_launch(void* const* d_in, const int* in_sizes, int n_in, void* d_out, int out_size, void* d_ws, size_t ws_size, hipStream_t stream) {
    constexpr size_t kDynLds = pg8::STAGE_BYTES + 16;
    static int grid_blocks = 0;
    if (grid_blocks == 0) {
        if (ws_size < WS_END) { fprintf(stderr, "kernel_launch: workspace too small: %zu < %zu\n", ws_size, (size_t)WS_END); grid_blocks = -1; return; }
        int dev = 0, cus = 0, per_cu = 0;
        (void)hipGetDevice(&dev);
        (void)hipDeviceGetAttribute(&cus, hipDeviceAttributeMultiprocessorCount, dev);
        if (hipFuncSetAttribute((const void*)fwd_megakernel, hipFuncAttributeMaxDynamicSharedMemorySize, (int)kDynLds) != hipSuccess) { fprintf(stderr, "kernel_launch: hipFuncSetAttribute failed\n"); grid_blocks = -1; return; }
        if (hipOccupancyMaxActiveBlocksPerMultiprocessor(&per_cu, (const void*)fwd_megakernel, 512, kDynLds) != hipSuccess || per_cu < 1) { fprintf(stderr, "kernel_launch: occupancy query failed (%d)\n", per_cu); (void)hipGetLastError(); grid_blocks = -1; return; }
        if (per_cu > 1) per_cu = 1;
        grid_blocks = cus * per_cu;
    }
    if (grid_blocks < 0) return;
    Params p{};
    p.x = (const float*)d_in[0]; p.pos = (const int*)d_in[1]; p.norm_gain = (const float*)d_in[2]; p.w_in = (const float*)d_in[3]; p.sinks = (const float*)d_in[4];
    p.lbt = (const float*)d_in[5]; p.hgain = (const float*)d_in[6]; p.w_ao = (const float*)d_in[7]; p.w_ho = (const float*)d_in[8]; p.w_o = (const float*)d_in[9];
    p.fgain = (const float*)d_in[10]; p.out = (float*)d_out; p.ws = (unsigned char*)d_ws;
    if (hipMemsetAsync((unsigned char*)d_ws + WS_BAR, 0, XCD_BAR_WORDS * 4, stream) != hipSuccess) { fprintf(stderr, "kernel_launch: memset of the barrier words failed\n"); return; }
    void* args[] = {&p};
    hipError_t e = hipLaunchCooperativeKernel((const void*)fwd_megakernel, dim3(grid_blocks), dim3(512), args, kDynLds, stream);
    if (e != hipSuccess) fprintf(stderr, "cooperative launch failed: %s (grid %d)\n", hipGetErrorString(e), grid_blocks);
}
```
